# Optimizing an MI355X kernel written in HIP

```python
import jax, jax.numpy as jnp
from jax import lax
import numpy as np

D_MODEL = 2048
BATCH = 4
SEQ = 4096
DEPTH = 1

N_BRANCH = 2
BRANCH_WIDTH = 2048
GMLP_WIDTH = BRANCH_WIDTH
GMLP_GROUPS = 8
GMLP_GROUP_DIM = GMLP_WIDTH // GMLP_GROUPS
GMLP_CHUNK = 128
SSD_WIDTH = BRANCH_WIDTH
SSD_HEAD_DIM = 64
SSD_HEADS = SSD_WIDTH // SSD_HEAD_DIM
SSD_GROUPS = 8
SSD_HEADS_PER_GROUP = SSD_HEADS // SSD_GROUPS
SSD_STATE = 128
SSD_CONV = 4
SSD_CHUNK = 128
SSD_CONV_DIM = SSD_WIDTH + 2 * SSD_GROUPS * SSD_STATE
SSD_NORM_GROUP = SSD_WIDTH // SSD_GROUPS
IN_PROJ_DIM = 3 * GMLP_WIDTH + SSD_WIDTH + SSD_CONV_DIM + SSD_HEADS + N_BRANCH * D_MODEL
EPS = 1e-5

kernel_name = "hybrid_gmlp_ssd_gated_merge"


def rms_norm(x, w):
    xf = x.astype(jnp.float32)
    y = xf * lax.rsqrt(jnp.mean(xf * xf, axis=-1, keepdims=True) + EPS)
    return (y * w.astype(jnp.float32)).astype(x.dtype)


def layer_norm(x, w, b):
    xf = x.astype(jnp.float32)
    mu = jnp.mean(xf, axis=-1, keepdims=True)
    var = jnp.mean(jnp.square(xf - mu), axis=-1, keepdims=True)
    y = (xf - mu) * lax.rsqrt(var + EPS)
    return (y * w.astype(jnp.float32) + b.astype(jnp.float32)).astype(x.dtype)


def gmlp_spatial_gating(u, v, z, ln_w, ln_b, w_s, b_s):
    b, s, _ = v.shape
    nc = s // GMLP_CHUNK
    v = layer_norm(v, ln_w, ln_b).reshape(b, nc, GMLP_CHUNK, GMLP_GROUPS, GMLP_GROUP_DIM)
    causal = jnp.tril(jnp.ones((GMLP_CHUNK, GMLP_CHUNK), dtype=bool))
    w_masked = jnp.where(causal[None], w_s, jnp.zeros_like(w_s))
    mixed = jnp.einsum('gts,bcsgd->bctgd', w_masked, v) + b_s.T[None, None, :, :, None]
    return jax.nn.silu(z) * u * mixed.reshape(b, s, GMLP_WIDTH)


def causal_depthwise_conv(u, w, bias):
    k_w = w.shape[0]
    s = u.shape[1]
    up = jnp.pad(u, ((0, 0), (k_w - 1, 0), (0, 0)))
    out = bias
    for k in range(k_w):
        out = out + up[:, k:k + s] * w[k]
    return out


def ssd_chunked_scan(xs, dt, a, bm, cm):
    b, s = xs.shape[:2]
    nc = s // SSD_CHUNK
    L, G, K, P, N = SSD_CHUNK, SSD_GROUPS, SSD_HEADS_PER_GROUP, SSD_HEAD_DIM, SSD_STATE
    x = (xs * dt[..., None]).reshape(b, nc, L, G, K, P)
    adt = (dt * a).reshape(b, nc, L, G, K).astype(jnp.float32)
    bm = bm.reshape(b, nc, L, G, N)
    cm = cm.reshape(b, nc, L, G, N)
    a_cum = jnp.cumsum(adt, axis=2)
    a_cum_t = jnp.moveaxis(a_cum, 2, -1)
    causal = jnp.tril(jnp.ones((L, L), dtype=bool))
    seg = a_cum_t[..., :, None] - a_cum_t[..., None, :]
    decay = jnp.where(causal, jnp.exp(jnp.where(causal, seg, jnp.zeros_like(seg))), jnp.zeros_like(seg))
    cb = jnp.einsum('bclgn,bcsgn->bcgls', cm, bm)
    scores = cb[:, :, :, None] * decay.astype(cb.dtype)
    y_diag = jnp.einsum('bcgkls,bcsgkp->bclgkp', scores, x)
    decay_to_end = jnp.exp(a_cum[:, :, -1:] - a_cum).astype(x.dtype)
    states = jnp.einsum('bclgn,bclgkp->bcgkpn', bm, x * decay_to_end[..., None])
    chunk_decay = jnp.exp(a_cum_t[..., -1]).astype(states.dtype)

    def step(h, inp):
        st, dec = inp
        return h * dec[..., None, None] + st, h

    h0 = jnp.zeros((b, G, K, P, N), dtype=states.dtype)
    _, prev = lax.scan(step, h0, (jnp.moveaxis(states, 1, 0), jnp.moveaxis(chunk_decay, 1, 0)))
    prev = jnp.moveaxis(prev, 0, 1)
    y_off = jnp.einsum('bclgn,bcgkpn->bclgkp', cm, prev) * jnp.exp(a_cum).astype(x.dtype)[..., None]
    return (y_diag + y_off).reshape(b, s, SSD_HEADS, P)


def ssd_branch(z, xbc, dt_raw, conv_w, conv_b, dt_bias, a_log, d_skip, norm_w):
    b, s, _ = xbc.shape
    xbc = jax.nn.silu(causal_depthwise_conv(xbc, conv_w, conv_b))
    gn = SSD_GROUPS * SSD_STATE
    xs = xbc[..., :SSD_WIDTH].reshape(b, s, SSD_HEADS, SSD_HEAD_DIM)
    bm = xbc[..., SSD_WIDTH:SSD_WIDTH + gn].reshape(b, s, SSD_GROUPS, SSD_STATE)
    cm = xbc[..., SSD_WIDTH + gn:].reshape(b, s, SSD_GROUPS, SSD_STATE)
    dt = jax.nn.softplus(dt_raw + dt_bias)
    a = -jnp.exp(a_log)
    y = ssd_chunked_scan(xs, dt, a, bm, cm) + d_skip[:, None] * xs
    y = y.reshape(b, s, SSD_WIDTH) * jax.nn.silu(z)
    yf = y.astype(jnp.float32).reshape(b, s, SSD_GROUPS, SSD_NORM_GROUP)
    yf = yf * lax.rsqrt(jnp.mean(yf * yf, axis=-1, keepdims=True) + EPS)
    return (yf.reshape(b, s, SSD_WIDTH) * norm_w.astype(jnp.float32)).astype(y.dtype)


def setup_inputs(seed: int = 0) -> dict:
    key = jax.random.key(seed)
    ks = jax.random.split(key, 17)
    nrm = jax.random.normal
    x = nrm(ks[0], (BATCH, SEQ, D_MODEL), jnp.float32)
    norm_w = 1.0 + 0.02 * nrm(ks[1], (DEPTH, D_MODEL), jnp.float32)
    w_in = nrm(ks[2], (DEPTH, D_MODEL, IN_PROJ_DIM), jnp.float32) * D_MODEL ** -0.5
    b_gate = 0.02 * nrm(ks[3], (DEPTH, N_BRANCH, D_MODEL), jnp.float32)
    ln_v_w = 1.0 + 0.02 * nrm(ks[4], (DEPTH, GMLP_WIDTH), jnp.float32)
    ln_v_b = 0.02 * nrm(ks[5], (DEPTH, GMLP_WIDTH), jnp.float32)
    w_spatial = nrm(ks[6], (DEPTH, GMLP_GROUPS, GMLP_CHUNK, GMLP_CHUNK), jnp.float32) * GMLP_CHUNK ** -0.5
    b_spatial = 1.0 + 0.1 * nrm(ks[7], (DEPTH, GMLP_GROUPS, GMLP_CHUNK), jnp.float32)
    conv_w = jax.random.uniform(ks[8], (DEPTH, SSD_CONV, SSD_CONV_DIM), jnp.float32, -1.0, 1.0) * SSD_CONV ** -0.5
    conv_b = 0.02 * nrm(ks[9], (DEPTH, SSD_CONV_DIM), jnp.float32)
    dt0 = jnp.exp(jax.random.uniform(ks[10], (DEPTH, SSD_HEADS), jnp.float32, np.log(1e-3), np.log(1e-1)))
    dt_bias = dt0 + jnp.log(-jnp.expm1(-dt0))
    a_log = jnp.log(jax.random.uniform(ks[11], (DEPTH, SSD_HEADS), jnp.float32, 1.0, 16.0))
    d_skip = 1.0 + 0.1 * nrm(ks[12], (DEPTH, SSD_HEADS), jnp.float32)
    ssm_norm_w = 1.0 + 0.02 * nrm(ks[13], (DEPTH, SSD_WIDTH), jnp.float32)
    w_branch = nrm(ks[14], (DEPTH, N_BRANCH, BRANCH_WIDTH, D_MODEL), jnp.float32) * BRANCH_WIDTH ** -0.5
    w_out = nrm(ks[15], (DEPTH, D_MODEL, D_MODEL), jnp.float32) * D_MODEL ** -0.5
    final_norm_w = 1.0 + 0.02 * nrm(ks[16], (D_MODEL,), jnp.float32)
    return {"x": x, "norm_w": norm_w, "w_in": w_in, "b_gate": b_gate, "ln_v_w": ln_v_w, "ln_v_b": ln_v_b,
            "w_spatial": w_spatial, "b_spatial": b_spatial, "conv_w": conv_w, "conv_b": conv_b,
            "dt_bias": dt_bias, "a_log": a_log, "d_skip": d_skip, "ssm_norm_w": ssm_norm_w,
            "w_branch": w_branch, "w_out": w_out, "final_norm_w": final_norm_w}


def reference(x, norm_w, w_in, b_gate, ln_v_w, ln_v_b, w_spatial, b_spatial, conv_w, conv_b,
              dt_bias, a_log, d_skip, ssm_norm_w, w_branch, w_out, final_norm_w):
    b, s, _ = x.shape
    o1 = GMLP_WIDTH
    o2 = 2 * GMLP_WIDTH
    o3 = 3 * GMLP_WIDTH
    o4 = o3 + SSD_WIDTH
    o5 = o4 + SSD_CONV_DIM
    o6 = o5 + SSD_HEADS
    for l in range(DEPTH):
        h = rms_norm(x, norm_w[l])
        proj = h @ w_in[l]
        u, v, z_a = proj[..., :o1], proj[..., o1:o2], proj[..., o2:o3]
        z_b, xbc, dt_raw = proj[..., o3:o4], proj[..., o4:o5], proj[..., o5:o6]
        gate_logits = proj[..., o6:].reshape(b, s, N_BRANCH, D_MODEL)
        y_a = gmlp_spatial_gating(u, v, z_a, ln_v_w[l], ln_v_b[l], w_spatial[l], b_spatial[l])
        y_b = ssd_branch(z_b, xbc, dt_raw, conv_w[l], conv_b[l], dt_bias[l], a_log[l], d_skip[l], ssm_norm_w[l])
        branches = jnp.stack([y_a, y_b], axis=2)
        branch_d = jnp.einsum('bsne,ned->bsnd', branches, w_branch[l])
        gates = jax.nn.sigmoid(gate_logits + b_gate[l])
        merged = jnp.sum(gates * branch_d, axis=2)
        x = x + merged @ w_out[l]
    return rms_norm(x, final_norm_w)
```

```cpp
#include <hip/hip_runtime.h>
#include <hip/hip_cooperative_groups.h>
#include <cstdio>
#include <cstdint>
namespace cg = cooperative_groups;
namespace pg8 {
#define PG8_LAS __attribute__((address_space(3)))
typedef unsigned short bf16_t;
typedef short bf16x8 __attribute__((ext_vector_type(8)));
typedef float f32x4 __attribute__((ext_vector_type(4)));
typedef unsigned u32x4 __attribute__((ext_vector_type(4)));
constexpr int BM = 256, BK = 64, HALF = 128, HTB = HALF * BK * 2  , STAGE_BYTES = 8 * HTB, NXCD = 8, WGM = 8;

__host__ __device__ __forceinline__ int lds_byte(int r, int c) { const int st = (r >> 4) * 2 + (c >> 5), rr = r & 15, cc = c & 31, ob = rr * 64 + cc * 2; return st * 1024 + (ob ^ (((ob >> 9) & 1) << 5)); }
__host__ __device__ __forceinline__ void stage_rc(int b, int& R, int& C) { const int st = b / 1024, sb = b % 1024, swz = sb ^ (((sb >> 9) & 1) << 5); R = (st >> 1) * 16 + swz / 64; C = (st & 1) * 32 + (swz % 64) / 2; }
__host__ __device__ __forceinline__ int perm32(int rho) { const int n = rho >> 4, i = rho & 15; return 8 * (i >> 2) + 4 * n + (i & 3); }

struct Unit { int pm, pn, kh; };
struct Gemm { const bf16_t* A; const bf16_t* Bt; int M, N, K, ld; };

struct StaticOrder {
    int nM, nN, nwg, G, c;
    __host__ __device__ void init(int M, int N, int G_, int c_) { nM = M / BM; nN = N / BM; nwg = nM * nN; G = G_; c = c_; }
    __host__ __device__ bool next(int i, Unit& u) const {
        const long L = (long)i * G + c; if (L >= nwg) return false;
        int wgid = (int)L; { const int q = nwg / NXCD, r = nwg % NXCD, xcd = wgid % NXCD, off = wgid / NXCD; wgid = (xcd < r ? xcd * (q + 1) : r * (q + 1) + (xcd - r) * q) + off; }
        const int nig = WGM * nN, gid = wgid / nig, fm = gid * WGM, gsz = (nM - fm) < WGM ? (nM - fm) : WGM;
        u.pm = fm + ((wgid % nig) % gsz); u.pn = (wgid % nig) / gsz; u.kh = 0; return true;
    }
    __device__ __forceinline__ void a_ready(const Unit&) const {}
    __device__ __forceinline__ void done(const Unit&) const {}
};
typedef float f32x2_t_ __attribute__((ext_vector_type(2)));
typedef __bf16 bf16x2_t_ __attribute__((ext_vector_type(2)));
__device__ __forceinline__ unsigned cvt_pk_bf16(float lo, float hi) { const f32x2_t_ v = {lo, hi}; const bf16x2_t_ b = __builtin_convertvector(v, bf16x2_t_); return __builtin_bit_cast(unsigned, b); }
template <class Epi, class Sched, bool ALIGN_EPI = false, bool SP2 = false>
__device__ __forceinline__ void gemm_phase(PG8_LAS unsigned char* lds, const Gemm g, const Sched& S, const Epi& E) {
    int tid_ = threadIdx.x; asm volatile("" : "+v"(tid_));
    const int tid = tid_, wid = __builtin_amdgcn_readfirstlane(tid >> 6), lane = tid & 63, wr = wid >> 2, wc = wid & 3, fr = lane & 15, fq = lane >> 4;
    const int K = g.K, nt = K / BK, ld = g.ld;
    unsigned voffA[2], voffB[2];
#pragma unroll
    for (int i = 0; i < 2; ++i) { int R, C; stage_rc(tid * 16 + i * 8192, R, C); const int Rb = Epi::PERM ? ((R & ~31) + perm32(R & 31)) : R;
        voffA[i] = (unsigned)(R * ld + C) * 2u; voffB[i] = (unsigned)(Rb * ld + C) * 2u; }
    const size_t kstep = (size_t)(BK * 2);
    const size_t hstep = (size_t)HALF * ld * 2;
    const size_t tstep = 2 * hstep;
    const unsigned ldsw = (unsigned)wid * 1024u;
    const int aoff = lds_byte(wr * 64 + fr, fq * 8), boff = lds_byte(wc * 32 + fr, fq * 8);
#define PG8_SA(b, h) (((b) * 2 + (h)) * HTB)
#define PG8_SB(b, h) ((4 + (b) * 2 + (h)) * HTB)
#define PG8_STAGE(bufoff, gbase, voff) do { _Pragma("unroll") for (int _i = 0; _i < 2; ++_i) \
        __builtin_amdgcn_global_load_lds((const unsigned*)((const char*)(gbase) + (voff)[_i]), (PG8_LAS unsigned*)(lds + (bufoff) + ldsw + _i * 8192), 16, 0, 0); } while (0)
#define PG8_LDA(dst, b, h) do { _Pragma("unroll") for (int m = 0; m < 4; ++m) _Pragma("unroll") for (int k = 0; k < 2; ++k) dst[m][k] = *(const PG8_LAS bf16x8*)(lds + PG8_SA(b, h) + aoff + m * 2048 + k * 1024); } while (0)
#define PG8_LDB(dst, b, h) do { _Pragma("unroll") for (int n = 0; n < 2; ++n) _Pragma("unroll") for (int k = 0; k < 2; ++k) dst[n][k] = *(const PG8_LAS bf16x8*)(lds + PG8_SB(b, h) + boff + n * 2048 + k * 1024); } while (0)
#define PG8_MMA(ai, bj, At, Bt) do { __builtin_amdgcn_s_setprio(1); _Pragma("unroll") for (int m = 0; m < 4; ++m) _Pragma("unroll") for (int n = 0; n < 2; ++n) _Pragma("unroll") for (int k = 0; k < 2; ++k) \
        acc[ai][bj][m][n] = __builtin_amdgcn_mfma_f32_16x16x32_bf16(Bt[n][k], At[m][k], acc[ai][bj][m][n], 0, 0, 0); __builtin_amdgcn_s_setprio(0); } while (0)
#define PG8_WAIT_V(n) asm volatile("s_waitcnt vmcnt(" #n ")" ::: "memory")
#define PG8_WAIT_L(n) asm volatile("s_waitcnt lgkmcnt(" #n ")" ::: "memory")
#define PG8_BAR __builtin_amdgcn_s_barrier()
#define PG8_SCHED __builtin_amdgcn_sched_barrier(0)
    Unit cur, nxt; int ui = 0;
    if (!S.next(0, cur)) return;
    f32x4 acc[2][2][4][2];
#pragma unroll
    for (int a = 0; a < 2; ++a)
#pragma unroll
        for (int b = 0; b < 2; ++b)
#pragma unroll
            for (int m = 0; m < 4; ++m)
#pragma unroll
                for (int n = 0; n < 2; ++n) acc[a][b][m][n] = (f32x4){0.f, 0.f, 0.f, 0.f};
    bf16x8 At[4][2], B0[2][2], B1[2][2];
    const char* cA = (const char*)g.A + (size_t)cur.pm * tstep + (size_t)cur.kh * K * 2; const char* cB = (const char*)g.Bt + (size_t)cur.pn * tstep + (size_t)cur.kh * K * 2;
    S.a_ready(cur);
    if constexpr (SP2) {
        PG8_STAGE(PG8_SB(0, 0), cB, voffB); PG8_STAGE(PG8_SB(0, 1), cB + hstep, voffB); PG8_STAGE(PG8_SA(0, 0), cA, voffA); PG8_STAGE(PG8_SA(0, 1), cA + hstep, voffA);
        if (wr == 1) PG8_BAR;
        PG8_WAIT_V(2); PG8_BAR;
        PG8_STAGE(PG8_SB(1, 0), cB + kstep, voffB); PG8_STAGE(PG8_SA(1, 0), cA + kstep, voffA); PG8_STAGE(PG8_SB(1, 1), cB + hstep + kstep, voffB);
        PG8_WAIT_V(6); PG8_BAR;
    } else {
        PG8_STAGE(PG8_SB(0, 0), cB, voffB); PG8_STAGE(PG8_SA(0, 0), cA, voffA); PG8_STAGE(PG8_SB(0, 1), cB + hstep, voffB); PG8_STAGE(PG8_SA(0, 1), cA + hstep, voffA);
        if (wr == 1) PG8_BAR;
        PG8_WAIT_V(4); PG8_BAR;
        PG8_STAGE(PG8_SB(1, 0), cB + kstep, voffB); PG8_STAGE(PG8_SA(1, 0), cA + kstep, voffA); PG8_STAGE(PG8_SB(1, 1), cB + hstep + kstep, voffB);
        PG8_WAIT_V(6); PG8_BAR;
    }
    for (;;) {
        const bool has_next = S.next(ui + 1, nxt);
        const char* nA = has_next ? (const char*)g.A + (size_t)nxt.pm * tstep + (size_t)nxt.kh * K * 2 : cA; const char* nB = has_next ? (const char*)g.Bt + (size_t)nxt.pn * tstep + (size_t)nxt.kh * K * 2 : cB;
        for (int t = 0; t < nt; t += 2) {
            const bool last = (t == nt - 2);
            const char* a1 = cA + (size_t)(t + 1) * kstep;
            const char* a2 = last ? nA : cA + (size_t)(t + 2) * kstep; const char* b2 = last ? nB : cB + (size_t)(t + 2) * kstep;
            const char* a3 = a2 + kstep; const char* b3 = b2 + kstep;
            if (last && has_next) S.a_ready(nxt);
            if constexpr (SP2) {
            PG8_LDB(B0, 0, 0); PG8_LDB(B1, 0, 1); PG8_SCHED; PG8_LDA(At, 0, 0); PG8_STAGE(PG8_SA(1, 1), a1 + hstep, voffA);
            PG8_WAIT_V(8); PG8_WAIT_L(0); PG8_BAR; PG8_MMA(0, 0, At, B0); PG8_MMA(0, 1, At, B1); PG8_BAR; PG8_SCHED;
            PG8_LDA(At, 0, 1); PG8_STAGE(PG8_SB(0, 0), b2, voffB); PG8_STAGE(PG8_SB(0, 1), b2 + hstep, voffB); PG8_STAGE(PG8_SA(0, 0), a2, voffA);
            PG8_WAIT_V(8); PG8_WAIT_L(0); PG8_BAR; PG8_MMA(1, 0, At, B0); PG8_MMA(1, 1, At, B1); PG8_BAR; PG8_SCHED;
            PG8_LDB(B0, 1, 0); PG8_LDB(B1, 1, 1); PG8_SCHED; PG8_LDA(At, 1, 0); PG8_STAGE(PG8_SA(0, 1), a2 + hstep, voffA);
            PG8_WAIT_V(8); PG8_WAIT_L(0); PG8_BAR; PG8_MMA(0, 0, At, B0); PG8_MMA(0, 1, At, B1); PG8_BAR; PG8_SCHED;
            PG8_LDA(At, 1, 1); PG8_STAGE(PG8_SB(1, 0), b3, voffB); PG8_STAGE(PG8_SB(1, 1), b3 + hstep, voffB); PG8_STAGE(PG8_SA(1, 0), a3, voffA);
            PG8_WAIT_V(8); PG8_WAIT_L(0); PG8_BAR; PG8_MMA(1, 0, At, B0); PG8_MMA(1, 1, At, B1); PG8_BAR; PG8_SCHED;
            } else {
            PG8_LDB(B0, 0, 0); PG8_SCHED; PG8_LDA(At, 0, 0); PG8_STAGE(PG8_SA(1, 1), a1 + hstep, voffA);
            PG8_WAIT_L(8); PG8_BAR; PG8_WAIT_L(0); PG8_MMA(0, 0, At, B0); PG8_BAR; PG8_SCHED;
            PG8_LDB(B1, 0, 1); PG8_STAGE(PG8_SB(0, 0), b2, voffB);
            PG8_BAR; PG8_WAIT_L(0); PG8_MMA(0, 1, At, B1); PG8_BAR;
            PG8_LDA(At, 0, 1); PG8_STAGE(PG8_SA(0, 0), a2, voffA);
            PG8_BAR; PG8_WAIT_L(0); PG8_MMA(1, 0, At, B0); PG8_BAR; PG8_SCHED;
            PG8_STAGE(PG8_SB(0, 1), b2 + hstep, voffB);
            PG8_WAIT_V(6); PG8_BAR; PG8_MMA(1, 1, At, B1); PG8_BAR;
            PG8_LDB(B0, 1, 0); PG8_SCHED; PG8_LDA(At, 1, 0); PG8_STAGE(PG8_SA(0, 1), a2 + hstep, voffA);
            PG8_WAIT_L(8); PG8_BAR; PG8_WAIT_L(0); PG8_MMA(0, 0, At, B0); PG8_BAR; PG8_SCHED;
            PG8_LDB(B1, 1, 1); PG8_STAGE(PG8_SB(1, 0), b3, voffB);
            PG8_BAR; PG8_WAIT_L(0); PG8_MMA(0, 1, At, B1); PG8_BAR;
            PG8_LDA(At, 1, 1); PG8_STAGE(PG8_SA(1, 0), a3, voffA);
            PG8_BAR; PG8_WAIT_L(0); PG8_MMA(1, 0, At, B0); PG8_BAR; PG8_SCHED;
            PG8_STAGE(PG8_SB(1, 1), b3 + hstep, voffB);
            PG8_WAIT_V(6); PG8_BAR; PG8_MMA(1, 1, At, B1); PG8_BAR;
            }
        }
        if constexpr (ALIGN_EPI) { if (wr == 0) PG8_BAR; }
        if constexpr (!Epi::AFTER_DRAIN) { E(acc, cur, wr, wc, fr, fq); S.done(cur); }
        if (!has_next) break;
        if (!E.keep(cur))
#pragma unroll
        for (int a = 0; a < 2; ++a)
#pragma unroll
            for (int b = 0; b < 2; ++b)
#pragma unroll
                for (int m = 0; m < 4; ++m)
#pragma unroll
                    for (int n = 0; n < 2; ++n) acc[a][b][m][n] = (f32x4){0.f, 0.f, 0.f, 0.f};
        cur = nxt; cA = nA; cB = nB; ++ui;
        if constexpr (ALIGN_EPI) { if (wr == 1) PG8_BAR; }
    }
    PG8_WAIT_V(0);
    if constexpr (!ALIGN_EPI) { if (wr == 0) PG8_BAR; }
    PG8_BAR;
    if constexpr (Epi::AFTER_DRAIN) { E.fused(acc, cur, wr, wc, fr, fq, lds, wid, lane); S.done(cur); }
#undef PG8_SA
#undef PG8_SB
#undef PG8_STAGE
#undef PG8_LDA
#undef PG8_LDB
#undef PG8_MMA
#undef PG8_WAIT_V
#undef PG8_WAIT_L
#undef PG8_BAR
#undef PG8_SCHED
}
}

#define LAS __attribute__((address_space(3)))
using pg8::bf16_t; using pg8::bf16x8; using pg8::f32x4; using pg8::u32x4; using pg8::cvt_pk_bf16;
typedef unsigned u32x2 __attribute__((ext_vector_type(2)));
typedef short s16x4 __attribute__((ext_vector_type(4)));

constexpr int NT = 512, NWAVES = 8;
constexpr int M_TOK = 16384, DM = 2048, SEQ = 4096, NCH = 32, CL_ = 128;
constexpr int NIN = 16416;
constexpr int NPROJ = 16384;
constexpr float EPS = 1e-5f;
constexpr int LDS_BYTES = 147456;
#ifndef PH_MASK
#define PH_MASK 0xFF
#endif

constexpr size_t MiB = 1048576;
constexpr size_t WS_BAR = 3 * MiB + 65536;
constexpr size_t WS_WDT = 0, WS_WSB = 131072, WS_STATS = 393216, WS_SSQ = 524288, WS_CD = 589824, WS_DT = 1 * MiB;
constexpr size_t WS_WB = 4 * MiB, WS_WO = 20 * MiB, WS_YAB = 28 * MiB, WS_V = 156 * MiB, WS_XBC = 220 * MiB, WS_R = 348 * MiB, WS_GB = 412 * MiB, WS_END = 476 * MiB;

__device__ __forceinline__ float bf2f(unsigned short u) { return __uint_as_float(((unsigned)u) << 16); }
__device__ __forceinline__ float bflo(unsigned w) { return __uint_as_float(w << 16); }
__device__ __forceinline__ float bfhi(unsigned w) { return __uint_as_float(w & 0xffff0000u); }
__device__ __forceinline__ float silu_f(float v) { return v * __builtin_amdgcn_rcpf(1.0f + __expf(-v)); }
__device__ __forceinline__ float sigmoid_f(float v) { return __builtin_amdgcn_rcpf(1.0f + __expf(-v)); }
__device__ __forceinline__ float wave_sum(float v) {
#pragma unroll
    for (int o = 1; o < 64; o <<= 1) v += __shfl_xor(v, o);
    return v;
}
__device__ __forceinline__ void atomic_addf(float* p, float v) { __hip_atomic_fetch_add(p, v, __ATOMIC_RELAXED, __HIP_MEMORY_SCOPE_AGENT); }

template <int OFF> __device__ __forceinline__ bf16x8 tr_frag(unsigned a) {
    s16x4 lo, hi;
    asm volatile("ds_read_b64_tr_b16 %0, %2\n\tds_read_b64_tr_b16 %1, %2 offset:%3\n\ts_waitcnt lgkmcnt(0)" : "=&v"(lo), "=&v"(hi) : "v"(a), "n"(OFF) : "memory");
    return (bf16x8){lo[0], lo[1], lo[2], lo[3], hi[0], hi[1], hi[2], hi[3]};
}

template <int OFF, int STEP> __device__ __forceinline__ void tr_frag2(unsigned a, bf16x8& f0, bf16x8& f1) {
    s16x4 l0, h0, l1, h1;
    asm volatile("ds_read_b64_tr_b16 %0, %4\n\tds_read_b64_tr_b16 %1, %4 offset:%5\n\tds_read_b64_tr_b16 %2, %4 offset:%6\n\tds_read_b64_tr_b16 %3, %4 offset:%7\n\ts_waitcnt lgkmcnt(0)"
                 : "=&v"(l0), "=&v"(h0), "=&v"(l1), "=&v"(h1) : "v"(a), "n"(OFF), "n"(STEP), "n"(STEP + OFF) : "memory");
    f0 = (bf16x8){l0[0], l0[1], l0[2], l0[3], h0[0], h0[1], h0[2], h0[3]}; f1 = (bf16x8){l1[0], l1[1], l1[2], l1[3], h1[0], h1[1], h1[2], h1[3]};
}
template <int OFF, int STEP> __device__ __forceinline__ void tr_frag4(unsigned a, bf16x8& f0, bf16x8& f1, bf16x8& f2, bf16x8& f3) {
    s16x4 l0, h0, l1, h1, l2, h2, l3, h3;
    asm volatile("ds_read_b64_tr_b16 %0, %8\n\tds_read_b64_tr_b16 %1, %8 offset:%9\n\tds_read_b64_tr_b16 %2, %8 offset:%10\n\tds_read_b64_tr_b16 %3, %8 offset:%11\n\t"
                 "ds_read_b64_tr_b16 %4, %8 offset:%12\n\tds_read_b64_tr_b16 %5, %8 offset:%13\n\tds_read_b64_tr_b16 %6, %8 offset:%14\n\tds_read_b64_tr_b16 %7, %8 offset:%15\n\ts_waitcnt lgkmcnt(0)"
                 : "=&v"(l0), "=&v"(h0), "=&v"(l1), "=&v"(h1), "=&v"(l2), "=&v"(h2), "=&v"(l3), "=&v"(h3)
                 : "v"(a), "n"(OFF), "n"(STEP), "n"(STEP + OFF), "n"(2 * STEP), "n"(2 * STEP + OFF), "n"(3 * STEP), "n"(3 * STEP + OFF) : "memory");
    f0 = (bf16x8){l0[0], l0[1], l0[2], l0[3], h0[0], h0[1], h0[2], h0[3]}; f1 = (bf16x8){l1[0], l1[1], l1[2], l1[3], h1[0], h1[1], h1[2], h1[3]};
    f2 = (bf16x8){l2[0], l2[1], l2[2], l2[3], h2[0], h2[1], h2[2], h2[3]}; f3 = (bf16x8){l3[0], l3[1], l3[2], l3[3], h3[0], h3[1], h3[2], h3[3]};
}

struct Args {
    const float* x; const float* norm_w; const float* w_in; const float* b_gate; const float* ln_w; const float* ln_b; const float* w_sp; const float* b_sp;
    const float* conv_w; const float* conv_b; const float* dt_bias; const float* a_log; const float* d_skip; const float* ssm_nw; const float* w_branch; const float* w_out; const float* fnw;
    float* out; unsigned char* ws;
};

struct EpiProj {
    static constexpr bool PERM = true, AFTER_DRAIN = false;
    __device__ __forceinline__ bool keep(const pg8::Unit&) const { return false; }
    bf16_t* YAB; bf16_t* V; bf16_t* XBC; bf16_t* R; bf16_t* GB; float* stats; const float* b_gate;
    __device__ __forceinline__ void operator()(const f32x4 (&acc)[2][2][4][2], const pg8::Unit& u, int wr, int wc, int fr, int fq) const {
        const int row0 = u.pm * 256 + wr * 64 + fr, pn = u.pn, cl = wc * 32 + 8 * fq;
        if (pn < 16) {
#pragma unroll
            for (int ai = 0; ai < 2; ++ai)
#pragma unroll
                for (int m = 0; m < 4; ++m) {
                    const f32x4 u0 = acc[ai][0][m][0], u1 = acc[ai][0][m][1], z0 = acc[ai][1][m][0], z1 = acc[ai][1][m][1];
                    u32x4 w;
                    w.x = cvt_pk_bf16(silu_f(z0[0]) * u0[0], silu_f(z0[1]) * u0[1]); w.y = cvt_pk_bf16(silu_f(z0[2]) * u0[2], silu_f(z0[3]) * u0[3]);
                    w.z = cvt_pk_bf16(silu_f(z1[0]) * u1[0], silu_f(z1[1]) * u1[1]); w.w = cvt_pk_bf16(silu_f(z1[2]) * u1[2], silu_f(z1[3]) * u1[3]);
                    *(u32x4*)(YAB + (size_t)(row0 + ai * 128 + m * 16) * 4096 + pn * 128 + cl) = w;
                }
        } else if (pn < 24) {
            const int c0 = (pn - 16) * 256 + cl;
#pragma unroll
            for (int ai = 0; ai < 2; ++ai)
#pragma unroll
                for (int m = 0; m < 4; ++m) {
                    const int row = row0 + ai * 128 + m * 16; float s = 0.f, q = 0.f;
#pragma unroll
                    for (int bj = 0; bj < 2; ++bj) {
                        const f32x4 v0 = acc[ai][bj][m][0], v1 = acc[ai][bj][m][1];
                        s += (v0[0] + v0[1]) + (v0[2] + v0[3]) + (v1[0] + v1[1]) + (v1[2] + v1[3]);
                        q += (v0[0] * v0[0] + v0[1] * v0[1]) + (v0[2] * v0[2] + v0[3] * v0[3]) + (v1[0] * v1[0] + v1[1] * v1[1]) + (v1[2] * v1[2] + v1[3] * v1[3]);
                        u32x4 w; w.x = cvt_pk_bf16(v0[0], v0[1]); w.y = cvt_pk_bf16(v0[2], v0[3]); w.z = cvt_pk_bf16(v1[0], v1[1]); w.w = cvt_pk_bf16(v1[2], v1[3]);
                        *(u32x4*)(V + (size_t)row * 2048 + c0 + bj * 128) = w;
                    }
                    s += __shfl_xor(s, 16); s += __shfl_xor(s, 32); q += __shfl_xor(q, 16); q += __shfl_xor(q, 32);
                    if (fq == 0) { atomic_addf(stats + 2 * row, s); atomic_addf(stats + 2 * row + 1, q); }
                }
        } else if (pn < 32) {
            const int c0 = (pn - 24) * 256 + cl;
#pragma unroll
            for (int ai = 0; ai < 2; ++ai)
#pragma unroll
                for (int m = 0; m < 4; ++m)
#pragma unroll
                    for (int bj = 0; bj < 2; ++bj) {
                        const f32x4 v0 = acc[ai][bj][m][0], v1 = acc[ai][bj][m][1];
                        u32x4 w; w.x = cvt_pk_bf16(silu_f(v0[0]), silu_f(v0[1])); w.y = cvt_pk_bf16(silu_f(v0[2]), silu_f(v0[3])); w.z = cvt_pk_bf16(silu_f(v1[0]), silu_f(v1[1])); w.w = cvt_pk_bf16(silu_f(v1[2]), silu_f(v1[3]));
                        *(u32x4*)(YAB + (size_t)(row0 + ai * 128 + m * 16) * 4096 + 2048 + c0 + bj * 128) = w;
                    }
        } else if (pn < 48) {
            const int c0 = (pn - 32) * 256 + cl;
#pragma unroll
            for (int ai = 0; ai < 2; ++ai)
#pragma unroll
                for (int m = 0; m < 4; ++m)
#pragma unroll
                    for (int bj = 0; bj < 2; ++bj) {
                        const f32x4 v0 = acc[ai][bj][m][0], v1 = acc[ai][bj][m][1];
                        u32x4 w; w.x = cvt_pk_bf16(v0[0], v0[1]); w.y = cvt_pk_bf16(v0[2], v0[3]); w.z = cvt_pk_bf16(v1[0], v1[1]); w.w = cvt_pk_bf16(v1[2], v1[3]);
                        *(u32x4*)(XBC + (size_t)(row0 + ai * 128 + m * 16) * 4096 + c0 + bj * 128) = w;
                    }
        } else {
            const int c0 = (pn - 48) * 128 + cl;
            const f32x4 ba0 = *(const f32x4*)(b_gate + c0), ba1 = *(const f32x4*)(b_gate + c0 + 4), bb0 = *(const f32x4*)(b_gate + 2048 + c0), bb1 = *(const f32x4*)(b_gate + 2048 + c0 + 4);
#pragma unroll
            for (int ai = 0; ai < 2; ++ai)
#pragma unroll
                for (int m = 0; m < 4; ++m) {
                    const f32x4 a0 = acc[ai][0][m][0] + ba0, a1 = acc[ai][0][m][1] + ba1, b0 = acc[ai][1][m][0] + bb0, b1 = acc[ai][1][m][1] + bb1;
                    float ea[8], eb[8], rr[8], gb[8];
#pragma unroll
                    for (int j = 0; j < 4; ++j) { ea[j] = 1.0f + __expf(-a0[j]); ea[4 + j] = 1.0f + __expf(-a1[j]); eb[j] = 1.0f + __expf(-b0[j]); eb[4 + j] = 1.0f + __expf(-b1[j]); }
#pragma unroll
                    for (int j = 0; j < 8; ++j) { rr[j] = eb[j] * __builtin_amdgcn_rcpf(ea[j]); gb[j] = 1.0f * __builtin_amdgcn_rcpf(eb[j]); }
                    u32x4 wr_, wg_;
                    wr_.x = cvt_pk_bf16(rr[0], rr[1]); wr_.y = cvt_pk_bf16(rr[2], rr[3]); wr_.z = cvt_pk_bf16(rr[4], rr[5]); wr_.w = cvt_pk_bf16(rr[6], rr[7]);
                    wg_.x = cvt_pk_bf16(gb[0], gb[1]); wg_.y = cvt_pk_bf16(gb[2], gb[3]); wg_.z = cvt_pk_bf16(gb[4], gb[5]); wg_.w = cvt_pk_bf16(gb[6], gb[7]);
                    const size_t o = (size_t)(row0 + ai * 128 + m * 16) * 2048 + c0;
                    *(u32x4*)(R + o) = wr_; *(u32x4*)(GB + o) = wg_;
                }
        }
    }
};
__device__ __forceinline__ void merge_store(const bf16_t* __restrict__ GB, bf16_t* __restrict__ merged, const f32x4 (&acc)[2][2][4][2], int row0, int col0) {
#pragma unroll
    for (int ai = 0; ai < 2; ++ai) {
        u32x4 gv[4][2];
#pragma unroll
        for (int m = 0; m < 4; ++m)
#pragma unroll
            for (int bj = 0; bj < 2; ++bj) gv[m][bj] = *(const u32x4*)(GB + (size_t)(row0 + ai * 128 + m * 16) * 2048 + col0 + bj * 128);
#pragma unroll
        for (int m = 0; m < 4; ++m)
#pragma unroll
            for (int bj = 0; bj < 2; ++bj) { const u32x4 g = gv[m][bj]; const f32x4 v0 = acc[ai][bj][m][0], v1 = acc[ai][bj][m][1];
                u32x4 w; w.x = cvt_pk_bf16(v0[0] * bflo(g.x), v0[1] * bfhi(g.x)); w.y = cvt_pk_bf16(v0[2] * bflo(g.y), v0[3] * bfhi(g.y));
                w.z = cvt_pk_bf16(v1[0] * bflo(g.z), v1[1] * bfhi(g.z)); w.w = cvt_pk_bf16(v1[2] * bflo(g.w), v1[3] * bfhi(g.w));
                *(u32x4*)(merged + (size_t)(row0 + ai * 128 + m * 16) * 2048 + col0 + bj * 128) = w; }
    }
}
struct EpiMerge {
    static constexpr bool PERM = true, AFTER_DRAIN = false;
    const bf16_t* R; const bf16_t* GB; bf16_t* merged;
    __device__ __forceinline__ bool keep(const pg8::Unit& u) const { return u.kh == 0; }
    __device__ __forceinline__ void operator()(f32x4 (&acc)[2][2][4][2], const pg8::Unit& u, int wr, int wc, int fr, int fq) const {
        const int row0 = u.pm * 256 + wr * 64 + fr, col0 = u.pn * 256 + wc * 32 + 8 * fq;
        if (u.kh == 0) {
#pragma unroll
            for (int ai = 0; ai < 2; ++ai) {
                u32x4 rv[4][2];
#pragma unroll
                for (int m = 0; m < 4; ++m)
#pragma unroll
                    for (int bj = 0; bj < 2; ++bj) rv[m][bj] = *(const u32x4*)(R + (size_t)(row0 + ai * 128 + m * 16) * 2048 + col0 + bj * 128);
#pragma unroll
                for (int m = 0; m < 4; ++m)
#pragma unroll
                    for (int bj = 0; bj < 2; ++bj) { const u32x4 g = rv[m][bj];
                        f32x4 v0 = acc[ai][bj][m][0], v1 = acc[ai][bj][m][1];
                        v0[0] *= bflo(g.x); v0[1] *= bfhi(g.x); v0[2] *= bflo(g.y); v0[3] *= bfhi(g.y); v1[0] *= bflo(g.z); v1[1] *= bfhi(g.z); v1[2] *= bflo(g.w); v1[3] *= bfhi(g.w);
                        acc[ai][bj][m][0] = v0; acc[ai][bj][m][1] = v1; }
            }
        } else merge_store(GB, merged, acc, row0, col0);
    }
};
struct SplitKOrder : pg8::StaticOrder {
    __device__ bool next(int i, pg8::Unit& u) const { const bool ok = pg8::StaticOrder::next(i >> 1, u); u.kh = i & 1; return ok; }
};
__device__ __forceinline__ void out_store(const float* __restrict__ x, float* __restrict__ out, float* __restrict__ ssq, const f32x4 (&acc)[2][2][4][2], int row0, int col0, int fq) {
    f32x4 xv[2][4];
#pragma unroll
    for (int bj = 0; bj < 2; ++bj)
#pragma unroll
        for (int n = 0; n < 2; ++n) xv[0][bj * 2 + n] = *(const f32x4*)(x + (size_t)row0 * 2048 + col0 + bj * 128 + n * 16);
#pragma unroll
    for (int gi = 0; gi < 8; ++gi) {
        const int ai = gi >> 2, m = gi & 3;
        if (gi < 7) { const int ai2 = (gi + 1) >> 2, m2 = (gi + 1) & 3;
#pragma unroll
            for (int bj = 0; bj < 2; ++bj)
#pragma unroll
                for (int n = 0; n < 2; ++n) xv[(gi + 1) & 1][bj * 2 + n] = *(const f32x4*)(x + (size_t)(row0 + ai2 * 128 + m2 * 16) * 2048 + col0 + bj * 128 + n * 16); }
        const size_t row = (size_t)(row0 + ai * 128 + m * 16); float q = 0.f;
#pragma unroll
        for (int bj = 0; bj < 2; ++bj)
#pragma unroll
            for (int n = 0; n < 2; ++n) { const f32x4 r = xv[gi & 1][bj * 2 + n] + acc[ai][bj][m][n];
                q += (r[0] * r[0] + r[1] * r[1]) + (r[2] * r[2] + r[3] * r[3]);
                *(f32x4*)(out + row * 2048 + col0 + bj * 128 + n * 16) = r; }
        q += __shfl_xor(q, 16); q += __shfl_xor(q, 32);
        if (fq == 0) atomic_addf(ssq + row, q);
    }
}
struct EpiOut {
    static constexpr bool PERM = false, AFTER_DRAIN = false;
    __device__ __forceinline__ bool keep(const pg8::Unit&) const { return false; }
    const float* x; float* out; float* ssq;
    __device__ __forceinline__ void operator()(const f32x4 (&acc)[2][2][4][2], const pg8::Unit& u, int wr, int wc, int fr, int fq) const {
        out_store(x, out, ssq, acc, u.pm * 256 + wr * 64 + fr, u.pn * 256 + wc * 32 + 4 * fq, fq);
    }
};

__device__ __forceinline__ void transpose_item(const float* W, int ldw, int K, int k0, int n0, bf16_t* dst, LAS float* scr, int lane, int kd = -1) {
    if (kd < 0) kd = k0;
#pragma unroll 8
    for (int i = 0; i < 32; ++i) { const int kk = 2 * i + (lane >> 5); scr[kk * 33 + (lane & 31)] = W[(size_t)(k0 + kk) * ldw + n0 + (lane & 31)]; }
    asm volatile("s_waitcnt lgkmcnt(0)" ::: "memory");
    const int c = lane & 7;
#pragma unroll
    for (int j = 0; j < 4; ++j) { const int n = (lane >> 3) + 8 * j; const LAS float* s = scr + (8 * c) * 33 + n;
        u32x4 o; o.x = cvt_pk_bf16(s[0 * 33], s[1 * 33]); o.y = cvt_pk_bf16(s[2 * 33], s[3 * 33]); o.z = cvt_pk_bf16(s[4 * 33], s[5 * 33]); o.w = cvt_pk_bf16(s[6 * 33], s[7 * 33]);
        *(u32x4*)(dst + (size_t)n * K + kd + 8 * c) = o; }
    asm volatile("s_waitcnt lgkmcnt(0)" ::: "memory");
}
__device__ __forceinline__ int proj_row(int n0) {
    if (n0 < 2048) return 256 * (n0 >> 7) + (n0 & 127);
    if (n0 < 4096) return 4096 + (n0 - 2048);
    if (n0 < 6144) { const int ch = n0 - 4096; return 256 * (ch >> 7) + 128 + (ch & 127); }
    if (n0 < 12288) return n0;
    if (n0 < 12320) return -1;
    { const int c = n0 - 12320, n = c >> 11, ch = c & 2047; return 12288 + 256 * (ch >> 7) + 128 * n + (ch & 127); }
}

template <int W>
__device__ __forceinline__ void stage_conv(LAS unsigned char* dst, int stride, const bf16_t* xbc, int tok0, int cidx, int col0, const float* conv_w, const float* conv_b, const LAS float* scale, int tid) {
    constexpr int CG = W / 8, RB = NT / CG, RPT = 128 / RB;
    const int cgi = tid % CG, rb = tid / CG, r0 = rb * RPT, ch0 = col0 + cgi * 8;
    float w[4][8], bias[8], h0[8], h1[8], h2[8];
#pragma unroll
    for (int k = 0; k < 4; ++k) { const f32x4 a = *(const f32x4*)(conv_w + k * 4096 + ch0), b = *(const f32x4*)(conv_w + k * 4096 + ch0 + 4);
#pragma unroll
        for (int j = 0; j < 4; ++j) { w[k][j] = a[j]; w[k][4 + j] = b[j]; } }
    { const f32x4 a = *(const f32x4*)(conv_b + ch0), b = *(const f32x4*)(conv_b + ch0 + 4);
#pragma unroll
      for (int j = 0; j < 4; ++j) { bias[j] = a[j]; bias[4 + j] = b[j]; } }
    const bf16_t* src = xbc + (size_t)tok0 * 4096 + ch0;
#define LD8(r, o) do { if (cidx == 0 && (r) < 0) { _Pragma("unroll") for (int j_ = 0; j_ < 8; ++j_) o[j_] = 0.f; } else { const u32x4 v_ = *(const u32x4*)(src + (ptrdiff_t)(r) * 4096); \
        o[0] = bflo(v_.x); o[1] = bfhi(v_.x); o[2] = bflo(v_.y); o[3] = bfhi(v_.y); o[4] = bflo(v_.z); o[5] = bfhi(v_.z); o[6] = bflo(v_.w); o[7] = bfhi(v_.w); } } while (0)
    LD8(r0 - 3, h0); LD8(r0 - 2, h1); LD8(r0 - 1, h2);
#pragma unroll
    for (int i = 0; i < RPT; ++i) {
        float cur[8], o[8]; LD8(r0 + i, cur);
        float sc = 1.0f; if (scale) sc = scale[(cgi >> 3) * 128 + r0 + i];
#pragma unroll
        for (int j = 0; j < 8; ++j) { float v = bias[j] + w[0][j] * h0[j] + w[1][j] * h1[j] + w[2][j] * h2[j] + w[3][j] * cur[j]; o[j] = silu_f(v) * sc; h0[j] = h1[j]; h1[j] = h2[j]; h2[j] = cur[j]; }
        u32x4 pk; pk.x = cvt_pk_bf16(o[0], o[1]); pk.y = cvt_pk_bf16(o[2], o[3]); pk.z = cvt_pk_bf16(o[4], o[5]); pk.w = cvt_pk_bf16(o[6], o[7]);
        *(LAS u32x4*)(dst + (r0 + i) * stride + cgi * 16) = pk;
    }
}

#undef LD8
__device__ __forceinline__ float chunk_prefix(LAS float* adt, LAS float* ac, const float* DT, const float* a_log, int tok0, int g, int tid) {
    const int k = tid >> 7, l = tid & 127, h = g * 4 + k, lane = tid & 63;
    const float dtv = DT[(size_t)(tok0 + l) * 32 + h];
    const float a = -expf(a_log[h]);
    float s = dtv * a;
#pragma unroll
    for (int o = 1; o < 64; o <<= 1) { const float t = __shfl_up(s, o); if (lane >= o) s += t; }
    if (lane == 63) adt[tid >> 6] = s;
    __syncthreads();
    if (l >= 64) s += adt[(tid >> 6) - 1];
    ac[k * 128 + l] = s;
    __syncthreads();
    return dtv;
}

constexpr int XS_STRIDE = 528, CB_STRIDE = 272;

__device__ __forceinline__ void own_barrier(unsigned* bar, unsigned target) {
    if (threadIdx.x == 0) {
        __hip_atomic_fetch_add(bar, 1u, __ATOMIC_RELAXED, __HIP_MEMORY_SCOPE_AGENT);
        const unsigned long long t0 = __builtin_amdgcn_s_memrealtime();
        while (__hip_atomic_load(bar, __ATOMIC_RELAXED, __HIP_MEMORY_SCOPE_AGENT) < target) {
            __builtin_amdgcn_s_sleep(2);
            if (__builtin_amdgcn_s_memrealtime() - t0 > 200000000ull) break;
        }
    }
    __syncthreads();
}
#define GRID_SYNC() do { asm volatile("s_waitcnt vmcnt(0) lgkmcnt(0)" ::: "memory"); grid.sync(); \
    __builtin_amdgcn_fence(__ATOMIC_ACQUIRE, "agent"); asm volatile("s_waitcnt vmcnt(0)" ::: "memory"); __syncthreads(); STAMP(); } while (0)
#ifdef SPIN_PHASE
#define STAMP() do { if (bx == 0 && tid == 0) { ((unsigned long long*)(BAR + 16))[n_stamp] = __builtin_amdgcn_s_memrealtime(); } ++n_stamp; } while (0)
#else
#define STAMP() do { } while (0)
#endif
__global__ void __launch_bounds__(NT, 2) fwd_megakernel(Args A) {
    extern __shared__ __attribute__((aligned(16))) unsigned char lds_raw[];
    LAS unsigned char* lds = (LAS unsigned char*)lds_raw;
    const unsigned lds_u32 = (unsigned)(size_t)lds_raw;
    cg::grid_group grid = cg::this_grid();
    const int tid = threadIdx.x, lane = tid & 63, wave = __builtin_amdgcn_readfirstlane(tid >> 6), fr = lane & 15, fq = lane >> 4;
    const int G = gridDim.x, bx = blockIdx.x;
    const int gw = bx * NWAVES + wave, NGW = G * NWAVES;
    unsigned char* ws = A.ws;
    bf16_t* WinT = (bf16_t*)A.out; bf16_t* H = (bf16_t*)((unsigned char*)A.out + 64 * MiB);
    float* STATES = A.out;
    bf16_t* WdtT = (bf16_t*)(ws + WS_WDT); bf16_t* WsB = (bf16_t*)(ws + WS_WSB); float* STATS = (float*)(ws + WS_STATS); float* SSQ = (float*)(ws + WS_SSQ);
    float* CD = (float*)(ws + WS_CD); float* DT = (float*)(ws + WS_DT); unsigned* BAR = (unsigned*)(ws + WS_BAR); unsigned bar_epoch = 0; int n_stamp = 0; (void)n_stamp;
    bf16_t* WbT = (bf16_t*)(ws + WS_WB); bf16_t* WoT = (bf16_t*)(ws + WS_WO); bf16_t* YAB = (bf16_t*)(ws + WS_YAB); bf16_t* V = (bf16_t*)(ws + WS_V);
    bf16_t* PREV = (bf16_t*)(ws + WS_V); bf16_t* MERGED = (bf16_t*)(ws + WS_V);
    bf16_t* XBC = (bf16_t*)(ws + WS_XBC); bf16_t* RG = (bf16_t*)(ws + WS_R); bf16_t* GB = (bf16_t*)(ws + WS_GB);

    STAMP();
    if constexpr ((PH_MASK >> 0) & 1)
    {
        LAS float* scr = (LAS float*)(lds + wave * 16384);
        constexpr int I_IN = 32 * (NIN / 32), I_B = 32 * 64, I_O = 32 * 64, NITEMS = I_IN + 2 * I_B + I_O;
        for (int it = gw; it < NITEMS; it += NGW) {
            int r = it;
            if (r < I_IN) { const int kb = r / (NIN / 32), nb = r % (NIN / 32), n0 = 32 * nb; const int pr = proj_row(n0);
                bf16_t* dst = pr >= 0 ? WinT + (size_t)pr * 2048 : WdtT;
                transpose_item(A.w_in, NIN, 2048, 64 * kb, n0, dst, scr, lane); continue; }
            r -= I_IN;
            if (r < 2 * I_B) { const int nbr = r / I_B, rr = r % I_B, kb = rr / 64, nb = rr % 64;
                transpose_item(A.w_branch + (size_t)nbr * 2048 * 2048, 2048, 4096, 64 * kb, 32 * nb, WbT + (size_t)(32 * nb) * 4096, scr, lane, nbr * 2048 + 64 * kb); continue; }
            r -= 2 * I_B;
            { const int kb = r / 64, nb = r % 64; transpose_item(A.w_out, 2048, 2048, 64 * kb, 32 * nb, WoT + (size_t)(32 * nb) * 2048, scr, lane); }
        }
        for (int i = bx * NT + tid; i < 8 * 128 * 128; i += G * NT) { const int t = (i >> 7) & 127, s = i & 127; const float v = (s <= t) ? A.w_sp[i] : 0.f; WsB[i] = (bf16_t)(cvt_pk_bf16(v, 0.f) & 0xffffu); }
        for (int i = bx * NT + tid; i < 2 * M_TOK; i += G * NT) STATS[i] = 0.f;
        for (int i = bx * NT + tid; i < M_TOK; i += G * NT) SSQ[i] = 0.f;
        for (int m = gw; m < M_TOK; m += NGW) {
            const f32x4* xr = (const f32x4*)(A.x + (size_t)m * DM) + lane; const f32x4* wr4 = (const f32x4*)A.norm_w + lane;
            f32x4 v[8]; float s = 0.f;
#pragma unroll
            for (int j = 0; j < 8; ++j) { v[j] = xr[64 * j]; s += (v[j][0] * v[j][0] + v[j][1] * v[j][1]) + (v[j][2] * v[j][2] + v[j][3] * v[j][3]); }
            const float rstd = 1.0f / sqrtf(wave_sum(s) * (1.0f / DM) + EPS);
            u32x2* o8 = (u32x2*)(H + (size_t)m * DM) + lane;
#pragma unroll
            for (int j = 0; j < 8; ++j) { const f32x4 w4 = wr4[64 * j]; u32x2 o; o.x = cvt_pk_bf16(v[j][0] * rstd * w4[0], v[j][1] * rstd * w4[1]); o.y = cvt_pk_bf16(v[j][2] * rstd * w4[2], v[j][3] * rstd * w4[3]); o8[64 * j] = o; }
        }
    }
    GRID_SYNC();

    if constexpr ((PH_MASK >> 1) & 1)
    {
        pg8::Gemm g{H, WinT, M_TOK, NPROJ, DM, DM}; pg8::StaticOrder S; S.init(M_TOK, NPROJ, G, bx);
        EpiProj E{YAB, V, XBC, RG, GB, STATS, A.b_gate};
        pg8::gemm_phase<EpiProj, pg8::StaticOrder, true, true>(lds, g, S, E);
        for (int t = gw; t < M_TOK / 16; t += NGW) {
            f32x4 acc0 = {0.f, 0.f, 0.f, 0.f}, acc1 = {0.f, 0.f, 0.f, 0.f};
            const bf16_t* ap = H + (size_t)(16 * t + fr) * DM + 8 * fq; const bf16_t* b0p = WdtT + (size_t)fr * DM + 8 * fq; const bf16_t* b1p = WdtT + (size_t)(16 + fr) * DM + 8 * fq;
#pragma unroll 4
            for (int ks = 0; ks < 64; ++ks) {
                const bf16x8 fa = *(const bf16x8*)(ap + 32 * ks), fb0 = *(const bf16x8*)(b0p + 32 * ks), fb1 = *(const bf16x8*)(b1p + 32 * ks);
                acc0 = __builtin_amdgcn_mfma_f32_16x16x32_bf16(fb0, fa, acc0, 0, 0, 0);
                acc1 = __builtin_amdgcn_mfma_f32_16x16x32_bf16(fb1, fa, acc1, 0, 0, 0);
            }
            const f32x4 bb0 = *(const f32x4*)(A.dt_bias + 4 * fq), bb1 = *(const f32x4*)(A.dt_bias + 16 + 4 * fq);
            f32x4 o0, o1;
#pragma unroll
            for (int j = 0; j < 4; ++j) { const float v0 = acc0[j] + bb0[j], v1 = acc1[j] + bb1[j];
                o0[j] = fmaxf(v0, 0.f) + log1pf(expf(-fabsf(v0))); o1[j] = fmaxf(v1, 0.f) + log1pf(expf(-fabsf(v1))); }
            float* dp = DT + (size_t)(16 * t + fr) * 32 + 4 * fq;
            *(f32x4*)dp = o0; *(f32x4*)(dp + 16) = o1;
        }
    }
    GRID_SYNC();

    if constexpr ((PH_MASK >> 2) & 1)
    for (int j = bx; j < 2048; j += G) {
        const int jj = j & 1023, g = jj & 7, bc = jj >> 3, tok0 = bc * 128, cidx = bc & 31;
        int tid = threadIdx.x; asm volatile("" : "+v"(tid));
        const int lane = tid & 63, fr = lane & 15, fq = lane >> 4;
        if (j < 1024) {
            {
                const int cgi = tid & 31, rb = tid >> 5, d0 = g * 256 + cgi * 8;
                const f32x4 lw0 = *(const f32x4*)(A.ln_w + d0), lw1 = *(const f32x4*)(A.ln_w + d0 + 4), lb0 = *(const f32x4*)(A.ln_b + d0), lb1 = *(const f32x4*)(A.ln_b + d0 + 4);
#pragma unroll
                for (int i = 0; i < 8; ++i) {
                    const int r = rb * 8 + i, tok = tok0 + r;
                    const float mean = STATS[2 * tok] * (1.0f / 2048.0f), var = STATS[2 * tok + 1] * (1.0f / 2048.0f) - mean * mean, rstd = 1.0f / sqrtf(fmaxf(var, 0.f) + EPS);
                    const u32x4 v = *(const u32x4*)(V + (size_t)tok * 2048 + d0);
                    u32x4 pk;
                    pk.x = cvt_pk_bf16((bflo(v.x) - mean) * rstd * lw0[0] + lb0[0], (bfhi(v.x) - mean) * rstd * lw0[1] + lb0[1]);
                    pk.y = cvt_pk_bf16((bflo(v.y) - mean) * rstd * lw0[2] + lb0[2], (bfhi(v.y) - mean) * rstd * lw0[3] + lb0[3]);
                    pk.z = cvt_pk_bf16((bflo(v.z) - mean) * rstd * lw1[0] + lb1[0], (bfhi(v.z) - mean) * rstd * lw1[1] + lb1[1]);
                    pk.w = cvt_pk_bf16((bflo(v.w) - mean) * rstd * lw1[2] + lb1[2], (bfhi(v.w) - mean) * rstd * lw1[3] + lb1[3]);
                    *(LAS u32x4*)(lds + r * XS_STRIDE + cgi * 16) = pk;
                }
            }
            __syncthreads();
            f32x4 acc[8][2];
#pragma unroll
            for (int mt = 0; mt < 8; ++mt) { acc[mt][0] = (f32x4){0.f, 0.f, 0.f, 0.f}; acc[mt][1] = (f32x4){0.f, 0.f, 0.f, 0.f}; }
            const bf16_t* wp = WsB + (size_t)g * 16384 + fr * 128 + 8 * fq;
            const unsigned tra = lds_u32 + (8 * fq + (fr >> 2)) * XS_STRIDE + (32 * wave + 4 * (lane & 3)) * 2;
#pragma unroll
            for (int ks = 0; ks < 4; ++ks) {
                bf16x8 fn0, fn1; tr_frag2<4 * XS_STRIDE, 32>(tra + 32 * ks * XS_STRIDE, fn0, fn1);
#pragma unroll
                for (int mt = 2 * ks; mt < 8; ++mt) {
                    const bf16x8 fm = *(const bf16x8*)(wp + mt * 16 * 128 + 32 * ks);
                    acc[mt][0] = __builtin_amdgcn_mfma_f32_16x16x32_bf16(fn0, fm, acc[mt][0], 0, 0, 0);
                    acc[mt][1] = __builtin_amdgcn_mfma_f32_16x16x32_bf16(fn1, fm, acc[mt][1], 0, 0, 0);
                }
            }
            {
                bf16_t* p0 = YAB + (size_t)(tok0 + fr) * 4096 + g * 256 + 32 * wave + 4 * fq;
                u32x2 sv[8][2]; float bs[8];
#pragma unroll
                for (int mt = 0; mt < 8; ++mt) { bs[mt] = A.b_sp[g * 128 + 16 * mt + fr];
#pragma unroll
                    for (int nt = 0; nt < 2; ++nt) sv[mt][nt] = *(const u32x2*)(p0 + (size_t)(16 * mt) * 4096 + 16 * nt); }
#pragma unroll
                for (int mt = 0; mt < 8; ++mt)
#pragma unroll
                    for (int nt = 0; nt < 2; ++nt) { const f32x4 a = acc[mt][nt]; const u32x2 s2 = sv[mt][nt]; const float b = bs[mt];
                        u32x2 o; o.x = cvt_pk_bf16(bflo(s2.x) * (a[0] + b), bfhi(s2.x) * (a[1] + b)); o.y = cvt_pk_bf16(bflo(s2.y) * (a[2] + b), bfhi(s2.y) * (a[3] + b));
                        *(u32x2*)(p0 + (size_t)(16 * mt) * 4096 + 16 * nt) = o; }
            }
            __syncthreads();
        } else {
            LAS float* adt = (LAS float*)(lds + 102400); LAS float* ac = adt + 512; LAS float* wg = ac + 512;
            const float dtv = chunk_prefix(adt, ac, DT, A.a_log, tok0, g, tid);
            { const int k = tid >> 7, l = tid & 127; const float aend = ac[k * 128 + 127]; wg[k * 128 + l] = expf(aend - ac[k * 128 + l]) * dtv; if (l == 127) CD[bc * 32 + g * 4 + k] = expf(aend); }
            __syncthreads();
            stage_conv<256>(lds, XS_STRIDE, XBC, tok0, cidx, g * 256, A.conv_w, A.conv_b, wg, tid);
            asm volatile("" ::: "memory"); __builtin_amdgcn_sched_barrier(0);
            stage_conv<128>(lds + 67584, CB_STRIDE, XBC, tok0, cidx, 2048 + g * 128, A.conv_w, A.conv_b, nullptr, tid);
            __syncthreads();
            const int k = wave >> 1, ph = wave & 1;
            f32x4 acc[2][8];
#pragma unroll
            for (int mt = 0; mt < 2; ++mt)
#pragma unroll
                for (int nt = 0; nt < 8; ++nt) acc[mt][nt] = (f32x4){0.f, 0.f, 0.f, 0.f};
            const unsigned xa = lds_u32 + (8 * fq + (fr >> 2)) * XS_STRIDE + (k * 64 + 32 * ph + 4 * (lane & 3)) * 2;
            const unsigned ba = lds_u32 + 67584 + (8 * fq + (fr >> 2)) * CB_STRIDE + (4 * (lane & 3)) * 2;
#pragma unroll
            for (int ks = 0; ks < 4; ++ks) {
                bf16x8 fm0, fm1; tr_frag2<4 * XS_STRIDE, 32>(xa + 32 * ks * XS_STRIDE, fm0, fm1);
#pragma unroll
                for (int nq = 0; nq < 2; ++nq) {
                    bf16x8 fn[4]; tr_frag4<4 * CB_STRIDE, 32>(ba + 32 * ks * CB_STRIDE + 128 * nq, fn[0], fn[1], fn[2], fn[3]);
#pragma unroll
                    for (int i = 0; i < 4; ++i) {
                        acc[0][4 * nq + i] = __builtin_amdgcn_mfma_f32_16x16x32_bf16(fn[i], fm0, acc[0][4 * nq + i], 0, 0, 0);
                        acc[1][4 * nq + i] = __builtin_amdgcn_mfma_f32_16x16x32_bf16(fn[i], fm1, acc[1][4 * nq + i], 0, 0, 0);
                    }
                }
            }
            float* sp = STATES + ((size_t)(bc * 32 + g * 4 + k) * 64 + 32 * ph + fr) * 128 + 4 * fq;
#pragma unroll
            for (int mt = 0; mt < 2; ++mt)
#pragma unroll
                for (int nt = 0; nt < 8; ++nt) *(f32x4*)(sp + mt * 16 * 128 + 16 * nt) = acc[mt][nt];
            __syncthreads();
        }
    }
    GRID_SYNC();

    if constexpr ((PH_MASK >> 3) & 1)
    for (int e4 = bx * NT + tid; e4 < 4 * 65536; e4 += G * NT) {
        const int b = e4 >> 16, o4 = e4 & 65535, h = o4 >> 11;
        const float* sp = STATES + (size_t)(b * 32) * 262144 + (size_t)o4 * 4; bf16_t* pp = PREV + (size_t)(b * 32) * 262144 + (size_t)o4 * 4;
        f32x4 sv[32]; float cdv[32];
#pragma unroll
        for (int c = 0; c < 32; ++c) { sv[c] = *(const f32x4*)(sp + (size_t)c * 262144); cdv[c] = CD[(b * 32 + c) * 32 + h]; }
        f32x4 hs = {0.f, 0.f, 0.f, 0.f};
#pragma unroll
        for (int c = 0; c < 32; ++c) {
            u32x2 o; o.x = cvt_pk_bf16(hs[0], hs[1]); o.y = cvt_pk_bf16(hs[2], hs[3]); *(u32x2*)(pp + (size_t)c * 262144) = o;
            hs = hs * cdv[c] + sv[c];
        }
    }
    GRID_SYNC();

    if constexpr ((PH_MASK >> 4) & 1)
    for (int j = bx; j < 1024; j += G) {
        const int g = j & 7, bc = j >> 3, tok0 = bc * 128, cidx = bc & 31;
        int tid = threadIdx.x; asm volatile("" : "+v"(tid));
        const int lane = tid & 63, fr = lane & 15, fq = lane >> 4;
        LAS float* ac = (LAS float*)(lds + 137216); LAS float* dtl = ac + 512; LAS float* adt = dtl + 512;
        { const float dtv = chunk_prefix(adt, ac, DT, A.a_log, tok0, g, tid); dtl[tid] = dtv; }
        stage_conv<128>(lds, CB_STRIDE, XBC, tok0, cidx, 3072 + g * 128, A.conv_w, A.conv_b, nullptr, tid);
        asm volatile("" ::: "memory"); __builtin_amdgcn_sched_barrier(0);
        stage_conv<128>(lds + 34816, CB_STRIDE, XBC, tok0, cidx, 2048 + g * 128, A.conv_w, A.conv_b, nullptr, tid);
        asm volatile("" ::: "memory"); __builtin_amdgcn_sched_barrier(0);
        stage_conv<256>(lds + 69632, XS_STRIDE, XBC, tok0, cidx, g * 256, A.conv_w, A.conv_b, nullptr, tid);
        __syncthreads();
        const int l = 16 * wave + fr;
        f32x4 cb[8];
        {
        bf16x8 fc[4];
#pragma unroll
        for (int ks = 0; ks < 4; ++ks) fc[ks] = *(const LAS bf16x8*)(lds + l * CB_STRIDE + (32 * ks + 8 * fq) * 2);
#pragma unroll
        for (int nt = 0; nt < 8; ++nt) {
            cb[nt] = (f32x4){0.f, 0.f, 0.f, 0.f};
            if (nt <= wave) {
#pragma unroll
                for (int ks = 0; ks < 4; ++ks) { const bf16x8 fb = *(const LAS bf16x8*)(lds + 34816 + (16 * nt + fr) * CB_STRIDE + (32 * ks + 8 * fq) * 2);
                    cb[nt] = __builtin_amdgcn_mfma_f32_16x16x32_bf16(fb, fc[ks], cb[nt], 0, 0, 0); }
            }
        }
        }
        __syncthreads();
        LAS unsigned char* sw = lds + 34816 + wave * (16 * CB_STRIDE);
        f32x4 y[4][4];
        float ss = 0.f;
        bf16_t* zp = YAB + (size_t)(tok0 + l) * 4096 + 2048 + g * 256 + 4 * fq;
#pragma unroll 1
        for (int k = 0; k < 4; ++k) {
            const int h = g * 4 + k; const float al = ac[k * 128 + l], dsk = A.d_skip[h];
#pragma unroll
            for (int nt = 0; nt < 8; ++nt) {
                float sv[4];
#pragma unroll
                for (int r = 0; r < 4; ++r) { const int s = 16 * nt + 4 * fq + r;
                    float v = (s <= l) ? cb[nt][r] * __expf(al - ac[k * 128 + s]) * dtl[k * 128 + s] : 0.f;
                    if (s == l) v += dsk; sv[r] = v; }
                u32x2 o; o.x = cvt_pk_bf16(sv[0], sv[1]); o.y = cvt_pk_bf16(sv[2], sv[3]);
                *(LAS u32x2*)(sw + fr * CB_STRIDE + (16 * nt + 4 * fq) * 2) = o;
            }
            asm volatile("s_waitcnt lgkmcnt(0)" ::: "memory");
            f32x4 ay[4], ao[4];
#pragma unroll
            for (int pt = 0; pt < 4; ++pt) { ay[pt] = (f32x4){0.f, 0.f, 0.f, 0.f}; ao[pt] = (f32x4){0.f, 0.f, 0.f, 0.f}; }
            const unsigned xa = lds_u32 + 69632 + (8 * fq + (fr >> 2)) * XS_STRIDE + (k * 64 + 4 * (lane & 3)) * 2;
#pragma unroll
            for (int ks = 0; ks < 4; ++ks) {
                if (ks <= (wave >> 1)) {
                    const bf16x8 fs = *(const LAS bf16x8*)(sw + fr * CB_STRIDE + (32 * ks + 8 * fq) * 2);
                    bf16x8 fx[4]; tr_frag4<4 * XS_STRIDE, 32>(xa + 32 * ks * XS_STRIDE, fx[0], fx[1], fx[2], fx[3]);
#pragma unroll
                    for (int pt = 0; pt < 4; ++pt) ay[pt] = __builtin_amdgcn_mfma_f32_16x16x32_bf16(fx[pt], fs, ay[pt], 0, 0, 0);
                }
            }
            const bf16_t* pp = PREV + ((size_t)(bc * 32 + h) * 64 + fr) * 128 + 8 * fq;
#pragma unroll
            for (int ks = 0; ks < 4; ++ks) {
                const bf16x8 fck = *(const LAS bf16x8*)(lds + l * CB_STRIDE + (32 * ks + 8 * fq) * 2);
#pragma unroll
                for (int pt = 0; pt < 4; ++pt) { const bf16x8 fp = *(const bf16x8*)(pp + pt * 16 * 128 + 32 * ks);
                    ao[pt] = __builtin_amdgcn_mfma_f32_16x16x32_bf16(fp, fck, ao[pt], 0, 0, 0); }
                if (ks & 1) asm volatile("" ::: "memory");
            }
            const float ea = __expf(al);
#pragma unroll
            for (int pt = 0; pt < 4; ++pt) { const u32x2 zv = *(const u32x2*)(zp + k * 64 + pt * 16);
                f32x4 v = ay[pt] + ao[pt] * ea; v[0] *= bflo(zv.x); v[1] *= bfhi(zv.x); v[2] *= bflo(zv.y); v[3] *= bfhi(zv.y);
                ss += (v[0] * v[0] + v[1] * v[1]) + (v[2] * v[2] + v[3] * v[3]); ay[pt] = v; }
            if (k == 0) {
#pragma unroll
                for (int pt = 0; pt < 4; ++pt) y[0][pt] = ay[pt];
            } else if (k == 1) {
#pragma unroll
                for (int pt = 0; pt < 4; ++pt) y[1][pt] = ay[pt];
            } else if (k == 2) {
#pragma unroll
                for (int pt = 0; pt < 4; ++pt) y[2][pt] = ay[pt];
            } else {
#pragma unroll
                for (int pt = 0; pt < 4; ++pt) y[3][pt] = ay[pt];
            }
            asm volatile("s_waitcnt lgkmcnt(0)" ::: "memory");
        }
        ss += __shfl_xor(ss, 16); ss += __shfl_xor(ss, 32);
        const float rstd = 1.0f / sqrtf(ss * (1.0f / 256.0f) + EPS);
        const float* nw = A.ssm_nw + g * 256 + 4 * fq;
#pragma unroll
        for (int k = 0; k < 4; ++k)
#pragma unroll
            for (int pt = 0; pt < 4; ++pt) { const f32x4 w4 = *(const f32x4*)(nw + k * 64 + pt * 16); const f32x4 v = y[k][pt];
                u32x2 o; o.x = cvt_pk_bf16(v[0] * rstd * w4[0], v[1] * rstd * w4[1]); o.y = cvt_pk_bf16(v[2] * rstd * w4[2], v[3] * rstd * w4[3]);
                *(u32x2*)(zp + k * 64 + pt * 16) = o; }
        __syncthreads();
    }
    GRID_SYNC();

    if constexpr ((PH_MASK >> 5) & 1)
    {
        pg8::Gemm g{YAB, WbT, M_TOK, DM, DM, 2 * DM}; SplitKOrder S; S.init(M_TOK, DM, G, bx);
        EpiMerge E{RG, GB, MERGED};
        pg8::gemm_phase<EpiMerge, SplitKOrder, true, true>(lds, g, S, E);
    }
    GRID_SYNC();

    if constexpr ((PH_MASK >> 6) & 1)
    {
        pg8::Gemm g{MERGED, WoT, M_TOK, DM, DM, DM}; pg8::StaticOrder S; S.init(M_TOK, DM, G, bx);
        EpiOut E{A.x, A.out, SSQ};
        pg8::gemm_phase<EpiOut, pg8::StaticOrder, true, true>(lds, g, S, E);
    }
    GRID_SYNC();

    if constexpr ((PH_MASK >> 7) & 1)
    for (int m = gw; m < M_TOK; m += NGW) {
        const float rstd = 1.0f / sqrtf(SSQ[m] * (1.0f / DM) + EPS);
        f32x4* orow = (f32x4*)(A.out + (size_t)m * DM) + lane; const f32x4* wr4 = (const f32x4*)A.fnw + lane;
#pragma unroll
        for (int j = 0; j < 8; ++j) { const f32x4 v = orow[64 * j], w4 = wr4[64 * j]; orow[64 * j] = v * rstd * w4; }
    }
#ifdef SPIN_PHASE
    STAMP();
    if (bx == 0 && tid == 0) {
        const unsigned long long* st = (const unsigned long long*)(BAR + 16);
        const unsigned long long d = (st[SPIN_PHASE + 1] - st[SPIN_PHASE]) * SPIN_MULT, t0 = __builtin_amdgcn_s_memrealtime();
        while (__builtin_amdgcn_s_memrealtime() - t0 < d) __builtin_amdgcn_s_sleep(10);
    }
#endif
}

extern "C" void kernel_launch(void* const* d_in, const int* in_sizes, int n_in, void* d_out, int out_size, void* d_ws, size_t ws_size, hipStream_t stream) {
    static int grid = 0;
    if (grid == 0) {
        if (n_in != 17 || out_size != M_TOK * DM || ws_size < WS_END) { fprintf(stderr, "kernel_launch: unexpected shapes (n_in %d out %d ws %zu)\n", n_in, out_size, ws_size); grid = -1; return; }
        int dev = 0, cus = 0, per_cu = 0;
        hipGetDevice(&dev); hipDeviceGetAttribute(&cus, hipDeviceAttributeMultiprocessorCount, dev);
        if (hipFuncSetAttribute((const void*)fwd_megakernel, hipFuncAttributeMaxDynamicSharedMemorySize, LDS_BYTES) != hipSuccess) { fprintf(stderr, "kernel_launch: hipFuncSetAttribute failed\n"); grid = -1; return; }
        if (hipOccupancyMaxActiveBlocksPerMultiprocessor(&per_cu, (const void*)fwd_megakernel, NT, LDS_BYTES) != hipSuccess || per_cu < 1) { fprintf(stderr, "kernel_launch: occupancy query says %d\n", per_cu); per_cu = 1; }
        (void)hipGetLastError();
        grid = cus * 1;
    }
    if (grid < 0) return;
    Args a{};
    a.x = (const float*)d_in[0]; a.norm_w = (const float*)d_in[1]; a.w_in = (const float*)d_in[2]; a.b_gate = (const float*)d_in[3]; a.ln_w = (const float*)d_in[4]; a.ln_b = (const float*)d_in[5];
    a.w_sp = (const float*)d_in[6]; a.b_sp = (const float*)d_in[7]; a.conv_w = (const float*)d_in[8]; a.conv_b = (const float*)d_in[9]; a.dt_bias = (const float*)d_in[10]; a.a_log = (const float*)d_in[11];
    a.d_skip = (const float*)d_in[12]; a.ssm_nw = (const float*)d_in[13]; a.w_branch = (const float*)d_in[14]; a.w_out = (const float*)d_in[15]; a.fnw = (const float*)d_in[16];
    a.out = (float*)d_out; a.ws = (unsigned char*)d_ws;
    if (hipMemsetAsync((char*)d_ws + WS_BAR, 0, 256, stream) != hipSuccess) { fprintf(stderr, "kernel_launch: memset failed\n"); return; }
    void* args[] = {&a};
    hipError_t e = hipLaunchCooperativeKernel((const void*)fwd_megakernel, dim3(grid), dim3(NT), args, LDS_BYTES, stream);
    if (e != hipSuccess) fprintf(stderr, "cooperative launch failed: %s (grid %d)\n", hipGetErrorString(e), grid);
}
```

```cpp
#include <hip/hip_runtime.h>
#include <hip/hip_cooperative_groups.h>
#include <cstdio>
#include <cstdint>
namespace cg = cooperative_groups;
namespace pg8 {
#define PG8_LAS __attribute__((address_space(3)))
typedef unsigned short bf16_t;
typedef short bf16x8 __attribute__((ext_vector_type(8)));
typedef float f32x4 __attribute__((ext_vector_type(4)));
typedef unsigned u32x4 __attribute__((ext_vector_type(4)));
constexpr int BM = 256, BK = 64, HALF = 128, HTB = HALF * BK * 2  , STAGE_BYTES = 8 * HTB, NXCD = 8, WGM = 8;

__host__ __device__ __forceinline__ int lds_byte(int r, int c) { const int st = (r >> 4) * 2 + (c >> 5), rr = r & 15, cc = c & 31, ob = rr * 64 + cc * 2; return st * 1024 + (ob ^ (((ob >> 9) & 1) << 5)); }
__host__ __device__ __forceinline__ void stage_rc(int b, int& R, int& C) { const int st = b / 1024, sb = b % 1024, swz = sb ^ (((sb >> 9) & 1) << 5); R = (st >> 1) * 16 + swz / 64; C = (st & 1) * 32 + (swz % 64) / 2; }
__host__ __device__ __forceinline__ int perm32(int rho) { const int n = rho >> 4, i = rho & 15; return 8 * (i >> 2) + 4 * n + (i & 3); }

struct Unit { int pm, pn, kh; };
struct Gemm { const bf16_t* A; const bf16_t* Bt; int M, N, K, ld; };

struct StaticOrder {
    int nM, nN, nwg, G, c, wgm;
    __host__ __device__ void init(int M, int N, int G_, int c_, int wgm_ = WGM) { nM = M / BM; nN = N / BM; nwg = nM * nN; G = G_; c = c_; wgm = wgm_; }
    __host__ __device__ bool next(int i, Unit& u) const {
        const long L = (long)i * G + c; if (L >= nwg) return false;
        int wgid = (int)L; { const int q = nwg / NXCD, r = nwg % NXCD, xcd = wgid % NXCD, off = wgid / NXCD; wgid = (xcd < r ? xcd * (q + 1) : r * (q + 1) + (xcd - r) * q) + off; }
        const int nig = wgm * nN, gid = wgid / nig, fm = gid * wgm, gsz = (nM - fm) < wgm ? (nM - fm) : wgm;
        u.pm = fm + ((wgid % nig) % gsz); u.pn = (wgid % nig) / gsz; u.kh = 0; return true;
    }
    __device__ __forceinline__ void a_ready(const Unit&) const {}
    __device__ __forceinline__ void done(const Unit&) const {}
};
typedef float f32x2_t_ __attribute__((ext_vector_type(2)));
typedef __bf16 bf16x2_t_ __attribute__((ext_vector_type(2)));
__device__ __forceinline__ unsigned cvt_pk_bf16(float lo, float hi) { const f32x2_t_ v = {lo, hi}; const bf16x2_t_ b = __builtin_convertvector(v, bf16x2_t_); return __builtin_bit_cast(unsigned, b); }
template <class Epi, class Sched, bool ALIGN_EPI = false, bool SP2 = false>
__device__ __forceinline__ void gemm_phase(PG8_LAS unsigned char* lds, const Gemm g, const Sched& S, const Epi& E) {
    int tid_ = threadIdx.x; asm volatile("" : "+v"(tid_));
    const int tid = tid_, wid = __builtin_amdgcn_readfirstlane(tid >> 6), lane = tid & 63, wr = wid >> 2, wc = wid & 3, fr = lane & 15, fq = lane >> 4;
    const int K = g.K, nt = K / BK, ld = g.ld;
    unsigned voffA[2], voffB[2];
#pragma unroll
    for (int i = 0; i < 2; ++i) { int R, C; stage_rc(tid * 16 + i * 8192, R, C); const int Rb = Epi::PERM ? ((R & ~31) + perm32(R & 31)) : R;
        voffA[i] = (unsigned)(R * ld + C) * 2u; voffB[i] = (unsigned)(Rb * ld + C) * 2u; }
    const size_t kstep = (size_t)(BK * 2);
    const size_t hstep = (size_t)HALF * ld * 2;
    const size_t tstep = 2 * hstep;
    const unsigned ldsw = (unsigned)wid * 1024u;
    const int aoff = lds_byte(wr * 64 + fr, fq * 8), boff = lds_byte(wc * 32 + fr, fq * 8);
#define PG8_SA(b, h) (((b) * 2 + (h)) * HTB)
#define PG8_SB(b, h) ((4 + (b) * 2 + (h)) * HTB)
#define PG8_STAGE(bufoff, gbase, voff) do { _Pragma("unroll") for (int _i = 0; _i < 2; ++_i) \
        __builtin_amdgcn_global_load_lds((const unsigned*)((const char*)(gbase) + (voff)[_i]), (PG8_LAS unsigned*)(lds + (bufoff) + ldsw + _i * 8192), 16, 0, 0); } while (0)
#define PG8_LDA(dst, b, h) do { _Pragma("unroll") for (int m = 0; m < 4; ++m) _Pragma("unroll") for (int k = 0; k < 2; ++k) dst[m][k] = *(const PG8_LAS bf16x8*)(lds + PG8_SA(b, h) + aoff + m * 2048 + k * 1024); } while (0)
#define PG8_LDB(dst, b, h) do { _Pragma("unroll") for (int n = 0; n < 2; ++n) _Pragma("unroll") for (int k = 0; k < 2; ++k) dst[n][k] = *(const PG8_LAS bf16x8*)(lds + PG8_SB(b, h) + boff + n * 2048 + k * 1024); } while (0)
#define PG8_MMA(ai, bj, At, Bt) do { __builtin_amdgcn_s_setprio(1); _Pragma("unroll") for (int m = 0; m < 4; ++m) _Pragma("unroll") for (int n = 0; n < 2; ++n) _Pragma("unroll") for (int k = 0; k < 2; ++k) \
        acc[ai][bj][m][n] = __builtin_amdgcn_mfma_f32_16x16x32_bf16(Bt[n][k], At[m][k], acc[ai][bj][m][n], 0, 0, 0); __builtin_amdgcn_s_setprio(0); } while (0)
#define PG8_WAIT_V(n) asm volatile("s_waitcnt vmcnt(" #n ")" ::: "memory")
#define PG8_WAIT_L(n) asm volatile("s_waitcnt lgkmcnt(" #n ")" ::: "memory")
#define PG8_BAR __builtin_amdgcn_s_barrier()
#define PG8_SCHED __builtin_amdgcn_sched_barrier(0)
    Unit cur, nxt; int ui = 0;
    if (!S.next(0, cur)) return;
    f32x4 acc[2][2][4][2];
#pragma unroll
    for (int a = 0; a < 2; ++a)
#pragma unroll
        for (int b = 0; b < 2; ++b)
#pragma unroll
            for (int m = 0; m < 4; ++m)
#pragma unroll
                for (int n = 0; n < 2; ++n) acc[a][b][m][n] = (f32x4){0.f, 0.f, 0.f, 0.f};
    bf16x8 At[4][2], B0[2][2], B1[2][2];
    const char* cA = (const char*)g.A + (size_t)cur.pm * tstep + (size_t)cur.kh * K * 2; const char* cB = (const char*)g.Bt + (size_t)cur.pn * tstep + (size_t)cur.kh * K * 2;
    S.a_ready(cur);
    if constexpr (SP2) {
        PG8_STAGE(PG8_SB(0, 0), cB, voffB); PG8_STAGE(PG8_SB(0, 1), cB + hstep, voffB); PG8_STAGE(PG8_SA(0, 0), cA, voffA); PG8_STAGE(PG8_SA(0, 1), cA + hstep, voffA);
        if (wr == 1) PG8_BAR;
        PG8_WAIT_V(2); PG8_BAR;
        PG8_STAGE(PG8_SB(1, 0), cB + kstep, voffB); PG8_STAGE(PG8_SA(1, 0), cA + kstep, voffA); PG8_STAGE(PG8_SB(1, 1), cB + hstep + kstep, voffB);
        PG8_WAIT_V(6); PG8_BAR;
    } else {
        PG8_STAGE(PG8_SB(0, 0), cB, voffB); PG8_STAGE(PG8_SA(0, 0), cA, voffA); PG8_STAGE(PG8_SB(0, 1), cB + hstep, voffB); PG8_STAGE(PG8_SA(0, 1), cA + hstep, voffA);
        if (wr == 1) PG8_BAR;
        PG8_WAIT_V(4); PG8_BAR;
        PG8_STAGE(PG8_SB(1, 0), cB + kstep, voffB); PG8_STAGE(PG8_SA(1, 0), cA + kstep, voffA); PG8_STAGE(PG8_SB(1, 1), cB + hstep + kstep, voffB);
        PG8_WAIT_V(6); PG8_BAR;
    }
    for (;;) {
        const bool has_next = S.next(ui + 1, nxt);
        const char* nA = has_next ? (const char*)g.A + (size_t)nxt.pm * tstep + (size_t)nxt.kh * K * 2 : cA; const char* nB = has_next ? (const char*)g.Bt + (size_t)nxt.pn * tstep + (size_t)nxt.kh * K * 2 : cB;
        for (int t = 0; t < nt; t += 2) {
            const bool last = (t == nt - 2);
            const char* a1 = cA + (size_t)(t + 1) * kstep;
            const char* a2 = last ? nA : cA + (size_t)(t + 2) * kstep; const char* b2 = last ? nB : cB + (size_t)(t + 2) * kstep;
            const char* a3 = a2 + kstep; const char* b3 = b2 + kstep;
            if (last && has_next) S.a_ready(nxt);
            if constexpr (SP2) {
            PG8_LDB(B0, 0, 0); PG8_LDB(B1, 0, 1); PG8_SCHED; PG8_LDA(At, 0, 0); PG8_STAGE(PG8_SA(1, 1), a1 + hstep, voffA);
            PG8_WAIT_V(8); PG8_WAIT_L(0); PG8_BAR; PG8_MMA(0, 0, At, B0); PG8_MMA(0, 1, At, B1); PG8_BAR; PG8_SCHED;
            PG8_LDA(At, 0, 1); PG8_STAGE(PG8_SB(0, 0), b2, voffB); PG8_STAGE(PG8_SB(0, 1), b2 + hstep, voffB); PG8_STAGE(PG8_SA(0, 0), a2, voffA);
            PG8_WAIT_V(8); PG8_WAIT_L(0); PG8_BAR; PG8_MMA(1, 0, At, B0); PG8_MMA(1, 1, At, B1); PG8_BAR; PG8_SCHED;
            PG8_LDB(B0, 1, 0); PG8_LDB(B1, 1, 1); PG8_SCHED; PG8_LDA(At, 1, 0); PG8_STAGE(PG8_SA(0, 1), a2 + hstep, voffA);
            PG8_WAIT_V(8); PG8_WAIT_L(0); PG8_BAR; PG8_MMA(0, 0, At, B0); PG8_MMA(0, 1, At, B1); PG8_BAR; PG8_SCHED;
            PG8_LDA(At, 1, 1); PG8_STAGE(PG8_SB(1, 0), b3, voffB); PG8_STAGE(PG8_SB(1, 1), b3 + hstep, voffB); PG8_STAGE(PG8_SA(1, 0), a3, voffA);
            PG8_WAIT_V(8); PG8_WAIT_L(0); PG8_BAR; PG8_MMA(1, 0, At, B0); PG8_MMA(1, 1, At, B1); PG8_BAR; PG8_SCHED;
            } else {
            PG8_LDB(B0, 0, 0); PG8_SCHED; PG8_LDA(At, 0, 0); PG8_STAGE(PG8_SA(1, 1), a1 + hstep, voffA);
            PG8_WAIT_L(8); PG8_BAR; PG8_WAIT_L(0); PG8_MMA(0, 0, At, B0); PG8_BAR; PG8_SCHED;
            PG8_LDB(B1, 0, 1); PG8_STAGE(PG8_SB(0, 0), b2, voffB);
            PG8_BAR; PG8_WAIT_L(0); PG8_MMA(0, 1, At, B1); PG8_BAR;
            PG8_LDA(At, 0, 1); PG8_STAGE(PG8_SA(0, 0), a2, voffA);
            PG8_BAR; PG8_WAIT_L(0); PG8_MMA(1, 0, At, B0); PG8_BAR; PG8_SCHED;
            PG8_STAGE(PG8_SB(0, 1), b2 + hstep, voffB);
            PG8_WAIT_V(6); PG8_BAR; PG8_MMA(1, 1, At, B1); PG8_BAR;
            PG8_LDB(B0, 1, 0); PG8_SCHED; PG8_LDA(At, 1, 0); PG8_STAGE(PG8_SA(0, 1), a2 + hstep, voffA);
            PG8_WAIT_L(8); PG8_BAR; PG8_WAIT_L(0); PG8_MMA(0, 0, At, B0); PG8_BAR; PG8_SCHED;
            PG8_LDB(B1, 1, 1); PG8_STAGE(PG8_SB(1, 0), b3, voffB);
            PG8_BAR; PG8_WAIT_L(0); PG8_MMA(0, 1, At, B1); PG8_BAR;
            PG8_LDA(At, 1, 1); PG8_STAGE(PG8_SA(1, 0), a3, voffA);
            PG8_BAR; PG8_WAIT_L(0); PG8_MMA(1, 0, At, B0); PG8_BAR; PG8_SCHED;
            PG8_STAGE(PG8_SB(1, 1), b3 + hstep, voffB);
            PG8_WAIT_V(6); PG8_BAR; PG8_MMA(1, 1, At, B1); PG8_BAR;
            }
        }
        if constexpr (ALIGN_EPI) { if (wr == 0) PG8_BAR; }
        if constexpr (!Epi::AFTER_DRAIN) { E(acc, cur, wr, wc, fr, fq); S.done(cur); }
        if (!has_next) break;
        if (!E.keep(cur))
#pragma unroll
        for (int a = 0; a < 2; ++a)
#pragma unroll
            for (int b = 0; b < 2; ++b)
#pragma unroll
                for (int m = 0; m < 4; ++m)
#pragma unroll
                    for (int n = 0; n < 2; ++n) acc[a][b][m][n] = (f32x4){0.f, 0.f, 0.f, 0.f};
        cur = nxt; cA = nA; cB = nB; ++ui;
        if constexpr (ALIGN_EPI) { if (wr == 1) PG8_BAR; }
    }
    PG8_WAIT_V(0);
    if constexpr (!ALIGN_EPI) { if (wr == 0) PG8_BAR; }
    PG8_BAR;
    if constexpr (Epi::AFTER_DRAIN) { E.fused(acc, cur, wr, wc, fr, fq, lds, wid, lane); S.done(cur); }
#undef PG8_SA
#undef PG8_SB
#undef PG8_STAGE
#undef PG8_LDA
#undef PG8_LDB
#undef PG8_MMA
#undef PG8_WAIT_V
#undef PG8_WAIT_L
#undef PG8_BAR
#undef PG8_SCHED
}
}

#define LAS __attribute__((address_space(3)))
using pg8::bf16_t; using pg8::bf16x8; using pg8::f32x4; using pg8::u32x4; using pg8::cvt_pk_bf16;
typedef unsigned u32x2 __attribute__((ext_vector_type(2)));
typedef short s16x4 __attribute__((ext_vector_type(4)));

constexpr int NT = 512, NWAVES = 8;
constexpr int M_TOK = 16384, DM = 2048, SEQ = 4096, NCH = 32, CL_ = 128;
constexpr int NIN = 16416;
constexpr int NPROJ = 16384;
constexpr float EPS = 1e-5f;
constexpr int LDS_BYTES = 147456;
#ifndef WGM_P1
#define WGM_P1 4
#endif
#ifndef WGM_P5
#define WGM_P5 4
#endif
#ifndef WGM_P6
#define WGM_P6 4
#endif
#ifndef PH_MASK
#define PH_MASK 0xFF
#endif

constexpr size_t MiB = 1048576;
constexpr size_t WS_BAR = 3 * MiB + 65536;
constexpr size_t WS_WDT = 0, WS_WSB = 131072, WS_STATS = 393216, WS_SSQ = 524288, WS_CD = 589824, WS_DT = 1 * MiB;
constexpr size_t WS_WB = 4 * MiB, WS_WO = 20 * MiB, WS_YAB = 28 * MiB, WS_V = 156 * MiB, WS_XBC = 220 * MiB, WS_R = 348 * MiB, WS_GB = 412 * MiB, WS_CC = 476 * MiB, WS_END = 508 * MiB;

__device__ __forceinline__ float bf2f(unsigned short u) { return __uint_as_float(((unsigned)u) << 16); }
__device__ __forceinline__ float bflo(unsigned w) { return __uint_as_float(w << 16); }
__device__ __forceinline__ float bfhi(unsigned w) { return __uint_as_float(w & 0xffff0000u); }
__device__ __forceinline__ float silu_f(float v) { return v * __builtin_amdgcn_rcpf(1.0f + __expf(-v)); }
__device__ __forceinline__ float sigmoid_f(float v) { return __builtin_amdgcn_rcpf(1.0f + __expf(-v)); }
__device__ __forceinline__ float wave_sum(float v) {
#pragma unroll
    for (int o = 1; o < 64; o <<= 1) v += __shfl_xor(v, o);
    return v;
}
__device__ __forceinline__ void atomic_addf(float* p, float v) { __hip_atomic_fetch_add(p, v, __ATOMIC_RELAXED, __HIP_MEMORY_SCOPE_AGENT); }

template <int OFF> __device__ __forceinline__ bf16x8 tr_frag(unsigned a) {
    s16x4 lo, hi;
    asm volatile("ds_read_b64_tr_b16 %0, %2\n\tds_read_b64_tr_b16 %1, %2 offset:%3\n\ts_waitcnt lgkmcnt(0)" : "=&v"(lo), "=&v"(hi) : "v"(a), "n"(OFF) : "memory");
    return (bf16x8){lo[0], lo[1], lo[2], lo[3], hi[0], hi[1], hi[2], hi[3]};
}

template <int OFF, int STEP> __device__ __forceinline__ void tr_frag2(unsigned a, bf16x8& f0, bf16x8& f1) {
    s16x4 l0, h0, l1, h1;
    asm volatile("ds_read_b64_tr_b16 %0, %4\n\tds_read_b64_tr_b16 %1, %4 offset:%5\n\tds_read_b64_tr_b16 %2, %4 offset:%6\n\tds_read_b64_tr_b16 %3, %4 offset:%7\n\ts_waitcnt lgkmcnt(0)"
                 : "=&v"(l0), "=&v"(h0), "=&v"(l1), "=&v"(h1) : "v"(a), "n"(OFF), "n"(STEP), "n"(STEP + OFF) : "memory");
    f0 = (bf16x8){l0[0], l0[1], l0[2], l0[3], h0[0], h0[1], h0[2], h0[3]}; f1 = (bf16x8){l1[0], l1[1], l1[2], l1[3], h1[0], h1[1], h1[2], h1[3]};
}
template <int OFF, int STEP> __device__ __forceinline__ void tr_frag4(unsigned a, bf16x8& f0, bf16x8& f1, bf16x8& f2, bf16x8& f3) {
    s16x4 l0, h0, l1, h1, l2, h2, l3, h3;
    asm volatile("ds_read_b64_tr_b16 %0, %8\n\tds_read_b64_tr_b16 %1, %8 offset:%9\n\tds_read_b64_tr_b16 %2, %8 offset:%10\n\tds_read_b64_tr_b16 %3, %8 offset:%11\n\t"
                 "ds_read_b64_tr_b16 %4, %8 offset:%12\n\tds_read_b64_tr_b16 %5, %8 offset:%13\n\tds_read_b64_tr_b16 %6, %8 offset:%14\n\tds_read_b64_tr_b16 %7, %8 offset:%15\n\ts_waitcnt lgkmcnt(0)"
                 : "=&v"(l0), "=&v"(h0), "=&v"(l1), "=&v"(h1), "=&v"(l2), "=&v"(h2), "=&v"(l3), "=&v"(h3)
                 : "v"(a), "n"(OFF), "n"(STEP), "n"(STEP + OFF), "n"(2 * STEP), "n"(2 * STEP + OFF), "n"(3 * STEP), "n"(3 * STEP + OFF) : "memory");
    f0 = (bf16x8){l0[0], l0[1], l0[2], l0[3], h0[0], h0[1], h0[2], h0[3]}; f1 = (bf16x8){l1[0], l1[1], l1[2], l1[3], h1[0], h1[1], h1[2], h1[3]};
    f2 = (bf16x8){l2[0], l2[1], l2[2], l2[3], h2[0], h2[1], h2[2], h2[3]}; f3 = (bf16x8){l3[0], l3[1], l3[2], l3[3], h3[0], h3[1], h3[2], h3[3]};
}

struct Args {
    const float* x; const float* norm_w; const float* w_in; const float* b_gate; const float* ln_w; const float* ln_b; const float* w_sp; const float* b_sp;
    const float* conv_w; const float* conv_b; const float* dt_bias; const float* a_log; const float* d_skip; const float* ssm_nw; const float* w_branch; const float* w_out; const float* fnw;
    float* out; unsigned char* ws;
};

struct EpiProj {
    static constexpr bool PERM = true, AFTER_DRAIN = false;
    __device__ __forceinline__ bool keep(const pg8::Unit&) const { return false; }
    bf16_t* YAB; bf16_t* V; bf16_t* XBC; bf16_t* R; bf16_t* GB; float* stats; const float* b_gate;
    __device__ __forceinline__ void operator()(const f32x4 (&acc)[2][2][4][2], const pg8::Unit& u, int wr, int wc, int fr, int fq) const {
        const int row0 = u.pm * 256 + wr * 64 + fr, pn = u.pn, cl = wc * 32 + 8 * fq;
        if (pn < 16) {
#pragma unroll
            for (int ai = 0; ai < 2; ++ai)
#pragma unroll
                for (int m = 0; m < 4; ++m) {
                    const f32x4 u0 = acc[ai][0][m][0], u1 = acc[ai][0][m][1], z0 = acc[ai][1][m][0], z1 = acc[ai][1][m][1];
                    u32x4 w;
                    w.x = cvt_pk_bf16(silu_f(z0[0]) * u0[0], silu_f(z0[1]) * u0[1]); w.y = cvt_pk_bf16(silu_f(z0[2]) * u0[2], silu_f(z0[3]) * u0[3]);
                    w.z = cvt_pk_bf16(silu_f(z1[0]) * u1[0], silu_f(z1[1]) * u1[1]); w.w = cvt_pk_bf16(silu_f(z1[2]) * u1[2], silu_f(z1[3]) * u1[3]);
                    *(u32x4*)(YAB + (size_t)(row0 + ai * 128 + m * 16) * 4096 + pn * 128 + cl) = w;
                }
        } else if (pn < 24) {
            const int c0 = (pn - 16) * 256 + cl;
#pragma unroll
            for (int ai = 0; ai < 2; ++ai)
#pragma unroll
                for (int m = 0; m < 4; ++m) {
                    const int row = row0 + ai * 128 + m * 16; float s = 0.f, q = 0.f;
#pragma unroll
                    for (int bj = 0; bj < 2; ++bj) {
                        const f32x4 v0 = acc[ai][bj][m][0], v1 = acc[ai][bj][m][1];
                        s += (v0[0] + v0[1]) + (v0[2] + v0[3]) + (v1[0] + v1[1]) + (v1[2] + v1[3]);
                        q += (v0[0] * v0[0] + v0[1] * v0[1]) + (v0[2] * v0[2] + v0[3] * v0[3]) + (v1[0] * v1[0] + v1[1] * v1[1]) + (v1[2] * v1[2] + v1[3] * v1[3]);
                        u32x4 w; w.x = cvt_pk_bf16(v0[0], v0[1]); w.y = cvt_pk_bf16(v0[2], v0[3]); w.z = cvt_pk_bf16(v1[0], v1[1]); w.w = cvt_pk_bf16(v1[2], v1[3]);
                        *(u32x4*)(V + (size_t)row * 2048 + c0 + bj * 128) = w;
                    }
                    s += __shfl_xor(s, 16); s += __shfl_xor(s, 32); q += __shfl_xor(q, 16); q += __shfl_xor(q, 32);
                    if (fq == 0) { atomic_addf(stats + 2 * row, s); atomic_addf(stats + 2 * row + 1, q); }
                }
        } else if (pn < 32) {
            const int c0 = (pn - 24) * 256 + cl;
#pragma unroll
            for (int ai = 0; ai < 2; ++ai)
#pragma unroll
                for (int m = 0; m < 4; ++m)
#pragma unroll
                    for (int bj = 0; bj < 2; ++bj) {
                        const f32x4 v0 = acc[ai][bj][m][0], v1 = acc[ai][bj][m][1];
                        u32x4 w; w.x = cvt_pk_bf16(silu_f(v0[0]), silu_f(v0[1])); w.y = cvt_pk_bf16(silu_f(v0[2]), silu_f(v0[3])); w.z = cvt_pk_bf16(silu_f(v1[0]), silu_f(v1[1])); w.w = cvt_pk_bf16(silu_f(v1[2]), silu_f(v1[3]));
                        *(u32x4*)(YAB + (size_t)(row0 + ai * 128 + m * 16) * 4096 + 2048 + c0 + bj * 128) = w;
                    }
        } else if (pn < 48) {
            const int c0 = (pn - 32) * 256 + cl;
#pragma unroll
            for (int ai = 0; ai < 2; ++ai)
#pragma unroll
                for (int m = 0; m < 4; ++m)
#pragma unroll
                    for (int bj = 0; bj < 2; ++bj) {
                        const f32x4 v0 = acc[ai][bj][m][0], v1 = acc[ai][bj][m][1];
                        u32x4 w; w.x = cvt_pk_bf16(v0[0], v0[1]); w.y = cvt_pk_bf16(v0[2], v0[3]); w.z = cvt_pk_bf16(v1[0], v1[1]); w.w = cvt_pk_bf16(v1[2], v1[3]);
                        *(u32x4*)(XBC + (size_t)(row0 + ai * 128 + m * 16) * 4096 + c0 + bj * 128) = w;
                    }
        } else {
            const int c0 = (pn - 48) * 128 + cl;
            const f32x4 ba0 = *(const f32x4*)(b_gate + c0), ba1 = *(const f32x4*)(b_gate + c0 + 4), bb0 = *(const f32x4*)(b_gate + 2048 + c0), bb1 = *(const f32x4*)(b_gate + 2048 + c0 + 4);
#pragma unroll
            for (int ai = 0; ai < 2; ++ai)
#pragma unroll
                for (int m = 0; m < 4; ++m) {
                    f32x4 a0 = acc[ai][0][m][0] + ba0, a1 = acc[ai][0][m][1] + ba1, b0 = acc[ai][1][m][0] + bb0, b1 = acc[ai][1][m][1] + bb1;
#pragma unroll
                    for (int j = 0; j < 4; ++j) { a0[j] = fminf(fmaxf(a0[j], -30.f), 30.f); a1[j] = fminf(fmaxf(a1[j], -30.f), 30.f); b0[j] = fminf(fmaxf(b0[j], -30.f), 30.f); b1[j] = fminf(fmaxf(b1[j], -30.f), 30.f); }
                    float ea[8], eb[8], rr[8], gb[8];
#pragma unroll
                    for (int j = 0; j < 4; ++j) { ea[j] = 1.0f + __expf(-a0[j]); ea[4 + j] = 1.0f + __expf(-a1[j]); eb[j] = 1.0f + __expf(-b0[j]); eb[4 + j] = 1.0f + __expf(-b1[j]); }
#pragma unroll
                    for (int j = 0; j < 8; ++j) { rr[j] = eb[j] * __builtin_amdgcn_rcpf(ea[j]); gb[j] = 1.0f * __builtin_amdgcn_rcpf(eb[j]); }
                    u32x4 wr_, wg_;
                    wr_.x = cvt_pk_bf16(rr[0], rr[1]); wr_.y = cvt_pk_bf16(rr[2], rr[3]); wr_.z = cvt_pk_bf16(rr[4], rr[5]); wr_.w = cvt_pk_bf16(rr[6], rr[7]);
                    wg_.x = cvt_pk_bf16(gb[0], gb[1]); wg_.y = cvt_pk_bf16(gb[2], gb[3]); wg_.z = cvt_pk_bf16(gb[4], gb[5]); wg_.w = cvt_pk_bf16(gb[6], gb[7]);
                    const size_t o = ((((((size_t)u.pm * 8 + ((pn - 48) >> 1)) * 2 + ((pn - 48) & 1)) * 2 + ai) * 4 + m) * 8 + (wr * 4 + wc)) * 512 + (size_t)(fr + 16 * fq) * 8;
                    *(u32x4*)(R + o) = wr_; *(u32x4*)(GB + o) = wg_;
                }
        }
    }
};
__device__ __forceinline__ void merge_store(const bf16_t* __restrict__ GB, bf16_t* __restrict__ merged, const f32x4 (&acc)[2][2][4][2], int row0, int col0, size_t gbase, int wl) {
#pragma unroll
    for (int ai = 0; ai < 2; ++ai) {
        u32x4 gv[4][2];
#pragma unroll
        for (int m = 0; m < 4; ++m)
#pragma unroll
            for (int bj = 0; bj < 2; ++bj) gv[m][bj] = *(const u32x4*)(GB + ((((gbase * 2 + bj) * 2 + ai) * 4 + m) * 8) * 512 + wl);
#pragma unroll
        for (int m = 0; m < 4; ++m)
#pragma unroll
            for (int bj = 0; bj < 2; ++bj) { const u32x4 g = gv[m][bj]; const f32x4 v0 = acc[ai][bj][m][0], v1 = acc[ai][bj][m][1];
                u32x4 w; w.x = cvt_pk_bf16(v0[0] * bflo(g.x), v0[1] * bfhi(g.x)); w.y = cvt_pk_bf16(v0[2] * bflo(g.y), v0[3] * bfhi(g.y));
                w.z = cvt_pk_bf16(v1[0] * bflo(g.z), v1[1] * bfhi(g.z)); w.w = cvt_pk_bf16(v1[2] * bflo(g.w), v1[3] * bfhi(g.w));
                *(u32x4*)(merged + (size_t)(row0 + ai * 128 + m * 16) * 2048 + col0 + bj * 128) = w; }
    }
}
struct EpiMerge {
    static constexpr bool PERM = true, AFTER_DRAIN = false;
    const bf16_t* R; const bf16_t* GB; bf16_t* merged;
    __device__ __forceinline__ bool keep(const pg8::Unit& u) const { return u.kh == 0; }
    __device__ __forceinline__ void operator()(f32x4 (&acc)[2][2][4][2], const pg8::Unit& u, int wr, int wc, int fr, int fq) const {
        const int row0 = u.pm * 256 + wr * 64 + fr, col0 = u.pn * 256 + wc * 32 + 8 * fq;
        const size_t gbase = (size_t)u.pm * 8 + u.pn; const int wl = (wr * 4 + wc) * 512 + (fr + 16 * fq) * 8;
        if (u.kh == 0) {
#pragma unroll
            for (int ai = 0; ai < 2; ++ai) {
                u32x4 rv[4][2];
#pragma unroll
                for (int m = 0; m < 4; ++m)
#pragma unroll
                    for (int bj = 0; bj < 2; ++bj) rv[m][bj] = *(const u32x4*)(R + ((((gbase * 2 + bj) * 2 + ai) * 4 + m) * 8) * 512 + wl);
#pragma unroll
                for (int m = 0; m < 4; ++m)
#pragma unroll
                    for (int bj = 0; bj < 2; ++bj) { const u32x4 g = rv[m][bj];
                        f32x4 v0 = acc[ai][bj][m][0], v1 = acc[ai][bj][m][1];
                        v0[0] *= bflo(g.x); v0[1] *= bfhi(g.x); v0[2] *= bflo(g.y); v0[3] *= bfhi(g.y); v1[0] *= bflo(g.z); v1[1] *= bfhi(g.z); v1[2] *= bflo(g.w); v1[3] *= bfhi(g.w);
                        acc[ai][bj][m][0] = v0; acc[ai][bj][m][1] = v1; }
            }
        } else merge_store(GB, merged, acc, row0, col0, gbase, wl);
    }
};
struct SplitKOrder : pg8::StaticOrder {
    __device__ bool next(int i, pg8::Unit& u) const { const bool ok = pg8::StaticOrder::next(i >> 1, u); u.kh = i & 1; return ok; }
};
__device__ __forceinline__ void out_store(const float* __restrict__ x, float* __restrict__ out, float* __restrict__ ssq, const f32x4 (&acc)[2][2][4][2], int row0, int col0, int fq) {
    f32x4 xv[2][4];
#pragma unroll
    for (int bj = 0; bj < 2; ++bj)
#pragma unroll
        for (int n = 0; n < 2; ++n) xv[0][bj * 2 + n] = *(const f32x4*)(x + (size_t)row0 * 2048 + col0 + bj * 128 + n * 16);
#pragma unroll
    for (int gi = 0; gi < 8; ++gi) {
        const int ai = gi >> 2, m = gi & 3;
        if (gi < 7) { const int ai2 = (gi + 1) >> 2, m2 = (gi + 1) & 3;
#pragma unroll
            for (int bj = 0; bj < 2; ++bj)
#pragma unroll
                for (int n = 0; n < 2; ++n) xv[(gi + 1) & 1][bj * 2 + n] = *(const f32x4*)(x + (size_t)(row0 + ai2 * 128 + m2 * 16) * 2048 + col0 + bj * 128 + n * 16); }
        const size_t row = (size_t)(row0 + ai * 128 + m * 16); float q = 0.f;
#pragma unroll
        for (int bj = 0; bj < 2; ++bj)
#pragma unroll
            for (int n = 0; n < 2; ++n) { const f32x4 r = xv[gi & 1][bj * 2 + n] + acc[ai][bj][m][n];
                q += (r[0] * r[0] + r[1] * r[1]) + (r[2] * r[2] + r[3] * r[3]);
                *(f32x4*)(out + row * 2048 + col0 + bj * 128 + n * 16) = r; }
        q += __shfl_xor(q, 16); q += __shfl_xor(q, 32);
        if (fq == 0) atomic_addf(ssq + row, q);
    }
}
struct EpiOut {
    static constexpr bool PERM = false, AFTER_DRAIN = false;
    __device__ __forceinline__ bool keep(const pg8::Unit&) const { return false; }
    const float* x; float* out; float* ssq;
    __device__ __forceinline__ void operator()(const f32x4 (&acc)[2][2][4][2], const pg8::Unit& u, int wr, int wc, int fr, int fq) const {
        out_store(x, out, ssq, acc, u.pm * 256 + wr * 64 + fr, u.pn * 256 + wc * 32 + 4 * fq, fq);
    }
};

struct EpiAcc {
    static constexpr bool PERM = true, AFTER_DRAIN = false;
    __device__ __forceinline__ bool keep(const pg8::Unit&) const { return false; }
    bf16_t* O;
    __device__ __forceinline__ void operator()(const f32x4 (&acc)[2][2][4][2], const pg8::Unit& u, int wr, int wc, int fr, int fq) const {
        const int row0 = u.pm * 256 + wr * 64 + fr, col0 = u.pn * 256 + wc * 32 + 8 * fq;
#pragma unroll
        for (int ai = 0; ai < 2; ++ai)
#pragma unroll
            for (int m = 0; m < 4; ++m)
#pragma unroll
                for (int bj = 0; bj < 2; ++bj) {
                    const f32x4 v0 = acc[ai][bj][m][0], v1 = acc[ai][bj][m][1];
                    u32x4 w; w.x = cvt_pk_bf16(v0[0], v0[1]); w.y = cvt_pk_bf16(v0[2], v0[3]); w.z = cvt_pk_bf16(v1[0], v1[1]); w.w = cvt_pk_bf16(v1[2], v1[3]);
                    *(u32x4*)(O + (size_t)(row0 + ai * 128 + m * 16) * 2048 + col0 + bj * 128) = w;
                }
    }
};

__device__ __forceinline__ void transpose_item(const float* W, int ldw, int K, int k0, int n0, bf16_t* dst, LAS float* scr, int lane, int kd = -1) {
    if (kd < 0) kd = k0;
#pragma unroll 8
    for (int i = 0; i < 32; ++i) { const int kk = 2 * i + (lane >> 5); scr[kk * 33 + (lane & 31)] = W[(size_t)(k0 + kk) * ldw + n0 + (lane & 31)]; }
    asm volatile("s_waitcnt lgkmcnt(0)" ::: "memory");
    const int c = lane & 7;
#pragma unroll
    for (int j = 0; j < 4; ++j) { const int n = (lane >> 3) + 8 * j; const LAS float* s = scr + (8 * c) * 33 + n;
        u32x4 o; o.x = cvt_pk_bf16(s[0 * 33], s[1 * 33]); o.y = cvt_pk_bf16(s[2 * 33], s[3 * 33]); o.z = cvt_pk_bf16(s[4 * 33], s[5 * 33]); o.w = cvt_pk_bf16(s[6 * 33], s[7 * 33]);
        *(u32x4*)(dst + (size_t)n * K + kd + 8 * c) = o; }
    asm volatile("s_waitcnt lgkmcnt(0)" ::: "memory");
}
struct TItem { const float* src; bf16_t* dst; int ldw, ldd; };
__device__ __forceinline__ void titem_load(const TItem& t, f32x4 (&v)[16], int lane) {
    const int r4 = lane >> 4, c4 = lane & 15;
#pragma unroll
    for (int i = 0; i < 16; ++i) v[i] = *(const f32x4*)(t.src + (size_t)(4 * i + r4) * t.ldw + 4 * c4);
}
__device__ __forceinline__ void titem_finish(const TItem& t, const f32x4 (&v)[16], LAS float* scr, int lane) {
    const int r4 = lane >> 4, c4 = lane & 15;
#pragma unroll
    for (int i = 0; i < 16; ++i) { LAS float* p = scr + (4 * i + r4) * 65 + 4 * c4; p[0] = v[i][0]; p[1] = v[i][1]; p[2] = v[i][2]; p[3] = v[i][3]; }
    asm volatile("s_waitcnt lgkmcnt(0)" ::: "memory");
    const int c = lane & 7;
#pragma unroll
    for (int i = 0; i < 8; ++i) { const int n = (lane >> 3) + 8 * i; const LAS float* s = scr + (8 * c) * 65 + n;
        u32x4 o; o.x = cvt_pk_bf16(s[0 * 65], s[1 * 65]); o.y = cvt_pk_bf16(s[2 * 65], s[3 * 65]); o.z = cvt_pk_bf16(s[4 * 65], s[5 * 65]); o.w = cvt_pk_bf16(s[6 * 65], s[7 * 65]);
        *(u32x4*)(t.dst + (size_t)n * t.ldd + 8 * c) = o; }
    asm volatile("s_waitcnt lgkmcnt(0)" ::: "memory");
}
__device__ __forceinline__ int proj_row(int n0) {
    if (n0 < 2048) return 256 * (n0 >> 7) + (n0 & 127);
    if (n0 < 4096) return 4096 + (n0 - 2048);
    if (n0 < 6144) { const int ch = n0 - 4096; return 256 * (ch >> 7) + 128 + (ch & 127); }
    if (n0 < 12288) return n0;
    if (n0 < 12320) return -1;
    { const int c = n0 - 12320, n = c >> 11, ch = c & 2047; return 12288 + 256 * (ch >> 7) + 128 * n + (ch & 127); }
}

template <int W> struct ConvRaw { static constexpr int CG = W / 8, RB = NT / CG, RPT = 128 / RB; u32x4 r[RPT + 3]; };
template <int W>
__device__ __forceinline__ void stage_conv_load(ConvRaw<W>& raw, const bf16_t* xbc, int tok0, int cidx, int col0, int tid) {
    constexpr int CG = ConvRaw<W>::CG, RPT = ConvRaw<W>::RPT;
    const int cgi = tid % CG, rb = tid / CG, r0 = rb * RPT;
    const bf16_t* src = xbc + (size_t)tok0 * 4096 + col0 + cgi * 8;
#pragma unroll
    for (int i = 0; i < RPT + 3; ++i) { const int r = r0 - 3 + i;
        if (cidx == 0 && r < 0) raw.r[i] = (u32x4){0u, 0u, 0u, 0u}; else raw.r[i] = *(const u32x4*)(src + (ptrdiff_t)r * 4096); }
}
template <int W>
__device__ __forceinline__ void stage_conv_finish(const ConvRaw<W>& raw, LAS unsigned char* dst, int stride, int col0, const float* conv_w, const float* conv_b, const LAS float* scale, int tid, bf16_t* gdst = nullptr, int gstride = 0) {
    constexpr int CG = ConvRaw<W>::CG, RPT = ConvRaw<W>::RPT;
    const int cgi = tid % CG, rb = tid / CG, r0 = rb * RPT, ch0 = col0 + cgi * 8;
    float w[4][8], bias[8], h0[8], h1[8], h2[8];
#pragma unroll
    for (int k = 0; k < 4; ++k) { const f32x4 a = *(const f32x4*)(conv_w + k * 4096 + ch0), b = *(const f32x4*)(conv_w + k * 4096 + ch0 + 4);
#pragma unroll
        for (int j = 0; j < 4; ++j) { w[k][j] = a[j]; w[k][4 + j] = b[j]; } }
    { const f32x4 a = *(const f32x4*)(conv_b + ch0), b = *(const f32x4*)(conv_b + ch0 + 4);
#pragma unroll
      for (int j = 0; j < 4; ++j) { bias[j] = a[j]; bias[4 + j] = b[j]; } }
#define UNPK(v_, o) do { o[0] = bflo(v_.x); o[1] = bfhi(v_.x); o[2] = bflo(v_.y); o[3] = bfhi(v_.y); o[4] = bflo(v_.z); o[5] = bfhi(v_.z); o[6] = bflo(v_.w); o[7] = bfhi(v_.w); } while (0)
    UNPK(raw.r[0], h0); UNPK(raw.r[1], h1); UNPK(raw.r[2], h2);
#pragma unroll
    for (int i = 0; i < RPT; ++i) {
        float cur[8], o[8]; UNPK(raw.r[3 + i], cur);
        float sc = 1.0f; if (scale) sc = scale[(cgi >> 3) * 128 + r0 + i];
#pragma unroll
        for (int j = 0; j < 8; ++j) { float v = bias[j] + w[0][j] * h0[j] + w[1][j] * h1[j] + w[2][j] * h2[j] + w[3][j] * cur[j]; o[j] = silu_f(v) * sc; h0[j] = h1[j]; h1[j] = h2[j]; h2[j] = cur[j]; }
        u32x4 pk; pk.x = cvt_pk_bf16(o[0], o[1]); pk.y = cvt_pk_bf16(o[2], o[3]); pk.z = cvt_pk_bf16(o[4], o[5]); pk.w = cvt_pk_bf16(o[6], o[7]);
        { LAS unsigned char* q_ = dst + (r0 + i) * stride + (32 * (cgi >> 2) + 4 * (cgi & 3)) * 2;
          *(LAS u32x2*)q_ = (u32x2){pk.x, pk.y}; *(LAS u32x2*)(q_ + 32) = (u32x2){pk.z, pk.w}; }
        if (gdst) *(u32x4*)(gdst + (size_t)(r0 + i) * gstride + cgi * 8) = pk;
    }
#undef UNPK
}
__device__ __forceinline__ float chunk_prefix(LAS float* adt, LAS float* ac, const float* DT, const float* a_log, int tok0, int g, int tid) {
    const int k = tid >> 7, l = tid & 127, h = g * 4 + k, lane = tid & 63;
    const float dtv = DT[(size_t)h * M_TOK + tok0 + l];
    const float a = -expf(a_log[h]);
    float s = dtv * a;
#pragma unroll
    for (int o = 1; o < 64; o <<= 1) { const float t = __shfl_up(s, o); if (lane >= o) s += t; }
    if (lane == 63) adt[tid >> 6] = s;
    __syncthreads();
    if (l >= 64) s += adt[(tid >> 6) - 1];
    ac[k * 128 + l] = s;
    __syncthreads();
    return dtv;
}

constexpr int XS_STRIDE = 528, CB_STRIDE = 272;

__device__ __forceinline__ void own_barrier(unsigned* bar, unsigned target) {
    if (threadIdx.x == 0) {
        __hip_atomic_fetch_add(bar, 1u, __ATOMIC_RELAXED, __HIP_MEMORY_SCOPE_AGENT);
        const unsigned long long t0 = __builtin_amdgcn_s_memrealtime();
        while (__hip_atomic_load(bar, __ATOMIC_RELAXED, __HIP_MEMORY_SCOPE_AGENT) < target) {
            __builtin_amdgcn_s_sleep(2);
            if (__builtin_amdgcn_s_memrealtime() - t0 > 200000000ull) break;
        }
    }
    __syncthreads();
}
#define GRID_SYNC(i) do { asm volatile("s_waitcnt vmcnt(0) lgkmcnt(0)" ::: "memory"); grid.sync(); \
    __builtin_amdgcn_fence(__ATOMIC_ACQUIRE, "agent"); asm volatile("s_waitcnt vmcnt(0)" ::: "memory"); __syncthreads(); STAMP(i); } while (0)
#ifdef SPIN_PHASE
#define STAMP(i) do { if (bx == 0 && tid == 0) { ((unsigned long long*)(BAR + 16))[i] = __builtin_amdgcn_s_memrealtime(); } } while (0)
#else
#define STAMP(i) do { } while (0)
#endif
#ifdef SPIN_SUB
#define SUBSTAMP(i) do { if (bx == 0 && tid == 0 && j == 0) ((unsigned long long*)(BAR + 16))[16 + (i)] = __builtin_amdgcn_s_memrealtime(); } while (0)
#else
#define SUBSTAMP(i) do { } while (0)
#endif
__global__ void __launch_bounds__(NT, 2) fwd_megakernel(Args A) {
    extern __shared__ __attribute__((aligned(16))) unsigned char lds_raw[];
    LAS unsigned char* lds = (LAS unsigned char*)lds_raw;
    const unsigned lds_u32 = (unsigned)(size_t)lds_raw;
    cg::grid_group grid = cg::this_grid();
    const int tid = threadIdx.x, lane = tid & 63, wave = __builtin_amdgcn_readfirstlane(tid >> 6), fr = lane & 15, fq = lane >> 4;
    const int G = gridDim.x, bx = blockIdx.x;
    const int gw = bx * NWAVES + wave, NGW = G * NWAVES;
    unsigned char* ws = A.ws;
    bf16_t* WinT = (bf16_t*)A.out; bf16_t* H = (bf16_t*)((unsigned char*)A.out + 64 * MiB);
    bf16_t* STATES = (bf16_t*)A.out;
    bf16_t* WdtT = (bf16_t*)(ws + WS_WDT); bf16_t* WsB = (bf16_t*)(ws + WS_WSB); float* STATS = (float*)(ws + WS_STATS); float* SSQ = (float*)(ws + WS_SSQ);
    float* CD = (float*)(ws + WS_CD); float* DT = (float*)(ws + WS_DT); unsigned* BAR = (unsigned*)(ws + WS_BAR); unsigned bar_epoch = 0;
    bf16_t* WbT = (bf16_t*)(ws + WS_WB); bf16_t* WoT = (bf16_t*)(ws + WS_WO); bf16_t* YAB = (bf16_t*)(ws + WS_YAB); bf16_t* V = (bf16_t*)(ws + WS_V);
    bf16_t* PREV = (bf16_t*)(ws + WS_V); bf16_t* MERGED = (bf16_t*)(ws + WS_V);
    bf16_t* CC = (bf16_t*)(ws + WS_CC); bf16_t* YD = (bf16_t*)((unsigned char*)A.out + 64 * MiB);
    bf16_t* XBC = (bf16_t*)(ws + WS_XBC); bf16_t* RG = (bf16_t*)(ws + WS_R); bf16_t* GB = (bf16_t*)(ws + WS_GB);

    STAMP(0);
    if constexpr ((PH_MASK >> 0) & 1)
    {
        LAS float* scr = (LAS float*)(lds + wave * 16640);
        constexpr int I_IN = 32 * 256, I_B = 32 * 32, I_O = 32 * 32, NITEMS = I_IN + 2 * I_B + I_O;
        auto item_of = [&](int it) -> TItem {
            TItem t; int r = it;
            if (r < I_IN) { const int kb = r >> 8, nb = r & 255, n0 = nb < 192 ? 64 * nb : 12320 + 64 * (nb - 192);
                t.src = A.w_in + (size_t)(64 * kb) * NIN + n0; t.ldw = NIN; t.dst = WinT + (size_t)proj_row(n0) * 2048 + 64 * kb; t.ldd = 2048; return t; }
            r -= I_IN;
            if (r < 2 * I_B) { const int nbr = r / I_B, rr = r % I_B, kb = rr >> 5, nb = rr & 31;
                t.src = A.w_branch + (size_t)nbr * 2048 * 2048 + (size_t)(64 * kb) * 2048 + 64 * nb; t.ldw = 2048; t.dst = WbT + (size_t)(64 * nb) * 4096 + nbr * 2048 + 64 * kb; t.ldd = 4096; return t; }
            r -= 2 * I_B;
            { const int kb = r >> 5, nb = r & 31; t.src = A.w_out + (size_t)(64 * kb) * 2048 + 64 * nb; t.ldw = 2048; t.dst = WoT + (size_t)(64 * nb) * 2048 + 64 * kb; t.ldd = 2048; return t; }
        };
        {
            f32x4 va[16], vb[16]; int it = gw; TItem ta, tb;
            if (it < NITEMS) { ta = item_of(it); titem_load(ta, va, lane); }
            while (it < NITEMS) {
                const int it2 = it + NGW, it3 = it2 + NGW;
                if (it2 < NITEMS) { tb = item_of(it2); titem_load(tb, vb, lane); }
                titem_finish(ta, va, scr, lane);
                if (it3 < NITEMS) { ta = item_of(it3); titem_load(ta, va, lane); }
                if (it2 < NITEMS) titem_finish(tb, vb, scr, lane);
                it = it3;
            }
        }
        for (int r = gw; r < 32; r += NGW) transpose_item(A.w_in, NIN, 2048, 64 * r, 12288, WdtT, scr, lane);
        for (int i = bx * NT + tid; i < 8 * 128 * 128; i += G * NT) { const int t = (i >> 7) & 127, s = i & 127; const float v = (s <= t) ? A.w_sp[i] : 0.f; WsB[i] = (bf16_t)(cvt_pk_bf16(v, 0.f) & 0xffffu); }
        for (int i = bx * NT + tid; i < 2 * M_TOK; i += G * NT) STATS[i] = 0.f;
        for (int i = bx * NT + tid; i < M_TOK; i += G * NT) SSQ[i] = 0.f;
        for (int m = gw; m < M_TOK; m += 2 * NGW) {
            const int m2 = m + NGW;
            const f32x4* xr = (const f32x4*)(A.x + (size_t)m * DM) + lane; const f32x4* xr2 = (const f32x4*)(A.x + (size_t)m2 * DM) + lane; const f32x4* wr4 = (const f32x4*)A.norm_w + lane;
            f32x4 v[8], v2[8]; float s = 0.f, s2 = 0.f;
#pragma unroll
            for (int j = 0; j < 8; ++j) { v[j] = xr[64 * j]; v2[j] = xr2[64 * j]; }
#pragma unroll
            for (int j = 0; j < 8; ++j) { s += (v[j][0] * v[j][0] + v[j][1] * v[j][1]) + (v[j][2] * v[j][2] + v[j][3] * v[j][3]); s2 += (v2[j][0] * v2[j][0] + v2[j][1] * v2[j][1]) + (v2[j][2] * v2[j][2] + v2[j][3] * v2[j][3]); }
            const float rstd = 1.0f / sqrtf(wave_sum(s) * (1.0f / DM) + EPS), rstd2 = 1.0f / sqrtf(wave_sum(s2) * (1.0f / DM) + EPS);
            u32x2* o8 = (u32x2*)(H + (size_t)m * DM) + lane; u32x2* o82 = (u32x2*)(H + (size_t)m2 * DM) + lane;
#pragma unroll
            for (int j = 0; j < 8; ++j) { const f32x4 w4 = wr4[64 * j];
                u32x2 o; o.x = cvt_pk_bf16(v[j][0] * rstd * w4[0], v[j][1] * rstd * w4[1]); o.y = cvt_pk_bf16(v[j][2] * rstd * w4[2], v[j][3] * rstd * w4[3]); o8[64 * j] = o;
                u32x2 o2; o2.x = cvt_pk_bf16(v2[j][0] * rstd2 * w4[0], v2[j][1] * rstd2 * w4[1]); o2.y = cvt_pk_bf16(v2[j][2] * rstd2 * w4[2], v2[j][3] * rstd2 * w4[3]); o82[64 * j] = o2; }
        }
    }
    GRID_SYNC(1);

    if constexpr ((PH_MASK >> 1) & 1)
    {
        pg8::Gemm g{H, WinT, M_TOK, NPROJ, DM, DM}; pg8::StaticOrder S; S.init(M_TOK, NPROJ, G, bx, WGM_P1);
        EpiProj E{YAB, V, XBC, RG, GB, STATS, A.b_gate};
        pg8::gemm_phase<EpiProj, pg8::StaticOrder, true, true>(lds, g, S, E);
        {
            constexpr int WROW = 4112;
#pragma unroll
            for (int i = 0; i < 16; ++i) { const int row = 2 * i + (tid >> 8), ch = tid & 255;
                *(LAS u32x4*)(lds + row * WROW + ch * 16) = *(const u32x4*)(WdtT + (size_t)row * DM + ch * 8); }
            __syncthreads();
            for (int t0 = bx * 4; t0 < M_TOK / 16; t0 += G * 4) {
                const int t = t0 + (wave >> 1), kh = wave & 1;
                f32x4 acc0 = {0.f, 0.f, 0.f, 0.f}, acc1 = {0.f, 0.f, 0.f, 0.f};
                const bf16_t* ap = H + (size_t)(16 * t + fr) * DM + 8 * fq + kh * 1024;
                const LAS unsigned char* bp = lds + fr * WROW + (8 * fq + kh * 1024) * 2;
#pragma unroll 16
                for (int ks = 0; ks < 32; ++ks) {
                    const bf16x8 fa = *(const bf16x8*)(ap + 32 * ks), fb0 = *(const LAS bf16x8*)(bp + 64 * ks), fb1 = *(const LAS bf16x8*)(bp + 16 * WROW + 64 * ks);
                    acc0 = __builtin_amdgcn_mfma_f32_16x16x32_bf16(fb0, fa, acc0, 0, 0, 0);
                    acc1 = __builtin_amdgcn_mfma_f32_16x16x32_bf16(fb1, fa, acc1, 0, 0, 0);
                }
                LAS f32x4* xch = (LAS f32x4*)(lds + 32 * WROW) + (wave >> 1) * 128 + lane * 2;
                if (kh) { xch[0] = acc0; xch[1] = acc1; }
                __syncthreads();
                if (!kh) {
                    acc0 += xch[0]; acc1 += xch[1];
                    const f32x4 bb0 = *(const f32x4*)(A.dt_bias + 4 * fq), bb1 = *(const f32x4*)(A.dt_bias + 16 + 4 * fq);
                    f32x4 o0, o1;
#pragma unroll
                    for (int j = 0; j < 4; ++j) { const float v0 = acc0[j] + bb0[j], v1 = acc1[j] + bb1[j];
                        o0[j] = fmaxf(v0, 0.f) + log1pf(expf(-fabsf(v0))); o1[j] = fmaxf(v1, 0.f) + log1pf(expf(-fabsf(v1))); }
                    float* dp = DT + (size_t)(4 * fq) * M_TOK + 16 * t + fr;
#pragma unroll
                    for (int j = 0; j < 4; ++j) { dp[(size_t)j * M_TOK] = o0[j]; dp[(size_t)(16 + j) * M_TOK] = o1[j]; }
                }
                __syncthreads();
            }
        }
    }
    GRID_SYNC(2);

    if constexpr ((PH_MASK >> 2) & 1)
    for (int j = bx; j < 2048; j += G) {
        const int jj = j & 1023, g = jj & 7, bc = jj >> 3, tok0 = bc * 128, cidx = bc & 31;
        int tid = threadIdx.x; asm volatile("" : "+v"(tid));
        const int lane = tid & 63, fr = lane & 15, fq = lane >> 4;
        if (j < 1024) {
            {
                const bf16_t* wsrc = WsB + (size_t)g * 16384;
                u32x4 wv[4];
#pragma unroll
                for (int i = 0; i < 4; ++i) wv[i] = *(const u32x4*)(wsrc + (size_t)(i * 32 + (tid >> 4)) * 128 + (tid & 15) * 8);
#pragma unroll
                for (int i = 0; i < 4; ++i) *(LAS u32x4*)(lds + 67584 + (i * 32 + (tid >> 4)) * CB_STRIDE + (tid & 15) * 16) = wv[i];
            }
            bf16_t* p0 = YAB + (size_t)(tok0 + fr) * 4096 + g * 256 + 32 * wave + 8 * fq;
            u32x4 sv[8]; float bs[8];
#pragma unroll
            for (int mt = 0; mt < 8; ++mt) { bs[mt] = A.b_sp[g * 128 + 16 * mt + fr]; sv[mt] = *(const u32x4*)(p0 + (size_t)(16 * mt) * 4096); }
            {
                const int cgi = tid & 31, rb = tid >> 5, d0 = g * 256 + cgi * 8;
                const f32x4 lw0 = *(const f32x4*)(A.ln_w + d0), lw1 = *(const f32x4*)(A.ln_w + d0 + 4), lb0 = *(const f32x4*)(A.ln_b + d0), lb1 = *(const f32x4*)(A.ln_b + d0 + 4);
#pragma unroll
                for (int i = 0; i < 8; ++i) {
                    const int r = rb * 8 + i, tok = tok0 + r;
                    const float2 st2 = *(const float2*)(STATS + 2 * tok); const float mean = st2.x * (1.0f / 2048.0f), var = st2.y * (1.0f / 2048.0f) - mean * mean, rstd = 1.0f / sqrtf(fmaxf(var, 0.f) + EPS);
                    const u32x4 v = *(const u32x4*)(V + (size_t)tok * 2048 + d0);
                    u32x4 pk;
                    pk.x = cvt_pk_bf16((bflo(v.x) - mean) * rstd * lw0[0] + lb0[0], (bfhi(v.x) - mean) * rstd * lw0[1] + lb0[1]);
                    pk.y = cvt_pk_bf16((bflo(v.y) - mean) * rstd * lw0[2] + lb0[2], (bfhi(v.y) - mean) * rstd * lw0[3] + lb0[3]);
                    pk.z = cvt_pk_bf16((bflo(v.z) - mean) * rstd * lw1[0] + lb1[0], (bfhi(v.z) - mean) * rstd * lw1[1] + lb1[1]);
                    pk.w = cvt_pk_bf16((bflo(v.w) - mean) * rstd * lw1[2] + lb1[2], (bfhi(v.w) - mean) * rstd * lw1[3] + lb1[3]);
                    { LAS unsigned char* q_ = lds + r * XS_STRIDE + (32 * (cgi >> 2) + 4 * (cgi & 3)) * 2; *(LAS u32x2*)q_ = (u32x2){pk.x, pk.y}; *(LAS u32x2*)(q_ + 32) = (u32x2){pk.z, pk.w}; }
                }
            }
            __syncthreads();
            f32x4 acc[8][2];
#pragma unroll
            for (int mt = 0; mt < 8; ++mt) { acc[mt][0] = (f32x4){0.f, 0.f, 0.f, 0.f}; acc[mt][1] = (f32x4){0.f, 0.f, 0.f, 0.f}; }
            const unsigned tra = lds_u32 + (8 * fq + (fr >> 2)) * XS_STRIDE + (32 * wave + 4 * (lane & 3)) * 2;
#pragma unroll
            for (int ks = 0; ks < 4; ++ks) {
                bf16x8 fn0, fn1; tr_frag2<4 * XS_STRIDE, 32>(tra + 32 * ks * XS_STRIDE, fn0, fn1);
#pragma unroll
                for (int mt = 2 * ks; mt < 8; ++mt) {
                    const bf16x8 fm = *(const LAS bf16x8*)(lds + 67584 + (16 * mt + fr) * CB_STRIDE + (32 * ks + 8 * fq) * 2);
                    acc[mt][0] = __builtin_amdgcn_mfma_f32_16x16x32_bf16(fn0, fm, acc[mt][0], 0, 0, 0);
                    acc[mt][1] = __builtin_amdgcn_mfma_f32_16x16x32_bf16(fn1, fm, acc[mt][1], 0, 0, 0);
                }
            }
            {
#pragma unroll
                for (int mt = 0; mt < 8; ++mt) { const f32x4 a0 = acc[mt][0], a1 = acc[mt][1]; const u32x4 s4 = sv[mt]; const float b = bs[mt];
                    u32x4 o; o.x = cvt_pk_bf16(bflo(s4.x) * (a0[0] + b), bfhi(s4.x) * (a0[1] + b)); o.y = cvt_pk_bf16(bflo(s4.y) * (a0[2] + b), bfhi(s4.y) * (a0[3] + b));
                    o.z = cvt_pk_bf16(bflo(s4.z) * (a1[0] + b), bfhi(s4.z) * (a1[1] + b)); o.w = cvt_pk_bf16(bflo(s4.w) * (a1[2] + b), bfhi(s4.w) * (a1[3] + b));
                    *(u32x4*)(p0 + (size_t)(16 * mt) * 4096) = o; }
            }
            __syncthreads();
        } else {
            LAS float* ac = (LAS float*)(lds + 137216); LAS float* dtl = ac + 512; LAS float* adt = dtl + 512; LAS float* wg = adt + 512;
            ConvRaw<128> rc, rbb; ConvRaw<256> rx;
            stage_conv_load<128>(rc, XBC, tok0, cidx, 3072 + g * 128, tid); stage_conv_load<128>(rbb, XBC, tok0, cidx, 2048 + g * 128, tid); stage_conv_load<256>(rx, XBC, tok0, cidx, g * 256, tid);
            { const float dtv = chunk_prefix(adt, ac, DT, A.a_log, tok0, g, tid); dtl[tid] = dtv;
              const int k = tid >> 7, l_ = tid & 127; const float aend = ac[k * 128 + 127]; wg[tid] = expf(aend - ac[tid]) * dtv; if (l_ == 127) CD[bc * 32 + g * 4 + k] = expf(aend); }
            stage_conv_finish<128>(rc, lds, CB_STRIDE, 3072 + g * 128, A.conv_w, A.conv_b, nullptr, tid, CC + (size_t)tok0 * 1024 + g * 128, 1024);
            stage_conv_finish<128>(rbb, lds + 34816, CB_STRIDE, 2048 + g * 128, A.conv_w, A.conv_b, nullptr, tid);
            stage_conv_finish<256>(rx, lds + 69632, XS_STRIDE, g * 256, A.conv_w, A.conv_b, nullptr, tid);
            __syncthreads();
            const int l = 16 * wave + fr;
            f32x4 cb[8];
            {
                bf16x8 fc[4];
#pragma unroll
                for (int ks = 0; ks < 4; ++ks) fc[ks] = *(const LAS bf16x8*)(lds + l * CB_STRIDE + (32 * ks + 8 * fq) * 2);
#pragma unroll
                for (int nt = 0; nt < 8; ++nt) {
                    cb[nt] = (f32x4){0.f, 0.f, 0.f, 0.f};
                    if (nt <= wave) {
#pragma unroll
                        for (int ks = 0; ks < 4; ++ks) { const bf16x8 fb = *(const LAS bf16x8*)(lds + 34816 + (16 * nt + fr) * CB_STRIDE + (32 * ks + 8 * fq) * 2);
                            cb[nt] = __builtin_amdgcn_mfma_f32_16x16x32_bf16(fb, fc[ks], cb[nt], 0, 0, 0); }
                    }
                }
            }
            {
                const int k = wave >> 1, ph = wave & 1;
                f32x4 acc[2][8];
#pragma unroll
                for (int mt = 0; mt < 2; ++mt)
#pragma unroll
                    for (int nt = 0; nt < 8; ++nt) acc[mt][nt] = (f32x4){0.f, 0.f, 0.f, 0.f};
                const unsigned xa = lds_u32 + 69632 + (8 * fq + (fr >> 2)) * XS_STRIDE + (k * 64 + 32 * ph + 4 * (lane & 3)) * 2;
                const unsigned ba = lds_u32 + 34816 + (8 * fq + (fr >> 2)) * CB_STRIDE + (4 * (lane & 3)) * 2;
#pragma unroll
                for (int ks = 0; ks < 4; ++ks) {
                    bf16x8 fm0, fm1; tr_frag2<4 * XS_STRIDE, 32>(xa + 32 * ks * XS_STRIDE, fm0, fm1);
                    const f32x4 w0 = *(const LAS f32x4*)(wg + k * 128 + 32 * ks + 8 * fq), w1 = *(const LAS f32x4*)(wg + k * 128 + 32 * ks + 8 * fq + 4);
                    const float wv[8] = {w0[0], w0[1], w0[2], w0[3], w1[0], w1[1], w1[2], w1[3]};
                    bf16x8 sm0, sm1;
#pragma unroll
                    for (int e = 0; e < 8; e += 2) {
                        const unsigned a0 = cvt_pk_bf16(bf2f((unsigned short)fm0[e]) * wv[e], bf2f((unsigned short)fm0[e + 1]) * wv[e + 1]);
                        const unsigned a1 = cvt_pk_bf16(bf2f((unsigned short)fm1[e]) * wv[e], bf2f((unsigned short)fm1[e + 1]) * wv[e + 1]);
                        sm0[e] = (short)(a0 & 0xffffu); sm0[e + 1] = (short)(a0 >> 16); sm1[e] = (short)(a1 & 0xffffu); sm1[e + 1] = (short)(a1 >> 16);
                    }
#pragma unroll
                    for (int nq = 0; nq < 2; ++nq) {
                        bf16x8 fn[4]; tr_frag4<4 * CB_STRIDE, 32>(ba + 32 * ks * CB_STRIDE + 128 * nq, fn[0], fn[1], fn[2], fn[3]);
#pragma unroll
                        for (int i = 0; i < 4; ++i) {
                            acc[0][4 * nq + i] = __builtin_amdgcn_mfma_f32_16x16x32_bf16(fn[i], sm0, acc[0][4 * nq + i], 0, 0, 0);
                            acc[1][4 * nq + i] = __builtin_amdgcn_mfma_f32_16x16x32_bf16(fn[i], sm1, acc[1][4 * nq + i], 0, 0, 0);
                        }
                    }
                }
                bf16_t* sp = STATES + ((size_t)(bc * 8 + g) * 4096 + (size_t)wave * 512 + lane) * 8;
#pragma unroll
                for (int mt = 0; mt < 2; ++mt)
#pragma unroll
                    for (int q = 0; q < 4; ++q) { const f32x4 a0 = acc[mt][2 * q], a1 = acc[mt][2 * q + 1];
                        u32x4 o; o.x = cvt_pk_bf16(a0[0], a0[1]); o.y = cvt_pk_bf16(a0[2], a0[3]); o.z = cvt_pk_bf16(a1[0], a1[1]); o.w = cvt_pk_bf16(a1[2], a1[3]);
                        *(u32x4*)(sp + (size_t)((mt * 4 + q) * 64) * 8) = o; }
            }
            __syncthreads();
            LAS unsigned char* sw = lds + 34816 + wave * (16 * CB_STRIDE);
            bf16_t* ydp = YD + ((size_t)(jj * 8 + wave) * 8 * 64 + lane) * 8;
#pragma unroll
            for (int k = 0; k < 4; ++k) {
                const int h = g * 4 + k; const float al = ac[k * 128 + l], dsk = A.d_skip[h];
#pragma unroll
                for (int nt = 0; nt < 8; ++nt) {
                    float sv[4];
#pragma unroll
                    for (int r = 0; r < 4; ++r) { const int s = 16 * nt + 4 * fq + r;
                        float v = (s <= l) ? cb[nt][r] * __expf(al - ac[k * 128 + s]) * dtl[k * 128 + s] : 0.f;
                        if (s == l) v += dsk; sv[r] = v; }
                    u32x2 o; o.x = cvt_pk_bf16(sv[0], sv[1]); o.y = cvt_pk_bf16(sv[2], sv[3]);
                    *(LAS u32x2*)(sw + fr * CB_STRIDE + (16 * nt + 4 * fq) * 2) = o;
                    if (nt & 1) asm volatile("" ::: "memory");
                }
                asm volatile("s_waitcnt lgkmcnt(0)" ::: "memory");
                f32x4 ay[4];
#pragma unroll
                for (int pt = 0; pt < 4; ++pt) ay[pt] = (f32x4){0.f, 0.f, 0.f, 0.f};
                const unsigned xa = lds_u32 + 69632 + (8 * fq + (fr >> 2)) * XS_STRIDE + (k * 64 + 4 * (lane & 3)) * 2;
#pragma unroll
                for (int ks = 0; ks < 4; ++ks) {
                    if (ks <= (wave >> 1)) {
                        const bf16x8 fs = *(const LAS bf16x8*)(sw + fr * CB_STRIDE + (32 * ks + 8 * fq) * 2);
                        bf16x8 fx[4]; tr_frag4<4 * XS_STRIDE, 32>(xa + 32 * ks * XS_STRIDE, fx[0], fx[1], fx[2], fx[3]);
#pragma unroll
                        for (int pt = 0; pt < 4; ++pt) ay[pt] = __builtin_amdgcn_mfma_f32_16x16x32_bf16(fx[pt], fs, ay[pt], 0, 0, 0);
                    }
                }
#pragma unroll
                for (int q = 0; q < 2; ++q) { u32x4 o; o.x = cvt_pk_bf16(ay[2 * q][0], ay[2 * q][1]); o.y = cvt_pk_bf16(ay[2 * q][2], ay[2 * q][3]); o.z = cvt_pk_bf16(ay[2 * q + 1][0], ay[2 * q + 1][1]); o.w = cvt_pk_bf16(ay[2 * q + 1][2], ay[2 * q + 1][3]); *(u32x4*)(ydp + (size_t)(k * 2 + q) * 512) = o; }
                __builtin_amdgcn_sched_barrier(0);
                asm volatile("s_waitcnt lgkmcnt(0)" ::: "memory");
            }
            __syncthreads();
        }
    }
    GRID_SYNC(3);

    if constexpr ((PH_MASK >> 3) & 1)
    for (int blk = bx; blk < 256; blk += G) {
        const int b = blk >> 6; const unsigned o8 = (unsigned)(blk & 63) * 512u + (unsigned)tid; const int h = (int)(o8 >> 10);
        const bf16_t* sbase = STATES + (size_t)(b * 32) * 262144; bf16_t* pbase = PREV + (size_t)(b * 32) * 262144;
        const unsigned voff = o8 * 8u;
        f32x4 h0 = {0.f, 0.f, 0.f, 0.f}, h1 = {0.f, 0.f, 0.f, 0.f};
#pragma unroll 1
        for (int cb0 = 0; cb0 < 32; cb0 += 16) {
            const bf16_t* sb = sbase + (size_t)cb0 * 262144; bf16_t* pb = pbase + (size_t)cb0 * 262144;
            u32x4 sv[16]; float cdv[16];
#pragma unroll
            for (int c = 0; c < 16; ++c) { sv[c] = *(const u32x4*)(sb + (size_t)c * 262144 + voff); cdv[c] = CD[(b * 32 + cb0 + c) * 32 + h]; }
#pragma unroll
            for (int c = 0; c < 16; ++c) {
                u32x4 o; o.x = cvt_pk_bf16(h0[0], h0[1]); o.y = cvt_pk_bf16(h0[2], h0[3]); o.z = cvt_pk_bf16(h1[0], h1[1]); o.w = cvt_pk_bf16(h1[2], h1[3]);
                *(u32x4*)(pb + (size_t)c * 262144 + voff) = o;
                const f32x4 s0 = {bflo(sv[c].x), bfhi(sv[c].x), bflo(sv[c].y), bfhi(sv[c].y)}, s1 = {bflo(sv[c].z), bfhi(sv[c].z), bflo(sv[c].w), bfhi(sv[c].w)};
                h0 = h0 * cdv[c] + s0; h1 = h1 * cdv[c] + s1;
            }
        }
    }
    GRID_SYNC(4);

    if constexpr ((PH_MASK >> 4) & 1)
    for (int j = bx; j < 1024; j += G) {
        const int g = j & 7, bc = j >> 3, tok0 = bc * 128;
        int tid = threadIdx.x; asm volatile("" : "+v"(tid));
        const int lane = tid & 63, fr = lane & 15, fq = lane >> 4;
        LAS float* ac = (LAS float*)lds; LAS float* adt = ac + 512;
        const int l = 16 * wave + fr;
        bf16x8 fc[4];
#pragma unroll
        for (int ks = 0; ks < 4; ++ks) fc[ks] = *(const bf16x8*)(CC + (size_t)(tok0 + l) * 1024 + g * 128 + 32 * ks + 8 * fq);
        {
            const bf16_t* pg = PREV + (size_t)(bc * 8 + g) * 4096 * 8;
            u32x4 pv[8];
#pragma unroll
            for (int i = 0; i < 8; ++i) pv[i] = *(const u32x4*)(pg + ((size_t)i * 512 + tid) * 8);
            const int mt_ = (tid >> 8) & 1, q_ = (tid >> 6) & 3, fr_ = tid & 15, fq_ = (tid >> 4) & 3;
#pragma unroll
            for (int i = 0; i < 8; ++i) { const int row = (i >> 1) * 64 + 32 * (i & 1) + 8 * (fr_ >> 2) + 4 * mt_ + (fr_ & 3);
                *(LAS u32x4*)(lds + 4096 + row * CB_STRIDE + (32 * q_ + 8 * fq_) * 2) = pv[i]; }
        }
        (void)chunk_prefix(adt, ac, DT, A.a_log, tok0, g, tid);
        f32x4 y[4][4];
        float ss = 0.f;
        bf16_t* zp = YAB + (size_t)(tok0 + l) * 4096 + 2048 + g * 256 + 8 * fq;
        const bf16_t* ydp = YD + ((size_t)(j * 8 + wave) * 8 * 64 + lane) * 8;
        const int prow0 = pg8::perm32(fr), prow1 = pg8::perm32(16 + fr);
#pragma unroll
        for (int k = 0; k < 4; ++k) {
            const int h = g * 4 + k; const float ea = __expf(ac[k * 128 + l]);
            const LAS unsigned char* pp = lds + 4096 + (k * 64) * CB_STRIDE + 16 * fq;
            f32x4 ao[4];
#pragma unroll
            for (int pt = 0; pt < 4; ++pt) ao[pt] = (f32x4){0.f, 0.f, 0.f, 0.f};
            u32x4 zv4[2], yv4[2];
#pragma unroll
            for (int q = 0; q < 2; ++q) { zv4[q] = *(const u32x4*)(zp + k * 64 + q * 32); yv4[q] = *(const u32x4*)(ydp + (size_t)(k * 2 + q) * 512); }
#pragma unroll
            for (int ks = 0; ks < 4; ++ks) {
                bf16x8 fpw[4];
#pragma unroll
                for (int pt = 0; pt < 4; ++pt) fpw[pt] = *(const LAS bf16x8*)(pp + (32 * (pt >> 1) + ((pt & 1) ? prow1 : prow0)) * CB_STRIDE + 64 * ks);
#pragma unroll
                for (int pt = 0; pt < 4; ++pt) ao[pt] = __builtin_amdgcn_mfma_f32_16x16x32_bf16(fpw[pt], fc[ks], ao[pt], 0, 0, 0);
            }
#pragma unroll
            for (int pt = 0; pt < 4; ++pt) { const u32x4 z4 = zv4[pt >> 1], y4 = yv4[pt >> 1];
                const unsigned zlo = (pt & 1) ? z4.z : z4.x, zhi = (pt & 1) ? z4.w : z4.y, ylo = (pt & 1) ? y4.z : y4.x, yhi = (pt & 1) ? y4.w : y4.y;
                f32x4 v = ao[pt] * ea; v[0] = (v[0] + bflo(ylo)) * bflo(zlo); v[1] = (v[1] + bfhi(ylo)) * bfhi(zlo); v[2] = (v[2] + bflo(yhi)) * bflo(zhi); v[3] = (v[3] + bfhi(yhi)) * bfhi(zhi);
                ss += (v[0] * v[0] + v[1] * v[1]) + (v[2] * v[2] + v[3] * v[3]); y[k][pt] = v; }
            __builtin_amdgcn_sched_barrier(0);
        }
        ss += __shfl_xor(ss, 16); ss += __shfl_xor(ss, 32);
        const float rstd = 1.0f / sqrtf(ss * (1.0f / 256.0f) + EPS);
        const float* nw = A.ssm_nw + g * 256 + 8 * fq;
        u32x4 ov[4][2];
#pragma unroll
        for (int k = 0; k < 4; ++k)
#pragma unroll
            for (int q = 0; q < 2; ++q) { const f32x4 w0 = *(const f32x4*)(nw + k * 64 + q * 32), w1 = *(const f32x4*)(nw + k * 64 + q * 32 + 4); const f32x4 v0 = y[k][2 * q], v1 = y[k][2 * q + 1];
                ov[k][q].x = cvt_pk_bf16(v0[0] * rstd * w0[0], v0[1] * rstd * w0[1]); ov[k][q].y = cvt_pk_bf16(v0[2] * rstd * w0[2], v0[3] * rstd * w0[3]);
                ov[k][q].z = cvt_pk_bf16(v1[0] * rstd * w1[0], v1[1] * rstd * w1[1]); ov[k][q].w = cvt_pk_bf16(v1[2] * rstd * w1[2], v1[3] * rstd * w1[3]); }
#pragma unroll
        for (int k = 0; k < 4; ++k)
#pragma unroll
            for (int q = 0; q < 2; ++q) *(u32x4*)(zp + k * 64 + q * 32) = ov[k][q];
        __syncthreads();
    }
    GRID_SYNC(5);

    if constexpr ((PH_MASK >> 5) & 1)
    {
        pg8::Gemm g{YAB, WbT, M_TOK, DM, DM, 2 * DM}; SplitKOrder S; S.init(M_TOK, DM, G, bx, WGM_P5);
        EpiMerge E{RG, GB, MERGED};
        pg8::gemm_phase<EpiMerge, SplitKOrder, true, true>(lds, g, S, E);
    }
    GRID_SYNC(6);

    if constexpr ((PH_MASK >> 6) & 1)
    {
        pg8::Gemm g{MERGED, WoT, M_TOK, DM, DM, DM}; pg8::StaticOrder S; S.init(M_TOK, DM, G, bx, WGM_P6);
        EpiAcc E{YAB};
        pg8::gemm_phase<EpiAcc, pg8::StaticOrder, true, true>(lds, g, S, E);
    }
    GRID_SYNC(7);

    if constexpr ((PH_MASK >> 7) & 1)
    for (int m = gw; m < M_TOK; m += 2 * NGW) {
        const int m2 = m + NGW;
        int tid_ = threadIdx.x; asm volatile("" : "+v"(tid_)); const int lane = tid_ & 63;
        const f32x4* xr = (const f32x4*)(A.x + (size_t)m * DM) + lane; const f32x4* xr2 = (const f32x4*)(A.x + (size_t)m2 * DM) + lane;
        const u32x2* ar = (const u32x2*)(YAB + (size_t)m * DM) + lane; const u32x2* ar2 = (const u32x2*)(YAB + (size_t)m2 * DM) + lane;
        const f32x4* wr4 = (const f32x4*)A.fnw + lane;
        f32x4 v[8], v2[8]; u32x2 a[8], a2[8]; float s = 0.f, s2 = 0.f;
#pragma unroll
        for (int j = 0; j < 8; ++j) { v[j] = xr[64 * j]; v2[j] = xr2[64 * j]; a[j] = ar[64 * j]; a2[j] = ar2[64 * j]; }
#pragma unroll
        for (int j = 0; j < 8; ++j) {
            v[j][0] += bflo(a[j].x); v[j][1] += bfhi(a[j].x); v[j][2] += bflo(a[j].y); v[j][3] += bfhi(a[j].y);
            v2[j][0] += bflo(a2[j].x); v2[j][1] += bfhi(a2[j].x); v2[j][2] += bflo(a2[j].y); v2[j][3] += bfhi(a2[j].y);
            s += (v[j][0] * v[j][0] + v[j][1] * v[j][1]) + (v[j][2] * v[j][2] + v[j][3] * v[j][3]); s2 += (v2[j][0] * v2[j][0] + v2[j][1] * v2[j][1]) + (v2[j][2] * v2[j][2] + v2[j][3] * v2[j][3]); }
        const float rstd = 1.0f / sqrtf(wave_sum(s) * (1.0f / DM) + EPS), rstd2 = 1.0f / sqrtf(wave_sum(s2) * (1.0f / DM) + EPS);
        f32x4* orow = (f32x4*)(A.out + (size_t)m * DM) + lane; f32x4* orow2 = (f32x4*)(A.out + (size_t)m2 * DM) + lane;
#pragma unroll
        for (int j = 0; j < 8; ++j) { const f32x4 w4 = wr4[64 * j]; orow[64 * j] = v[j] * rstd * w4; orow2[64 * j] = v2[j] * rstd2 * w4; }
    }
#ifdef SPIN_SUB
    if (bx == 0 && tid == 0) {
        const unsigned long long* st = (const unsigned long long*)(BAR + 16) + 16;
        const unsigned long long d = (st[SPIN_SUB + 1] - st[SPIN_SUB]) * SPIN_MULT, t0 = __builtin_amdgcn_s_memrealtime();
        while (__builtin_amdgcn_s_memrealtime() - t0 < d) __builtin_amdgcn_s_sleep(10);
    }
#endif
#ifdef SPIN_PHASE
    STAMP(8);
    if (bx == 0 && tid == 0) {
        const unsigned long long* st = (const unsigned long long*)(BAR + 16);
        const unsigned long long d = (st[SPIN_PHASE + 1] - st[SPIN_PHASE]) * SPIN_MULT, t0 = __builtin_amdgcn_s_memrealtime();
        while (__builtin_amdgcn_s_memrealtime() - t0 < d) __builtin_amdgcn_s_sleep(10);
    }
#endif
}

extern "C" void kernel_launch(void* const* d_in, const int* in_sizes, int n_in, void* d_out, int out_size, void* d_ws, size_t ws_size, hipStream_t stream) {
    static int grid = 0;
    if (grid == 0) {
        if (n_in != 17 || out_size != M_TOK * DM || ws_size < WS_END) { fprintf(stderr, "kernel_launch: unexpected shapes (n_in %d out %d ws %zu)\n", n_in, out_size, ws_size); grid = -1; return; }
        int dev = 0, cus = 0, per_cu = 0;
        hipGetDevice(&dev); hipDeviceGetAttribute(&cus, hipDeviceAttributeMultiprocessorCount, dev);
        if (hipFuncSetAttribute((const void*)fwd_megakernel, hipFuncAttributeMaxDynamicSharedMemorySize, LDS_BYTES) != hipSuccess) { fprintf(stderr, "kernel_launch: hipFuncSetAttribute failed\n"); grid = -1; return; }
        if (hipOccupancyMaxActiveBlocksPerMultiprocessor(&per_cu, (const void*)fwd_megakernel, NT, LDS_BYTES) != hipSuccess || per_cu < 1) { fprintf(stderr, "kernel_launch: occupancy query says %d\n", per_cu); per_cu = 1; }
        (void)hipGetLastError();
        grid = cus * 1;
    }
    if (grid < 0) return;
    Args a{};
    a.x = (const float*)d_in[0]; a.norm_w = (const float*)d_in[1]; a.w_in = (const float*)d_in[2]; a.b_gate = (const float*)d_in[3]; a.ln_w = (const float*)d_in[4]; a.ln_b = (const float*)d_in[5];
    a.w_sp = (const float*)d_in[6]; a.b_sp = (const float*)d_in[7]; a.conv_w = (const float*)d_in[8]; a.conv_b = (const float*)d_in[9]; a.dt_bias = (const float*)d_in[10]; a.a_log = (const float*)d_in[11];
    a.d_skip = (const float*)d_in[12]; a.ssm_nw = (const float*)d_in[13]; a.w_branch = (const float*)d_in[14]; a.w_out = (const float*)d_in[15]; a.fnw = (const float*)d_in[16];
    a.out = (float*)d_out; a.ws = (unsigned char*)d_ws;
    if (hipMemsetAsync((char*)d_ws + WS_BAR, 0, 256, stream) != hipSuccess) { fprintf(stderr, "kernel_launch: memset failed\n"); return; }
    void* args[] = {&a};
    hipError_t e = hipLaunchCooperativeKernel((const void*)fwd_megakernel, dim3(grid), dim3(NT), args, LDS_BYTES, stream);
    if (e != hipSuccess) fprintf(stderr, "cooperative launch failed: %s (grid %d)\n", hipGetErrorString(e), grid);
}
```

```cpp
#include <hip/hip_runtime.h>
#include <hip/hip_cooperative_groups.h>
#include <cstdio>
#include <cstdint>
namespace cg = cooperative_groups;
namespace pg8 {
#define PG8_LAS __attribute__((address_space(3)))
typedef unsigned short bf16_t;
typedef short bf16x8 __attribute__((ext_vector_type(8)));
typedef float f32x4 __attribute__((ext_vector_type(4)));
typedef unsigned u32x4 __attribute__((ext_vector_type(4)));
constexpr int BM = 256, BK = 64, HALF = 128, HTB = HALF * BK * 2  , STAGE_BYTES = 8 * HTB, NXCD = 8, WGM = 8;

__host__ __device__ __forceinline__ int lds_byte(int r, int c) { const int st = (r >> 4) * 2 + (c >> 5), rr = r & 15, cc = c & 31, ob = rr * 64 + cc * 2; return st * 1024 + (ob ^ (((ob >> 9) & 1) << 5)); }
__host__ __device__ __forceinline__ void stage_rc(int b, int& R, int& C) { const int st = b / 1024, sb = b % 1024, swz = sb ^ (((sb >> 9) & 1) << 5); R = (st >> 1) * 16 + swz / 64; C = (st & 1) * 32 + (swz % 64) / 2; }
__host__ __device__ __forceinline__ int perm32(int rho) { const int n = rho >> 4, i = rho & 15; return 8 * (i >> 2) + 4 * n + (i & 3); }

struct Unit { int pm, pn, kh; };
struct Gemm { const bf16_t* A; const bf16_t* Bt; int M, N, K, ld; };

struct StaticOrder {
    int nM, nN, nwg, G, c, wgm;
    __host__ __device__ void init(int M, int N, int G_, int c_, int wgm_ = WGM) { nM = M / BM; nN = N / BM; nwg = nM * nN; G = G_; c = c_; wgm = wgm_; }
    __host__ __device__ bool next(int i, Unit& u) const {
        const long L = (long)i * G + c; if (L >= nwg) return false;
        int wgid = (int)L; { const int q = nwg / NXCD, r = nwg % NXCD, xcd = wgid % NXCD, off = wgid / NXCD; wgid = (xcd < r ? xcd * (q + 1) : r * (q + 1) + (xcd - r) * q) + off; }
        const int nig = wgm * nN, gid = wgid / nig, fm = gid * wgm, gsz = (nM - fm) < wgm ? (nM - fm) : wgm;
        u.pm = fm + ((wgid % nig) % gsz); u.pn = (wgid % nig) / gsz; u.kh = 0; return true;
    }
    __device__ __forceinline__ void a_ready(const Unit&) const {}
    __device__ __forceinline__ void done(const Unit&) const {}
};
typedef float f32x2_t_ __attribute__((ext_vector_type(2)));
typedef __bf16 bf16x2_t_ __attribute__((ext_vector_type(2)));
__device__ __forceinline__ unsigned cvt_pk_bf16(float lo, float hi) { const f32x2_t_ v = {lo, hi}; const bf16x2_t_ b = __builtin_convertvector(v, bf16x2_t_); return __builtin_bit_cast(unsigned, b); }
template <class Epi, class Sched, bool ALIGN_EPI = false, bool SP2 = false>
__device__ __forceinline__ void gemm_phase(PG8_LAS unsigned char* lds, const Gemm g, const Sched& S, const Epi& E) {
    int tid_ = threadIdx.x; asm volatile("" : "+v"(tid_));
    const int tid = tid_, wid = __builtin_amdgcn_readfirstlane(tid >> 6), lane = tid & 63, wr = wid >> 2, wc = wid & 3, fr = lane & 15, fq = lane >> 4;
    const int K = g.K, nt = K / BK, ld = g.ld;
    unsigned voffA[2], voffB[2];
#pragma unroll
    for (int i = 0; i < 2; ++i) { int R, C; stage_rc(tid * 16 + i * 8192, R, C); const int Rb = Epi::PERM ? ((R & ~31) + perm32(R & 31)) : R;
        voffA[i] = (unsigned)(R * ld + C) * 2u; voffB[i] = (unsigned)(Rb * ld + C) * 2u; }
    const size_t kstep = (size_t)(BK * 2);
    const size_t hstep = (size_t)HALF * ld * 2;
    const size_t tstep = 2 * hstep;
    const unsigned ldsw = (unsigned)wid * 1024u;
    const int aoff = lds_byte(wr * 64 + fr, fq * 8), boff = lds_byte(wc * 32 + fr, fq * 8);
#define PG8_SA(b, h) (((b) * 2 + (h)) * HTB)
#define PG8_SB(b, h) ((4 + (b) * 2 + (h)) * HTB)
#define PG8_STAGE(bufoff, gbase, voff) do { _Pragma("unroll") for (int _i = 0; _i < 2; ++_i) \
        __builtin_amdgcn_global_load_lds((const unsigned*)((const char*)(gbase) + (voff)[_i]), (PG8_LAS unsigned*)(lds + (bufoff) + ldsw + _i * 8192), 16, 0, 0); } while (0)
#define PG8_LDA(dst, b, h) do { _Pragma("unroll") for (int m = 0; m < 4; ++m) _Pragma("unroll") for (int k = 0; k < 2; ++k) dst[m][k] = *(const PG8_LAS bf16x8*)(lds + PG8_SA(b, h) + aoff + m * 2048 + k * 1024); } while (0)
#define PG8_LDB(dst, b, h) do { _Pragma("unroll") for (int n = 0; n < 2; ++n) _Pragma("unroll") for (int k = 0; k < 2; ++k) dst[n][k] = *(const PG8_LAS bf16x8*)(lds + PG8_SB(b, h) + boff + n * 2048 + k * 1024); } while (0)
#define PG8_MMA(ai, bj, At, Bt) do { __builtin_amdgcn_s_setprio(1); _Pragma("unroll") for (int m = 0; m < 4; ++m) _Pragma("unroll") for (int n = 0; n < 2; ++n) _Pragma("unroll") for (int k = 0; k < 2; ++k) \
        acc[ai][bj][m][n] = __builtin_amdgcn_mfma_f32_16x16x32_bf16(Bt[n][k], At[m][k], acc[ai][bj][m][n], 0, 0, 0); __builtin_amdgcn_s_setprio(0); } while (0)
#define PG8_WAIT_V(n) asm volatile("s_waitcnt vmcnt(" #n ")" ::: "memory")
#define PG8_WAIT_L(n) asm volatile("s_waitcnt lgkmcnt(" #n ")" ::: "memory")
#define PG8_BAR __builtin_amdgcn_s_barrier()
#define PG8_SCHED __builtin_amdgcn_sched_barrier(0)
    Unit cur, nxt; int ui = 0;
    if (!S.next(0, cur)) return;
    f32x4 acc[2][2][4][2];
#pragma unroll
    for (int a = 0; a < 2; ++a)
#pragma unroll
        for (int b = 0; b < 2; ++b)
#pragma unroll
            for (int m = 0; m < 4; ++m)
#pragma unroll
                for (int n = 0; n < 2; ++n) acc[a][b][m][n] = (f32x4){0.f, 0.f, 0.f, 0.f};
    bf16x8 At[4][2], B0[2][2], B1[2][2];
    const char* cA = (const char*)g.A + (size_t)cur.pm * tstep + (size_t)cur.kh * K * 2; const char* cB = (const char*)g.Bt + (size_t)cur.pn * tstep + (size_t)cur.kh * K * 2;
    S.a_ready(cur);
    if constexpr (SP2) {
        PG8_STAGE(PG8_SB(0, 0), cB, voffB); PG8_STAGE(PG8_SB(0, 1), cB + hstep, voffB); PG8_STAGE(PG8_SA(0, 0), cA, voffA); PG8_STAGE(PG8_SA(0, 1), cA + hstep, voffA);
        if (wr == 1) PG8_BAR;
        PG8_WAIT_V(2); PG8_BAR;
        PG8_STAGE(PG8_SB(1, 0), cB + kstep, voffB); PG8_STAGE(PG8_SA(1, 0), cA + kstep, voffA); PG8_STAGE(PG8_SB(1, 1), cB + hstep + kstep, voffB);
        PG8_WAIT_V(6); PG8_BAR;
    } else {
        PG8_STAGE(PG8_SB(0, 0), cB, voffB); PG8_STAGE(PG8_SA(0, 0), cA, voffA); PG8_STAGE(PG8_SB(0, 1), cB + hstep, voffB); PG8_STAGE(PG8_SA(0, 1), cA + hstep, voffA);
        if (wr == 1) PG8_BAR;
        PG8_WAIT_V(4); PG8_BAR;
        PG8_STAGE(PG8_SB(1, 0), cB + kstep, voffB); PG8_STAGE(PG8_SA(1, 0), cA + kstep, voffA); PG8_STAGE(PG8_SB(1, 1), cB + hstep + kstep, voffB);
        PG8_WAIT_V(6); PG8_BAR;
    }
    for (;;) {
        const bool has_next = S.next(ui + 1, nxt);
        const char* nA = has_next ? (const char*)g.A + (size_t)nxt.pm * tstep + (size_t)nxt.kh * K * 2 : cA; const char* nB = has_next ? (const char*)g.Bt + (size_t)nxt.pn * tstep + (size_t)nxt.kh * K * 2 : cB;
        for (int t = 0; t < nt; t += 2) {
            const bool last = (t == nt - 2);
            const char* a1 = cA + (size_t)(t + 1) * kstep;
            const char* a2 = last ? nA : cA + (size_t)(t + 2) * kstep; const char* b2 = last ? nB : cB + (size_t)(t + 2) * kstep;
            const char* a3 = a2 + kstep; const char* b3 = b2 + kstep;
            if (last && has_next) S.a_ready(nxt);
            if constexpr (SP2) {
            PG8_LDB(B0, 0, 0); PG8_LDB(B1, 0, 1); PG8_SCHED; PG8_LDA(At, 0, 0); PG8_STAGE(PG8_SA(1, 1), a1 + hstep, voffA);
            PG8_WAIT_V(8); PG8_WAIT_L(0); PG8_BAR; PG8_MMA(0, 0, At, B0); PG8_MMA(0, 1, At, B1); PG8_BAR; PG8_SCHED;
            PG8_LDA(At, 0, 1); PG8_STAGE(PG8_SB(0, 0), b2, voffB); PG8_STAGE(PG8_SB(0, 1), b2 + hstep, voffB); PG8_STAGE(PG8_SA(0, 0), a2, voffA);
            PG8_WAIT_V(8); PG8_WAIT_L(0); PG8_BAR; PG8_MMA(1, 0, At, B0); PG8_MMA(1, 1, At, B1); PG8_BAR; PG8_SCHED;
            PG8_LDB(B0, 1, 0); PG8_LDB(B1, 1, 1); PG8_SCHED; PG8_LDA(At, 1, 0); PG8_STAGE(PG8_SA(0, 1), a2 + hstep, voffA);
            PG8_WAIT_V(8); PG8_WAIT_L(0); PG8_BAR; PG8_MMA(0, 0, At, B0); PG8_MMA(0, 1, At, B1); PG8_BAR; PG8_SCHED;
            PG8_LDA(At, 1, 1); PG8_STAGE(PG8_SB(1, 0), b3, voffB); PG8_STAGE(PG8_SB(1, 1), b3 + hstep, voffB); PG8_STAGE(PG8_SA(1, 0), a3, voffA);
            PG8_WAIT_V(8); PG8_WAIT_L(0); PG8_BAR; PG8_MMA(1, 0, At, B0); PG8_MMA(1, 1, At, B1); PG8_BAR; PG8_SCHED;
            } else {
            PG8_LDB(B0, 0, 0); PG8_SCHED; PG8_LDA(At, 0, 0); PG8_STAGE(PG8_SA(1, 1), a1 + hstep, voffA);
            PG8_WAIT_L(8); PG8_BAR; PG8_WAIT_L(0); PG8_MMA(0, 0, At, B0); PG8_BAR; PG8_SCHED;
            PG8_LDB(B1, 0, 1); PG8_STAGE(PG8_SB(0, 0), b2, voffB);
            PG8_BAR; PG8_WAIT_L(0); PG8_MMA(0, 1, At, B1); PG8_BAR;
            PG8_LDA(At, 0, 1); PG8_STAGE(PG8_SA(0, 0), a2, voffA);
            PG8_BAR; PG8_WAIT_L(0); PG8_MMA(1, 0, At, B0); PG8_BAR; PG8_SCHED;
            PG8_STAGE(PG8_SB(0, 1), b2 + hstep, voffB);
            PG8_WAIT_V(6); PG8_BAR; PG8_MMA(1, 1, At, B1); PG8_BAR;
            PG8_LDB(B0, 1, 0); PG8_SCHED; PG8_LDA(At, 1, 0); PG8_STAGE(PG8_SA(0, 1), a2 + hstep, voffA);
            PG8_WAIT_L(8); PG8_BAR; PG8_WAIT_L(0); PG8_MMA(0, 0, At, B0); PG8_BAR; PG8_SCHED;
            PG8_LDB(B1, 1, 1); PG8_STAGE(PG8_SB(1, 0), b3, voffB);
            PG8_BAR; PG8_WAIT_L(0); PG8_MMA(0, 1, At, B1); PG8_BAR;
            PG8_LDA(At, 1, 1); PG8_STAGE(PG8_SA(1, 0), a3, voffA);
            PG8_BAR; PG8_WAIT_L(0); PG8_MMA(1, 0, At, B0); PG8_BAR; PG8_SCHED;
            PG8_STAGE(PG8_SB(1, 1), b3 + hstep, voffB);
            PG8_WAIT_V(6); PG8_BAR; PG8_MMA(1, 1, At, B1); PG8_BAR;
            }
        }
        if constexpr (ALIGN_EPI) { if (wr == 0) PG8_BAR; }
        if constexpr (!Epi::AFTER_DRAIN) { E(acc, cur, wr, wc, fr, fq); S.done(cur); }
        if (!has_next) break;
        if (!E.keep(cur))
#pragma unroll
        for (int a = 0; a < 2; ++a)
#pragma unroll
            for (int b = 0; b < 2; ++b)
#pragma unroll
                for (int m = 0; m < 4; ++m)
#pragma unroll
                    for (int n = 0; n < 2; ++n) acc[a][b][m][n] = (f32x4){0.f, 0.f, 0.f, 0.f};
        cur = nxt; cA = nA; cB = nB; ++ui;
        if constexpr (ALIGN_EPI) { if (wr == 1) PG8_BAR; }
    }
    PG8_WAIT_V(0);
    if constexpr (!ALIGN_EPI) { if (wr == 0) PG8_BAR; }
    PG8_BAR;
    if constexpr (Epi::AFTER_DRAIN) { E.fused(acc, cur, wr, wc, fr, fq, lds, wid, lane); S.done(cur); }
#undef PG8_SA
#undef PG8_SB
#undef PG8_STAGE
#undef PG8_LDA
#undef PG8_LDB
#undef PG8_MMA
#undef PG8_WAIT_V
#undef PG8_WAIT_L
#undef PG8_BAR
#undef PG8_SCHED
}
}

#define LAS __attribute__((address_space(3)))
using pg8::bf16_t; using pg8::bf16x8; using pg8::f32x4; using pg8::u32x4; using pg8::cvt_pk_bf16;
typedef unsigned u32x2 __attribute__((ext_vector_type(2)));
typedef short s16x4 __attribute__((ext_vector_type(4)));

constexpr int NT = 512, NWAVES = 8;
constexpr int M_TOK = 16384, DM = 2048, SEQ = 4096, NCH = 32, CL_ = 128;
constexpr int NIN = 16416;
constexpr int NPROJ = 16384;
constexpr float EPS = 1e-5f;
constexpr int LDS_BYTES = 147456;
#ifndef WGM_P1
#define WGM_P1 4
#endif
#ifndef WGM_P5
#define WGM_P5 4
#endif
#ifndef WGM_P6
#define WGM_P6 4
#endif
#ifndef PH_MASK
#define PH_MASK 0xFF
#endif

constexpr size_t MiB = 1048576;
constexpr size_t WS_BAR = 3 * MiB + 65536;
constexpr size_t WS_WDT = 0, WS_WSB = 131072, WS_STATS = 393216, WS_SSQ = 524288, WS_CD = 589824, WS_DT = 1 * MiB;
constexpr size_t WS_WB = 4 * MiB, WS_WO = 20 * MiB, WS_YAB = 28 * MiB, WS_V = 156 * MiB, WS_XBC = 220 * MiB, WS_R = 348 * MiB, WS_GB = 412 * MiB, WS_CC = 476 * MiB, WS_END = 508 * MiB;

__device__ __forceinline__ float bf2f(unsigned short u) { return __uint_as_float(((unsigned)u) << 16); }
__device__ __forceinline__ float bflo(unsigned w) { return __uint_as_float(w << 16); }
__device__ __forceinline__ float bfhi(unsigned w) { return __uint_as_float(w & 0xffff0000u); }
__device__ __forceinline__ float silu_f(float v) { return v * __builtin_amdgcn_rcpf(1.0f + __expf(-v)); }
__device__ __forceinline__ float sigmoid_f(float v) { return __builtin_amdgcn_rcpf(1.0f + __expf(-v)); }
__device__ __forceinline__ float wave_sum(float v) {
#pragma unroll
    for (int o = 1; o < 64; o <<= 1) v += __shfl_xor(v, o);
    return v;
}
__device__ __forceinline__ void atomic_addf(float* p, float v) { __hip_atomic_fetch_add(p, v, __ATOMIC_RELAXED, __HIP_MEMORY_SCOPE_AGENT); }

template <int OFF> __device__ __forceinline__ bf16x8 tr_frag(unsigned a) {
    s16x4 lo, hi;
    asm volatile("ds_read_b64_tr_b16 %0, %2\n\tds_read_b64_tr_b16 %1, %2 offset:%3\n\ts_waitcnt lgkmcnt(0)" : "=&v"(lo), "=&v"(hi) : "v"(a), "n"(OFF) : "memory");
    return (bf16x8){lo[0], lo[1], lo[2], lo[3], hi[0], hi[1], hi[2], hi[3]};
}

template <int OFF, int STEP> __device__ __forceinline__ void tr_frag2(unsigned a, bf16x8& f0, bf16x8& f1) {
    s16x4 l0, h0, l1, h1;
    asm volatile("ds_read_b64_tr_b16 %0, %4\n\tds_read_b64_tr_b16 %1, %4 offset:%5\n\tds_read_b64_tr_b16 %2, %4 offset:%6\n\tds_read_b64_tr_b16 %3, %4 offset:%7\n\ts_waitcnt lgkmcnt(0)"
                 : "=&v"(l0), "=&v"(h0), "=&v"(l1), "=&v"(h1) : "v"(a), "n"(OFF), "n"(STEP), "n"(STEP + OFF) : "memory");
    f0 = (bf16x8){l0[0], l0[1], l0[2], l0[3], h0[0], h0[1], h0[2], h0[3]}; f1 = (bf16x8){l1[0], l1[1], l1[2], l1[3], h1[0], h1[1], h1[2], h1[3]};
}
template <int OFF, int STEP> __device__ __forceinline__ void tr_frag4(unsigned a, bf16x8& f0, bf16x8& f1, bf16x8& f2, bf16x8& f3) {
    s16x4 l0, h0, l1, h1, l2, h2, l3, h3;
    asm volatile("ds_read_b64_tr_b16 %0, %8\n\tds_read_b64_tr_b16 %1, %8 offset:%9\n\tds_read_b64_tr_b16 %2, %8 offset:%10\n\tds_read_b64_tr_b16 %3, %8 offset:%11\n\t"
                 "ds_read_b64_tr_b16 %4, %8 offset:%12\n\tds_read_b64_tr_b16 %5, %8 offset:%13\n\tds_read_b64_tr_b16 %6, %8 offset:%14\n\tds_read_b64_tr_b16 %7, %8 offset:%15\n\ts_waitcnt lgkmcnt(0)"
                 : "=&v"(l0), "=&v"(h0), "=&v"(l1), "=&v"(h1), "=&v"(l2), "=&v"(h2), "=&v"(l3), "=&v"(h3)
                 : "v"(a), "n"(OFF), "n"(STEP), "n"(STEP + OFF), "n"(2 * STEP), "n"(2 * STEP + OFF), "n"(3 * STEP), "n"(3 * STEP + OFF) : "memory");
    f0 = (bf16x8){l0[0], l0[1], l0[2], l0[3], h0[0], h0[1], h0[2], h0[3]}; f1 = (bf16x8){l1[0], l1[1], l1[2], l1[3], h1[0], h1[1], h1[2], h1[3]};
    f2 = (bf16x8){l2[0], l2[1], l2[2], l2[3], h2[0], h2[1], h2[2], h2[3]}; f3 = (bf16x8){l3[0], l3[1], l3[2], l3[3], h3[0], h3[1], h3[2], h3[3]};
}

struct Args {
    const float* x; const float* norm_w; const float* w_in; const float* b_gate; const float* ln_w; const float* ln_b; const float* w_sp; const float* b_sp;
    const float* conv_w; const float* conv_b; const float* dt_bias; const float* a_log; const float* d_skip; const float* ssm_nw; const float* w_branch; const float* w_out; const float* fnw;
    float* out; unsigned char* ws;
};

struct EpiProj {
    static constexpr bool PERM = true, AFTER_DRAIN = false;
    __device__ __forceinline__ bool keep(const pg8::Unit&) const { return false; }
    bf16_t* YAB; bf16_t* V; bf16_t* XBC; bf16_t* R; bf16_t* GB; float* stats; const float* b_gate;
    __device__ __forceinline__ void operator()(const f32x4 (&acc)[2][2][4][2], const pg8::Unit& u, int wr, int wc, int fr, int fq) const {
        const int row0 = u.pm * 256 + wr * 64 + fr, pn = u.pn, cl = wc * 32 + 8 * fq;
        if (pn < 16) {
#pragma unroll
            for (int ai = 0; ai < 2; ++ai)
#pragma unroll
                for (int m = 0; m < 4; ++m) {
                    const f32x4 u0 = acc[ai][0][m][0], u1 = acc[ai][0][m][1], z0 = acc[ai][1][m][0], z1 = acc[ai][1][m][1];
                    u32x4 w;
                    w.x = cvt_pk_bf16(silu_f(z0[0]) * u0[0], silu_f(z0[1]) * u0[1]); w.y = cvt_pk_bf16(silu_f(z0[2]) * u0[2], silu_f(z0[3]) * u0[3]);
                    w.z = cvt_pk_bf16(silu_f(z1[0]) * u1[0], silu_f(z1[1]) * u1[1]); w.w = cvt_pk_bf16(silu_f(z1[2]) * u1[2], silu_f(z1[3]) * u1[3]);
                    *(u32x4*)(YAB + (size_t)(row0 + ai * 128 + m * 16) * 4096 + pn * 128 + cl) = w;
                }
        } else if (pn < 24) {
            const int c0 = (pn - 16) * 256 + cl;
#pragma unroll
            for (int ai = 0; ai < 2; ++ai)
#pragma unroll
                for (int m = 0; m < 4; ++m) {
                    const int row = row0 + ai * 128 + m * 16; float s = 0.f, q = 0.f;
#pragma unroll
                    for (int bj = 0; bj < 2; ++bj) {
                        const f32x4 v0 = acc[ai][bj][m][0], v1 = acc[ai][bj][m][1];
                        s += (v0[0] + v0[1]) + (v0[2] + v0[3]) + (v1[0] + v1[1]) + (v1[2] + v1[3]);
                        q += (v0[0] * v0[0] + v0[1] * v0[1]) + (v0[2] * v0[2] + v0[3] * v0[3]) + (v1[0] * v1[0] + v1[1] * v1[1]) + (v1[2] * v1[2] + v1[3] * v1[3]);
                        u32x4 w; w.x = cvt_pk_bf16(v0[0], v0[1]); w.y = cvt_pk_bf16(v0[2], v0[3]); w.z = cvt_pk_bf16(v1[0], v1[1]); w.w = cvt_pk_bf16(v1[2], v1[3]);
                        *(u32x4*)(V + (size_t)row * 2048 + c0 + bj * 128) = w;
                    }
                    s += __shfl_xor(s, 16); s += __shfl_xor(s, 32); q += __shfl_xor(q, 16); q += __shfl_xor(q, 32);
                    if (fq == 0) { atomic_addf(stats + 2 * row, s); atomic_addf(stats + 2 * row + 1, q); }
                }
        } else if (pn < 32) {
            const int c0 = (pn - 24) * 256 + cl;
#pragma unroll
            for (int ai = 0; ai < 2; ++ai)
#pragma unroll
                for (int m = 0; m < 4; ++m)
#pragma unroll
                    for (int bj = 0; bj < 2; ++bj) {
                        const f32x4 v0 = acc[ai][bj][m][0], v1 = acc[ai][bj][m][1];
                        u32x4 w; w.x = cvt_pk_bf16(silu_f(v0[0]), silu_f(v0[1])); w.y = cvt_pk_bf16(silu_f(v0[2]), silu_f(v0[3])); w.z = cvt_pk_bf16(silu_f(v1[0]), silu_f(v1[1])); w.w = cvt_pk_bf16(silu_f(v1[2]), silu_f(v1[3]));
                        *(u32x4*)(YAB + (size_t)(row0 + ai * 128 + m * 16) * 4096 + 2048 + c0 + bj * 128) = w;
                    }
        } else if (pn < 48) {
            const int c0 = (pn - 32) * 256 + cl;
#pragma unroll
            for (int ai = 0; ai < 2; ++ai)
#pragma unroll
                for (int m = 0; m < 4; ++m)
#pragma unroll
                    for (int bj = 0; bj < 2; ++bj) {
                        const f32x4 v0 = acc[ai][bj][m][0], v1 = acc[ai][bj][m][1];
                        u32x4 w; w.x = cvt_pk_bf16(v0[0], v0[1]); w.y = cvt_pk_bf16(v0[2], v0[3]); w.z = cvt_pk_bf16(v1[0], v1[1]); w.w = cvt_pk_bf16(v1[2], v1[3]);
                        *(u32x4*)(XBC + (size_t)(row0 + ai * 128 + m * 16) * 4096 + c0 + bj * 128) = w;
                    }
        } else {
            const int c0 = (pn - 48) * 128 + cl;
            const f32x4 ba0 = *(const f32x4*)(b_gate + c0), ba1 = *(const f32x4*)(b_gate + c0 + 4), bb0 = *(const f32x4*)(b_gate + 2048 + c0), bb1 = *(const f32x4*)(b_gate + 2048 + c0 + 4);
#pragma unroll
            for (int ai = 0; ai < 2; ++ai)
#pragma unroll
                for (int m = 0; m < 4; ++m) {
                    f32x4 a0 = acc[ai][0][m][0] + ba0, a1 = acc[ai][0][m][1] + ba1, b0 = acc[ai][1][m][0] + bb0, b1 = acc[ai][1][m][1] + bb1;
#pragma unroll
                    for (int j = 0; j < 4; ++j) { a0[j] = fminf(fmaxf(a0[j], -30.f), 30.f); a1[j] = fminf(fmaxf(a1[j], -30.f), 30.f); b0[j] = fminf(fmaxf(b0[j], -30.f), 30.f); b1[j] = fminf(fmaxf(b1[j], -30.f), 30.f); }
                    float ea[8], eb[8], rr[8], gb[8];
#pragma unroll
                    for (int j = 0; j < 4; ++j) { ea[j] = 1.0f + __expf(-a0[j]); ea[4 + j] = 1.0f + __expf(-a1[j]); eb[j] = 1.0f + __expf(-b0[j]); eb[4 + j] = 1.0f + __expf(-b1[j]); }
#pragma unroll
                    for (int j = 0; j < 8; ++j) { rr[j] = eb[j] * __builtin_amdgcn_rcpf(ea[j]); gb[j] = 1.0f * __builtin_amdgcn_rcpf(eb[j]); }
                    u32x4 wr_, wg_;
                    wr_.x = cvt_pk_bf16(rr[0], rr[1]); wr_.y = cvt_pk_bf16(rr[2], rr[3]); wr_.z = cvt_pk_bf16(rr[4], rr[5]); wr_.w = cvt_pk_bf16(rr[6], rr[7]);
                    wg_.x = cvt_pk_bf16(gb[0], gb[1]); wg_.y = cvt_pk_bf16(gb[2], gb[3]); wg_.z = cvt_pk_bf16(gb[4], gb[5]); wg_.w = cvt_pk_bf16(gb[6], gb[7]);
                    const size_t o = ((((((size_t)u.pm * 8 + ((pn - 48) >> 1)) * 2 + ((pn - 48) & 1)) * 2 + ai) * 4 + m) * 8 + (wr * 4 + wc)) * 512 + (size_t)(fr + 16 * fq) * 8;
                    *(u32x4*)(R + o) = wr_; *(u32x4*)(GB + o) = wg_;
                }
        }
    }
};
__device__ __forceinline__ void merge_store(const bf16_t* __restrict__ GB, bf16_t* __restrict__ merged, const f32x4 (&acc)[2][2][4][2], int row0, int col0, size_t gbase, int wl) {
#pragma unroll
    for (int ai = 0; ai < 2; ++ai) {
        u32x4 gv[4][2];
#pragma unroll
        for (int m = 0; m < 4; ++m)
#pragma unroll
            for (int bj = 0; bj < 2; ++bj) gv[m][bj] = *(const u32x4*)(GB + ((((gbase * 2 + bj) * 2 + ai) * 4 + m) * 8) * 512 + wl);
#pragma unroll
        for (int m = 0; m < 4; ++m)
#pragma unroll
            for (int bj = 0; bj < 2; ++bj) { const u32x4 g = gv[m][bj]; const f32x4 v0 = acc[ai][bj][m][0], v1 = acc[ai][bj][m][1];
                u32x4 w; w.x = cvt_pk_bf16(v0[0] * bflo(g.x), v0[1] * bfhi(g.x)); w.y = cvt_pk_bf16(v0[2] * bflo(g.y), v0[3] * bfhi(g.y));
                w.z = cvt_pk_bf16(v1[0] * bflo(g.z), v1[1] * bfhi(g.z)); w.w = cvt_pk_bf16(v1[2] * bflo(g.w), v1[3] * bfhi(g.w));
                *(u32x4*)(merged + (size_t)(row0 + ai * 128 + m * 16) * 2048 + col0 + bj * 128) = w; }
    }
}
struct EpiMerge {
    static constexpr bool PERM = true, AFTER_DRAIN = false;
    const bf16_t* R; const bf16_t* GB; bf16_t* merged;
    __device__ __forceinline__ bool keep(const pg8::Unit& u) const { return u.kh == 0; }
    __device__ __forceinline__ void operator()(f32x4 (&acc)[2][2][4][2], const pg8::Unit& u, int wr, int wc, int fr, int fq) const {
        const int row0 = u.pm * 256 + wr * 64 + fr, col0 = u.pn * 256 + wc * 32 + 8 * fq;
        const size_t gbase = (size_t)u.pm * 8 + u.pn; const int wl = (wr * 4 + wc) * 512 + (fr + 16 * fq) * 8;
        if (u.kh == 0) {
#pragma unroll
            for (int ai = 0; ai < 2; ++ai) {
                u32x4 rv[4][2];
#pragma unroll
                for (int m = 0; m < 4; ++m)
#pragma unroll
                    for (int bj = 0; bj < 2; ++bj) rv[m][bj] = *(const u32x4*)(R + ((((gbase * 2 + bj) * 2 + ai) * 4 + m) * 8) * 512 + wl);
#pragma unroll
                for (int m = 0; m < 4; ++m)
#pragma unroll
                    for (int bj = 0; bj < 2; ++bj) { const u32x4 g = rv[m][bj];
                        f32x4 v0 = acc[ai][bj][m][0], v1 = acc[ai][bj][m][1];
                        v0[0] *= bflo(g.x); v0[1] *= bfhi(g.x); v0[2] *= bflo(g.y); v0[3] *= bfhi(g.y); v1[0] *= bflo(g.z); v1[1] *= bfhi(g.z); v1[2] *= bflo(g.w); v1[3] *= bfhi(g.w);
                        acc[ai][bj][m][0] = v0; acc[ai][bj][m][1] = v1; }
            }
        } else merge_store(GB, merged, acc, row0, col0, gbase, wl);
    }
};
struct SplitKOrder : pg8::StaticOrder {
    __device__ bool next(int i, pg8::Unit& u) const { const bool ok = pg8::StaticOrder::next(i >> 1, u); u.kh = i & 1; return ok; }
};
__device__ __forceinline__ void out_store(const float* __restrict__ x, float* __restrict__ out, float* __restrict__ ssq, const f32x4 (&acc)[2][2][4][2], int row0, int col0, int fq) {
    f32x4 xv[2][4];
#pragma unroll
    for (int bj = 0; bj < 2; ++bj)
#pragma unroll
        for (int n = 0; n < 2; ++n) xv[0][bj * 2 + n] = *(const f32x4*)(x + (size_t)row0 * 2048 + col0 + bj * 128 + n * 16);
#pragma unroll
    for (int gi = 0; gi < 8; ++gi) {
        const int ai = gi >> 2, m = gi & 3;
        if (gi < 7) { const int ai2 = (gi + 1) >> 2, m2 = (gi + 1) & 3;
#pragma unroll
            for (int bj = 0; bj < 2; ++bj)
#pragma unroll
                for (int n = 0; n < 2; ++n) xv[(gi + 1) & 1][bj * 2 + n] = *(const f32x4*)(x + (size_t)(row0 + ai2 * 128 + m2 * 16) * 2048 + col0 + bj * 128 + n * 16); }
        const size_t row = (size_t)(row0 + ai * 128 + m * 16); float q = 0.f;
#pragma unroll
        for (int bj = 0; bj < 2; ++bj)
#pragma unroll
            for (int n = 0; n < 2; ++n) { const f32x4 r = xv[gi & 1][bj * 2 + n] + acc[ai][bj][m][n];
                q += (r[0] * r[0] + r[1] * r[1]) + (r[2] * r[2] + r[3] * r[3]);
                *(f32x4*)(out + row * 2048 + col0 + bj * 128 + n * 16) = r; }
        q += __shfl_xor(q, 16); q += __shfl_xor(q, 32);
        if (fq == 0) atomic_addf(ssq + row, q);
    }
}
struct EpiOut {
    static constexpr bool PERM = false, AFTER_DRAIN = false;
    __device__ __forceinline__ bool keep(const pg8::Unit&) const { return false; }
    const float* x; float* out; float* ssq;
    __device__ __forceinline__ void operator()(const f32x4 (&acc)[2][2][4][2], const pg8::Unit& u, int wr, int wc, int fr, int fq) const {
        out_store(x, out, ssq, acc, u.pm * 256 + wr * 64 + fr, u.pn * 256 + wc * 32 + 4 * fq, fq);
    }
};

struct EpiAcc {
    static constexpr bool PERM = true, AFTER_DRAIN = false;
    __device__ __forceinline__ bool keep(const pg8::Unit&) const { return false; }
    bf16_t* O;
    __device__ __forceinline__ void operator()(const f32x4 (&acc)[2][2][4][2], const pg8::Unit& u, int wr, int wc, int fr, int fq) const {
        const int row0 = u.pm * 256 + wr * 64 + fr, col0 = u.pn * 256 + wc * 32 + 8 * fq;
#pragma unroll
        for (int ai = 0; ai < 2; ++ai)
#pragma unroll
            for (int m = 0; m < 4; ++m)
#pragma unroll
                for (int bj = 0; bj < 2; ++bj) {
                    const f32x4 v0 = acc[ai][bj][m][0], v1 = acc[ai][bj][m][1];
                    u32x4 w; w.x = cvt_pk_bf16(v0[0], v0[1]); w.y = cvt_pk_bf16(v0[2], v0[3]); w.z = cvt_pk_bf16(v1[0], v1[1]); w.w = cvt_pk_bf16(v1[2], v1[3]);
                    *(u32x4*)(O + (size_t)(row0 + ai * 128 + m * 16) * 2048 + col0 + bj * 128) = w;
                }
    }
};

__device__ __forceinline__ void transpose_item(const float* W, int ldw, int K, int k0, int n0, bf16_t* dst, LAS float* scr, int lane, int kd = -1) {
    if (kd < 0) kd = k0;
#pragma unroll 8
    for (int i = 0; i < 32; ++i) { const int kk = 2 * i + (lane >> 5); scr[kk * 33 + (lane & 31)] = W[(size_t)(k0 + kk) * ldw + n0 + (lane & 31)]; }
    asm volatile("s_waitcnt lgkmcnt(0)" ::: "memory");
    const int c = lane & 7;
#pragma unroll
    for (int j = 0; j < 4; ++j) { const int n = (lane >> 3) + 8 * j; const LAS float* s = scr + (8 * c) * 33 + n;
        u32x4 o; o.x = cvt_pk_bf16(s[0 * 33], s[1 * 33]); o.y = cvt_pk_bf16(s[2 * 33], s[3 * 33]); o.z = cvt_pk_bf16(s[4 * 33], s[5 * 33]); o.w = cvt_pk_bf16(s[6 * 33], s[7 * 33]);
        *(u32x4*)(dst + (size_t)n * K + kd + 8 * c) = o; }
    asm volatile("s_waitcnt lgkmcnt(0)" ::: "memory");
}
struct TItem { const float* src; bf16_t* dst; int ldw, ldd; };
__device__ __forceinline__ void titem_load(const TItem& t, f32x4 (&v)[16], int lane) {
    const int r4 = lane >> 4, c4 = lane & 15;
#pragma unroll
    for (int i = 0; i < 16; ++i) v[i] = *(const f32x4*)(t.src + (size_t)(4 * i + r4) * t.ldw + 4 * c4);
}
__device__ __forceinline__ void titem_finish(const TItem& t, const f32x4 (&v)[16], LAS float* scr, int lane) {
    const int r4 = lane >> 4, c4 = lane & 15;
#pragma unroll
    for (int i = 0; i < 16; ++i) { LAS float* p = scr + (4 * i + r4) * 65 + 4 * c4; p[0] = v[i][0]; p[1] = v[i][1]; p[2] = v[i][2]; p[3] = v[i][3]; }
    asm volatile("s_waitcnt lgkmcnt(0)" ::: "memory");
    const int c = lane & 7;
#pragma unroll
    for (int i = 0; i < 8; ++i) { const int n = (lane >> 3) + 8 * i; const LAS float* s = scr + (8 * c) * 65 + n;
        u32x4 o; o.x = cvt_pk_bf16(s[0 * 65], s[1 * 65]); o.y = cvt_pk_bf16(s[2 * 65], s[3 * 65]); o.z = cvt_pk_bf16(s[4 * 65], s[5 * 65]); o.w = cvt_pk_bf16(s[6 * 65], s[7 * 65]);
        *(u32x4*)(t.dst + (size_t)n * t.ldd + 8 * c) = o; }
    asm volatile("s_waitcnt lgkmcnt(0)" ::: "memory");
}
__device__ __forceinline__ int proj_row(int n0) {
    if (n0 < 2048) return 256 * (n0 >> 7) + (n0 & 127);
    if (n0 < 4096) return 4096 + (n0 - 2048);
    if (n0 < 6144) { const int ch = n0 - 4096; return 256 * (ch >> 7) + 128 + (ch & 127); }
    if (n0 < 12288) return n0;
    if (n0 < 12320) return -1;
    { const int c = n0 - 12320, n = c >> 11, ch = c & 2047; return 12288 + 256 * (ch >> 7) + 128 * n + (ch & 127); }
}

template <int W> struct ConvRaw { static constexpr int CG = W / 8, RB = NT / CG, RPT = 128 / RB; u32x4 r[RPT + 3]; };
template <int W>
__device__ __forceinline__ void stage_conv_load(ConvRaw<W>& raw, const bf16_t* xbc, int tok0, int cidx, int col0, int tid) {
    constexpr int CG = ConvRaw<W>::CG, RPT = ConvRaw<W>::RPT;
    const int cgi = tid % CG, rb = tid / CG, r0 = rb * RPT;
    const bf16_t* src = xbc + (size_t)tok0 * 4096 + col0 + cgi * 8;
#pragma unroll
    for (int i = 0; i < RPT + 3; ++i) { const int r = r0 - 3 + i;
        if (cidx == 0 && r < 0) raw.r[i] = (u32x4){0u, 0u, 0u, 0u}; else raw.r[i] = *(const u32x4*)(src + (ptrdiff_t)r * 4096); }
}
template <int W>
__device__ __forceinline__ void stage_conv_finish(const ConvRaw<W>& raw, LAS unsigned char* dst, int stride, int col0, const float* conv_w, const float* conv_b, const LAS float* scale, int tid, bf16_t* gdst = nullptr, int gstride = 0) {
    constexpr int CG = ConvRaw<W>::CG, RPT = ConvRaw<W>::RPT;
    const int cgi = tid % CG, rb = tid / CG, r0 = rb * RPT, ch0 = col0 + cgi * 8;
    float w[4][8], bias[8], h0[8], h1[8], h2[8];
#pragma unroll
    for (int k = 0; k < 4; ++k) { const f32x4 a = *(const f32x4*)(conv_w + k * 4096 + ch0), b = *(const f32x4*)(conv_w + k * 4096 + ch0 + 4);
#pragma unroll
        for (int j = 0; j < 4; ++j) { w[k][j] = a[j]; w[k][4 + j] = b[j]; } }
    { const f32x4 a = *(const f32x4*)(conv_b + ch0), b = *(const f32x4*)(conv_b + ch0 + 4);
#pragma unroll
      for (int j = 0; j < 4; ++j) { bias[j] = a[j]; bias[4 + j] = b[j]; } }
#define UNPK(v_, o) do { o[0] = bflo(v_.x); o[1] = bfhi(v_.x); o[2] = bflo(v_.y); o[3] = bfhi(v_.y); o[4] = bflo(v_.z); o[5] = bfhi(v_.z); o[6] = bflo(v_.w); o[7] = bfhi(v_.w); } while (0)
    UNPK(raw.r[0], h0); UNPK(raw.r[1], h1); UNPK(raw.r[2], h2);
#pragma unroll
    for (int i = 0; i < RPT; ++i) {
        float cur[8], o[8]; UNPK(raw.r[3 + i], cur);
        float sc = 1.0f; if (scale) sc = scale[(cgi >> 3) * 128 + r0 + i];
#pragma unroll
        for (int j = 0; j < 8; ++j) { float v = bias[j] + w[0][j] * h0[j] + w[1][j] * h1[j] + w[2][j] * h2[j] + w[3][j] * cur[j]; o[j] = silu_f(v) * sc; h0[j] = h1[j]; h1[j] = h2[j]; h2[j] = cur[j]; }
        u32x4 pk; pk.x = cvt_pk_bf16(o[0], o[1]); pk.y = cvt_pk_bf16(o[2], o[3]); pk.z = cvt_pk_bf16(o[4], o[5]); pk.w = cvt_pk_bf16(o[6], o[7]);
        { LAS unsigned char* q_ = dst + (r0 + i) * stride + (32 * (cgi >> 2) + 4 * (cgi & 3)) * 2;
          *(LAS u32x2*)q_ = (u32x2){pk.x, pk.y}; *(LAS u32x2*)(q_ + 32) = (u32x2){pk.z, pk.w}; }
        if (gdst) *(u32x4*)(gdst + (size_t)(r0 + i) * gstride + cgi * 8) = pk;
    }
#undef UNPK
}
__device__ __forceinline__ float chunk_prefix(LAS float* adt, LAS float* ac, const float* DT, const float* a_log, int tok0, int g, int tid) {
    const int k = tid >> 7, l = tid & 127, h = g * 4 + k, lane = tid & 63;
    const float dtv = DT[(size_t)h * M_TOK + tok0 + l];
    const float a = -expf(a_log[h]);
    float s = dtv * a;
#pragma unroll
    for (int o = 1; o < 64; o <<= 1) { const float t = __shfl_up(s, o); if (lane >= o) s += t; }
    if (lane == 63) adt[tid >> 6] = s;
    __syncthreads();
    if (l >= 64) s += adt[(tid >> 6) - 1];
    ac[k * 128 + l] = s;
    __syncthreads();
    return dtv;
}

constexpr int XS_STRIDE = 528, CB_STRIDE = 272;

__device__ __forceinline__ void own_barrier(unsigned* bar, unsigned target) {
    if (threadIdx.x == 0) {
        __hip_atomic_fetch_add(bar, 1u, __ATOMIC_RELAXED, __HIP_MEMORY_SCOPE_AGENT);
        const unsigned long long t0 = __builtin_amdgcn_s_memrealtime();
        while (__hip_atomic_load(bar, __ATOMIC_RELAXED, __HIP_MEMORY_SCOPE_AGENT) < target) {
            __builtin_amdgcn_s_sleep(2);
            if (__builtin_amdgcn_s_memrealtime() - t0 > 200000000ull) break;
        }
    }
    __syncthreads();
}
#define GRID_SYNC(i) do { asm volatile("s_waitcnt vmcnt(0) lgkmcnt(0)" ::: "memory"); grid.sync(); \
    __builtin_amdgcn_fence(__ATOMIC_ACQUIRE, "agent"); asm volatile("s_waitcnt vmcnt(0)" ::: "memory"); __syncthreads(); STAMP(i); } while (0)
#ifdef SPIN_PHASE
#define STAMP(i) do { if (bx == 0 && tid == 0) { ((unsigned long long*)(BAR + 16))[i] = __builtin_amdgcn_s_memrealtime(); } } while (0)
#else
#define STAMP(i) do { } while (0)
#endif
#ifdef SPIN_SUB
#define SUBSTAMP(i) do { if (bx == 0 && tid == 0 && j == 0) ((unsigned long long*)(BAR + 16))[16 + (i)] = __builtin_amdgcn_s_memrealtime(); } while (0)
#else
#define SUBSTAMP(i) do { } while (0)
#endif
__global__ void __launch_bounds__(NT, 2) fwd_megakernel(Args A) {
    extern __shared__ __attribute__((aligned(16))) unsigned char lds_raw[];
    LAS unsigned char* lds = (LAS unsigned char*)lds_raw;
    const unsigned lds_u32 = (unsigned)(size_t)lds_raw;
    cg::grid_group grid = cg::this_grid();
    const int tid = threadIdx.x, lane = tid & 63, wave = __builtin_amdgcn_readfirstlane(tid >> 6), fr = lane & 15, fq = lane >> 4;
    const int G = gridDim.x, bx = blockIdx.x;
    const int gw = bx * NWAVES + wave, NGW = G * NWAVES;
    unsigned char* ws = A.ws;
    bf16_t* WinT = (bf16_t*)A.out; bf16_t* H = (bf16_t*)((unsigned char*)A.out + 64 * MiB);
    bf16_t* STATES = (bf16_t*)A.out;
    bf16_t* WdtT = (bf16_t*)(ws + WS_WDT); bf16_t* WsB = (bf16_t*)(ws + WS_WSB); float* STATS = (float*)(ws + WS_STATS); float* SSQ = (float*)(ws + WS_SSQ);
    float* CD = (float*)(ws + WS_CD); float* DT = (float*)(ws + WS_DT); unsigned* BAR = (unsigned*)(ws + WS_BAR); unsigned bar_epoch = 0;
    bf16_t* WbT = (bf16_t*)(ws + WS_WB); bf16_t* WoT = (bf16_t*)(ws + WS_WO); bf16_t* YAB = (bf16_t*)(ws + WS_YAB); bf16_t* V = (bf16_t*)(ws + WS_V);
    bf16_t* PREV = (bf16_t*)(ws + WS_V); bf16_t* MERGED = (bf16_t*)(ws + WS_V);
    bf16_t* CC = (bf16_t*)(ws + WS_CC); bf16_t* YD = (bf16_t*)((unsigned char*)A.out + 64 * MiB);
    bf16_t* XBC = (bf16_t*)(ws + WS_XBC); bf16_t* RG = (bf16_t*)(ws + WS_R); bf16_t* GB = (bf16_t*)(ws + WS_GB);

    STAMP(0);
    if constexpr ((PH_MASK >> 0) & 1)
    {
        LAS float* scr = (LAS float*)(lds + wave * 16640);
        constexpr int I_IN = 32 * 256, I_B = 32 * 32, I_O = 32 * 32, NITEMS = I_IN + 2 * I_B + I_O;
        auto item_of = [&](int it) -> TItem {
            TItem t; int r = it;
            if (r < I_IN) { const int kb = r >> 8, nb = r & 255, n0 = nb < 192 ? 64 * nb : 12320 + 64 * (nb - 192);
                t.src = A.w_in + (size_t)(64 * kb) * NIN + n0; t.ldw = NIN; t.dst = WinT + (size_t)proj_row(n0) * 2048 + 64 * kb; t.ldd = 2048; return t; }
            r -= I_IN;
            if (r < 2 * I_B) { const int nbr = r / I_B, rr = r % I_B, kb = rr >> 5, nb = rr & 31;
                t.src = A.w_branch + (size_t)nbr * 2048 * 2048 + (size_t)(64 * kb) * 2048 + 64 * nb; t.ldw = 2048; t.dst = WbT + (size_t)(64 * nb) * 4096 + nbr * 2048 + 64 * kb; t.ldd = 4096; return t; }
            r -= 2 * I_B;
            { const int kb = r >> 5, nb = r & 31; t.src = A.w_out + (size_t)(64 * kb) * 2048 + 64 * nb; t.ldw = 2048; t.dst = WoT + (size_t)(64 * nb) * 2048 + 64 * kb; t.ldd = 2048; return t; }
        };
        {
            f32x4 va[16], vb[16]; int it = gw; TItem ta, tb;
            if (it < NITEMS) { ta = item_of(it); titem_load(ta, va, lane); }
            while (it < NITEMS) {
                const int it2 = it + NGW, it3 = it2 + NGW;
                if (it2 < NITEMS) { tb = item_of(it2); titem_load(tb, vb, lane); }
                titem_finish(ta, va, scr, lane);
                if (it3 < NITEMS) { ta = item_of(it3); titem_load(ta, va, lane); }
                if (it2 < NITEMS) titem_finish(tb, vb, scr, lane);
                it = it3;
            }
        }
        for (int r = gw; r < 32; r += NGW) transpose_item(A.w_in, NIN, 2048, 64 * r, 12288, WdtT, scr, lane);
        for (int i = bx * NT + tid; i < 8 * 128 * 128; i += G * NT) { const int t = (i >> 7) & 127, s = i & 127; const float v = (s <= t) ? A.w_sp[i] : 0.f; WsB[i] = (bf16_t)(cvt_pk_bf16(v, 0.f) & 0xffffu); }
        for (int i = bx * NT + tid; i < 2 * M_TOK; i += G * NT) STATS[i] = 0.f;
        for (int i = bx * NT + tid; i < M_TOK; i += G * NT) SSQ[i] = 0.f;
        for (int m = gw; m < M_TOK; m += 2 * NGW) {
            const int m2 = m + NGW;
            const f32x4* xr = (const f32x4*)(A.x + (size_t)m * DM) + lane; const f32x4* xr2 = (const f32x4*)(A.x + (size_t)m2 * DM) + lane; const f32x4* wr4 = (const f32x4*)A.norm_w + lane;
            f32x4 v[8], v2[8]; float s = 0.f, s2 = 0.f;
#pragma unroll
            for (int j = 0; j < 8; ++j) { v[j] = xr[64 * j]; v2[j] = xr2[64 * j]; }
#pragma unroll
            for (int j = 0; j < 8; ++j) { s += (v[j][0] * v[j][0] + v[j][1] * v[j][1]) + (v[j][2] * v[j][2] + v[j][3] * v[j][3]); s2 += (v2[j][0] * v2[j][0] + v2[j][1] * v2[j][1]) + (v2[j][2] * v2[j][2] + v2[j][3] * v2[j][3]); }
            const float rstd = 1.0f / sqrtf(wave_sum(s) * (1.0f / DM) + EPS), rstd2 = 1.0f / sqrtf(wave_sum(s2) * (1.0f / DM) + EPS);
            u32x2* o8 = (u32x2*)(H + (size_t)m * DM) + lane; u32x2* o82 = (u32x2*)(H + (size_t)m2 * DM) + lane;
#pragma unroll
            for (int j = 0; j < 8; ++j) { const f32x4 w4 = wr4[64 * j];
                u32x2 o; o.x = cvt_pk_bf16(v[j][0] * rstd * w4[0], v[j][1] * rstd * w4[1]); o.y = cvt_pk_bf16(v[j][2] * rstd * w4[2], v[j][3] * rstd * w4[3]); o8[64 * j] = o;
                u32x2 o2; o2.x = cvt_pk_bf16(v2[j][0] * rstd2 * w4[0], v2[j][1] * rstd2 * w4[1]); o2.y = cvt_pk_bf16(v2[j][2] * rstd2 * w4[2], v2[j][3] * rstd2 * w4[3]); o82[64 * j] = o2; }
        }
    }
    GRID_SYNC(1);

    if constexpr ((PH_MASK >> 1) & 1)
    {
        pg8::Gemm g{H, WinT, M_TOK, NPROJ, DM, DM}; pg8::StaticOrder S; S.init(M_TOK, NPROJ, G, bx, WGM_P1);
        EpiProj E{YAB, V, XBC, RG, GB, STATS, A.b_gate};
        pg8::gemm_phase<EpiProj, pg8::StaticOrder, true, true>(lds, g, S, E);
        {
            constexpr int WROW = 4112;
#pragma unroll
            for (int i = 0; i < 16; ++i) { const int row = 2 * i + (tid >> 8), ch = tid & 255;
                *(LAS u32x4*)(lds + row * WROW + ch * 16) = *(const u32x4*)(WdtT + (size_t)row * DM + ch * 8); }
            __syncthreads();
            for (int t0 = bx * 4; t0 < M_TOK / 16; t0 += G * 4) {
                const int t = t0 + (wave >> 1), kh = wave & 1;
                f32x4 acc0 = {0.f, 0.f, 0.f, 0.f}, acc1 = {0.f, 0.f, 0.f, 0.f};
                const bf16_t* ap = H + (size_t)(16 * t + fr) * DM + 8 * fq + kh * 1024;
                const LAS unsigned char* bp = lds + fr * WROW + (8 * fq + kh * 1024) * 2;
#pragma unroll 16
                for (int ks = 0; ks < 32; ++ks) {
                    const bf16x8 fa = *(const bf16x8*)(ap + 32 * ks), fb0 = *(const LAS bf16x8*)(bp + 64 * ks), fb1 = *(const LAS bf16x8*)(bp + 16 * WROW + 64 * ks);
                    acc0 = __builtin_amdgcn_mfma_f32_16x16x32_bf16(fb0, fa, acc0, 0, 0, 0);
                    acc1 = __builtin_amdgcn_mfma_f32_16x16x32_bf16(fb1, fa, acc1, 0, 0, 0);
                }
                LAS f32x4* xch = (LAS f32x4*)(lds + 32 * WROW) + (wave >> 1) * 128 + lane * 2;
                if (kh) { xch[0] = acc0; xch[1] = acc1; }
                __syncthreads();
                if (!kh) {
                    acc0 += xch[0]; acc1 += xch[1];
                    const f32x4 bb0 = *(const f32x4*)(A.dt_bias + 4 * fq), bb1 = *(const f32x4*)(A.dt_bias + 16 + 4 * fq);
                    f32x4 o0, o1;
#pragma unroll
                    for (int j = 0; j < 4; ++j) { const float v0 = acc0[j] + bb0[j], v1 = acc1[j] + bb1[j];
                        o0[j] = fmaxf(v0, 0.f) + log1pf(expf(-fabsf(v0))); o1[j] = fmaxf(v1, 0.f) + log1pf(expf(-fabsf(v1))); }
                    float* dp = DT + (size_t)(4 * fq) * M_TOK + 16 * t + fr;
#pragma unroll
                    for (int j = 0; j < 4; ++j) { dp[(size_t)j * M_TOK] = o0[j]; dp[(size_t)(16 + j) * M_TOK] = o1[j]; }
                }
                __syncthreads();
            }
        }
    }
    GRID_SYNC(2);

    if constexpr ((PH_MASK >> 2) & 1)
    for (int j = bx; j < 2048; j += G) {
        const int jj = j & 1023, g = jj & 7, bc = jj >> 3, tok0 = bc * 128, cidx = bc & 31;
        int tid = threadIdx.x; asm volatile("" : "+v"(tid));
        const int lane = tid & 63, fr = lane & 15, fq = lane >> 4;
        if (j < 1024) {
            {
                const bf16_t* wsrc = WsB + (size_t)g * 16384;
                u32x4 wv[4];
#pragma unroll
                for (int i = 0; i < 4; ++i) wv[i] = *(const u32x4*)(wsrc + (size_t)(i * 32 + (tid >> 4)) * 128 + (tid & 15) * 8);
#pragma unroll
                for (int i = 0; i < 4; ++i) *(LAS u32x4*)(lds + 67584 + (i * 32 + (tid >> 4)) * CB_STRIDE + (tid & 15) * 16) = wv[i];
            }
            bf16_t* p0 = YAB + (size_t)(tok0 + fr) * 4096 + g * 256 + 32 * wave + 8 * fq;
            u32x4 sv[8]; float bs[8];
#pragma unroll
            for (int mt = 0; mt < 8; ++mt) { bs[mt] = A.b_sp[g * 128 + 16 * mt + fr]; sv[mt] = *(const u32x4*)(p0 + (size_t)(16 * mt) * 4096); }
            {
                const int cgi = tid & 31, rb = tid >> 5, d0 = g * 256 + cgi * 8;
                const f32x4 lw0 = *(const f32x4*)(A.ln_w + d0), lw1 = *(const f32x4*)(A.ln_w + d0 + 4), lb0 = *(const f32x4*)(A.ln_b + d0), lb1 = *(const f32x4*)(A.ln_b + d0 + 4);
#pragma unroll
                for (int i = 0; i < 8; ++i) {
                    const int r = rb * 8 + i, tok = tok0 + r;
                    const float2 st2 = *(const float2*)(STATS + 2 * tok); const float mean = st2.x * (1.0f / 2048.0f), var = st2.y * (1.0f / 2048.0f) - mean * mean, rstd = 1.0f / sqrtf(fmaxf(var, 0.f) + EPS);
                    const u32x4 v = *(const u32x4*)(V + (size_t)tok * 2048 + d0);
                    u32x4 pk;
                    pk.x = cvt_pk_bf16((bflo(v.x) - mean) * rstd * lw0[0] + lb0[0], (bfhi(v.x) - mean) * rstd * lw0[1] + lb0[1]);
                    pk.y = cvt_pk_bf16((bflo(v.y) - mean) * rstd * lw0[2] + lb0[2], (bfhi(v.y) - mean) * rstd * lw0[3] + lb0[3]);
                    pk.z = cvt_pk_bf16((bflo(v.z) - mean) * rstd * lw1[0] + lb1[0], (bfhi(v.z) - mean) * rstd * lw1[1] + lb1[1]);
                    pk.w = cvt_pk_bf16((bflo(v.w) - mean) * rstd * lw1[2] + lb1[2], (bfhi(v.w) - mean) * rstd * lw1[3] + lb1[3]);
                    { LAS unsigned char* q_ = lds + r * XS_STRIDE + (32 * (cgi >> 2) + 4 * (cgi & 3)) * 2; *(LAS u32x2*)q_ = (u32x2){pk.x, pk.y}; *(LAS u32x2*)(q_ + 32) = (u32x2){pk.z, pk.w}; }
                }
            }
            __syncthreads();
            f32x4 acc[8][2];
#pragma unroll
            for (int mt = 0; mt < 8; ++mt) { acc[mt][0] = (f32x4){0.f, 0.f, 0.f, 0.f}; acc[mt][1] = (f32x4){0.f, 0.f, 0.f, 0.f}; }
            const unsigned tra = lds_u32 + (8 * fq + (fr >> 2)) * XS_STRIDE + (32 * wave + 4 * (lane & 3)) * 2;
#pragma unroll
            for (int ks = 0; ks < 4; ++ks) {
                bf16x8 fn0, fn1; tr_frag2<4 * XS_STRIDE, 32>(tra + 32 * ks * XS_STRIDE, fn0, fn1);
#pragma unroll
                for (int mt = 2 * ks; mt < 8; ++mt) {
                    const bf16x8 fm = *(const LAS bf16x8*)(lds + 67584 + (16 * mt + fr) * CB_STRIDE + (32 * ks + 8 * fq) * 2);
                    acc[mt][0] = __builtin_amdgcn_mfma_f32_16x16x32_bf16(fn0, fm, acc[mt][0], 0, 0, 0);
                    acc[mt][1] = __builtin_amdgcn_mfma_f32_16x16x32_bf16(fn1, fm, acc[mt][1], 0, 0, 0);
                }
            }
            {
#pragma unroll
                for (int mt = 0; mt < 8; ++mt) { const f32x4 a0 = acc[mt][0], a1 = acc[mt][1]; const u32x4 s4 = sv[mt]; const float b = bs[mt];
                    u32x4 o; o.x = cvt_pk_bf16(bflo(s4.x) * (a0[0] + b), bfhi(s4.x) * (a0[1] + b)); o.y = cvt_pk_bf16(bflo(s4.y) * (a0[2] + b), bfhi(s4.y) * (a0[3] + b));
                    o.z = cvt_pk_bf16(bflo(s4.z) * (a1[0] + b), bfhi(s4.z) * (a1[1] + b)); o.w = cvt_pk_bf16(bflo(s4.w) * (a1[2] + b), bfhi(s4.w) * (a1[3] + b));
                    *(u32x4*)(p0 + (size_t)(16 * mt) * 4096) = o; }
            }
            __syncthreads();
        } else {
            LAS float* ac = (LAS float*)(lds + 137216); LAS float* dtl = ac + 512; LAS float* adt = dtl + 512; LAS float* wg = adt + 512;
            ConvRaw<128> rc, rbb; ConvRaw<256> rx;
            stage_conv_load<128>(rc, XBC, tok0, cidx, 3072 + g * 128, tid); stage_conv_load<128>(rbb, XBC, tok0, cidx, 2048 + g * 128, tid); stage_conv_load<256>(rx, XBC, tok0, cidx, g * 256, tid);
            { const float dtv = chunk_prefix(adt, ac, DT, A.a_log, tok0, g, tid); dtl[tid] = dtv;
              const int k = tid >> 7, l_ = tid & 127; const float aend = ac[k * 128 + 127]; wg[tid] = expf(aend - ac[tid]) * dtv; if (l_ == 127) CD[bc * 32 + g * 4 + k] = expf(aend); }
            stage_conv_finish<128>(rc, lds, CB_STRIDE, 3072 + g * 128, A.conv_w, A.conv_b, nullptr, tid, CC + (size_t)tok0 * 1024 + g * 128, 1024);
            stage_conv_finish<128>(rbb, lds + 34816, CB_STRIDE, 2048 + g * 128, A.conv_w, A.conv_b, nullptr, tid);
            stage_conv_finish<256>(rx, lds + 69632, XS_STRIDE, g * 256, A.conv_w, A.conv_b, nullptr, tid);
            __syncthreads();
            const int l = 16 * wave + fr;
            f32x4 cb[8];
            {
                bf16x8 fc[4];
#pragma unroll
                for (int ks = 0; ks < 4; ++ks) fc[ks] = *(const LAS bf16x8*)(lds + l * CB_STRIDE + (32 * ks + 8 * fq) * 2);
#pragma unroll
                for (int nt = 0; nt < 8; ++nt) {
                    cb[nt] = (f32x4){0.f, 0.f, 0.f, 0.f};
                    if (nt <= wave) {
#pragma unroll
                        for (int ks = 0; ks < 4; ++ks) { const bf16x8 fb = *(const LAS bf16x8*)(lds + 34816 + (16 * nt + fr) * CB_STRIDE + (32 * ks + 8 * fq) * 2);
                            cb[nt] = __builtin_amdgcn_mfma_f32_16x16x32_bf16(fb, fc[ks], cb[nt], 0, 0, 0); }
                    }
                }
            }
            {
                const int k = wave >> 1, ph = wave & 1;
                f32x4 acc[2][8];
#pragma unroll
                for (int mt = 0; mt < 2; ++mt)
#pragma unroll
                    for (int nt = 0; nt < 8; ++nt) acc[mt][nt] = (f32x4){0.f, 0.f, 0.f, 0.f};
                const unsigned xa = lds_u32 + 69632 + (8 * fq + (fr >> 2)) * XS_STRIDE + (k * 64 + 32 * ph + 4 * (lane & 3)) * 2;
                const unsigned ba = lds_u32 + 34816 + (8 * fq + (fr >> 2)) * CB_STRIDE + (4 * (lane & 3)) * 2;
#pragma unroll
                for (int ks = 0; ks < 4; ++ks) {
                    bf16x8 fm0, fm1; tr_frag2<4 * XS_STRIDE, 32>(xa + 32 * ks * XS_STRIDE, fm0, fm1);
                    const f32x4 w0 = *(const LAS f32x4*)(wg + k * 128 + 32 * ks + 8 * fq), w1 = *(const LAS f32x4*)(wg + k * 128 + 32 * ks + 8 * fq + 4);
                    const float wv[8] = {w0[0], w0[1], w0[2], w0[3], w1[0], w1[1], w1[2], w1[3]};
                    bf16x8 sm0, sm1;
#pragma unroll
                    for (int e = 0; e < 8; e += 2) {
                        const unsigned a0 = cvt_pk_bf16(bf2f((unsigned short)fm0[e]) * wv[e], bf2f((unsigned short)fm0[e + 1]) * wv[e + 1]);
                        const unsigned a1 = cvt_pk_bf16(bf2f((unsigned short)fm1[e]) * wv[e], bf2f((unsigned short)fm1[e + 1]) * wv[e + 1]);
                        sm0[e] = (short)(a0 & 0xffffu); sm0[e + 1] = (short)(a0 >> 16); sm1[e] = (short)(a1 & 0xffffu); sm1[e + 1] = (short)(a1 >> 16);
                    }
#pragma unroll
                    for (int nq = 0; nq < 2; ++nq) {
                        bf16x8 fn[4]; tr_frag4<4 * CB_STRIDE, 32>(ba + 32 * ks * CB_STRIDE + 128 * nq, fn[0], fn[1], fn[2], fn[3]);
#pragma unroll
                        for (int i = 0; i < 4; ++i) {
                            acc[0][4 * nq + i] = __builtin_amdgcn_mfma_f32_16x16x32_bf16(fn[i], sm0, acc[0][4 * nq + i], 0, 0, 0);
                            acc[1][4 * nq + i] = __builtin_amdgcn_mfma_f32_16x16x32_bf16(fn[i], sm1, acc[1][4 * nq + i], 0, 0, 0);
                        }
                    }
                }
                bf16_t* sp = STATES + ((size_t)(bc * 8 + g) * 4096 + (size_t)wave * 512 + lane) * 8;
#pragma unroll
                for (int mt = 0; mt < 2; ++mt)
#pragma unroll
                    for (int q = 0; q < 4; ++q) { const f32x4 a0 = acc[mt][2 * q], a1 = acc[mt][2 * q + 1];
                        u32x4 o; o.x = cvt_pk_bf16(a0[0], a0[1]); o.y = cvt_pk_bf16(a0[2], a0[3]); o.z = cvt_pk_bf16(a1[0], a1[1]); o.w = cvt_pk_bf16(a1[2], a1[3]);
                        *(u32x4*)(sp + (size_t)((mt * 4 + q) * 64) * 8) = o; }
            }
            __syncthreads();
            LAS unsigned char* sw = lds + 34816 + wave * (16 * CB_STRIDE);
            bf16_t* ydp = YD + ((size_t)(jj * 8 + wave) * 8 * 64 + lane) * 8;
#pragma unroll
            for (int k = 0; k < 4; ++k) {
                const int h = g * 4 + k; const float al = ac[k * 128 + l], dsk = A.d_skip[h];
#pragma unroll
                for (int nt = 0; nt < 8; ++nt) {
                    float sv[4];
#pragma unroll
                    for (int r = 0; r < 4; ++r) { const int s = 16 * nt + 4 * fq + r;
                        float v = (s <= l) ? cb[nt][r] * __expf(al - ac[k * 128 + s]) * dtl[k * 128 + s] : 0.f;
                        if (s == l) v += dsk; sv[r] = v; }
                    u32x2 o; o.x = cvt_pk_bf16(sv[0], sv[1]); o.y = cvt_pk_bf16(sv[2], sv[3]);
                    *(LAS u32x2*)(sw + fr * CB_STRIDE + (16 * nt + 4 * fq) * 2) = o;
                    if (nt & 1) asm volatile("" ::: "memory");
                }
                asm volatile("s_waitcnt lgkmcnt(0)" ::: "memory");
                f32x4 ay[4];
#pragma unroll
                for (int pt = 0; pt < 4; ++pt) ay[pt] = (f32x4){0.f, 0.f, 0.f, 0.f};
                const unsigned xa = lds_u32 + 69632 + (8 * fq + (fr >> 2)) * XS_STRIDE + (k * 64 + 4 * (lane & 3)) * 2;
#pragma unroll
                for (int ks = 0; ks < 4; ++ks) {
                    if (ks <= (wave >> 1)) {
                        const bf16x8 fs = *(const LAS bf16x8*)(sw + fr * CB_STRIDE + (32 * ks + 8 * fq) * 2);
                        bf16x8 fx[4]; tr_frag4<4 * XS_STRIDE, 32>(xa + 32 * ks * XS_STRIDE, fx[0], fx[1], fx[2], fx[3]);
#pragma unroll
                        for (int pt = 0; pt < 4; ++pt) ay[pt] = __builtin_amdgcn_mfma_f32_16x16x32_bf16(fx[pt], fs, ay[pt], 0, 0, 0);
                    }
                }
#pragma unroll
                for (int q = 0; q < 2; ++q) { u32x4 o; o.x = cvt_pk_bf16(ay[2 * q][0], ay[2 * q][1]); o.y = cvt_pk_bf16(ay[2 * q][2], ay[2 * q][3]); o.z = cvt_pk_bf16(ay[2 * q + 1][0], ay[2 * q + 1][1]); o.w = cvt_pk_bf16(ay[2 * q + 1][2], ay[2 * q + 1][3]); *(u32x4*)(ydp + (size_t)(k * 2 + q) * 512) = o; }
                __builtin_amdgcn_sched_barrier(0);
                asm volatile("s_waitcnt lgkmcnt(0)" ::: "memory");
            }
            __syncthreads();
        }
    }
    GRID_SYNC(3);

    if constexpr ((PH_MASK >> 3) & 1)
    for (int blk = bx; blk < 256; blk += G) {
        const int b = blk >> 6; const unsigned o8 = (unsigned)(blk & 63) * 512u + (unsigned)tid; const int h = (int)(o8 >> 10);
        const bf16_t* sbase = STATES + (size_t)(b * 32) * 262144; bf16_t* pbase = PREV + (size_t)(b * 32) * 262144;
        const unsigned voff = o8 * 8u;
        f32x4 h0 = {0.f, 0.f, 0.f, 0.f}, h1 = {0.f, 0.f, 0.f, 0.f};
#pragma unroll 1
        for (int cb0 = 0; cb0 < 32; cb0 += 16) {
            const bf16_t* sb = sbase + (size_t)cb0 * 262144; bf16_t* pb = pbase + (size_t)cb0 * 262144;
            u32x4 sv[16]; float cdv[16];
#pragma unroll
            for (int c = 0; c < 16; ++c) { sv[c] = *(const u32x4*)(sb + (size_t)c * 262144 + voff); cdv[c] = CD[(b * 32 + cb0 + c) * 32 + h]; }
#pragma unroll
            for (int c = 0; c < 16; ++c) {
                u32x4 o; o.x = cvt_pk_bf16(h0[0], h0[1]); o.y = cvt_pk_bf16(h0[2], h0[3]); o.z = cvt_pk_bf16(h1[0], h1[1]); o.w = cvt_pk_bf16(h1[2], h1[3]);
                *(u32x4*)(pb + (size_t)c * 262144 + voff) = o;
                const f32x4 s0 = {bflo(sv[c].x), bfhi(sv[c].x), bflo(sv[c].y), bfhi(sv[c].y)}, s1 = {bflo(sv[c].z), bfhi(sv[c].z), bflo(sv[c].w), bfhi(sv[c].w)};
                h0 = h0 * cdv[c] + s0; h1 = h1 * cdv[c] + s1;
            }
        }
    }
    GRID_SYNC(4);

    if constexpr ((PH_MASK >> 4) & 1)
    for (int j = bx; j < 1024; j += G) {
        const int g = j & 7, bc = j >> 3, tok0 = bc * 128;
        int tid = threadIdx.x; asm volatile("" : "+v"(tid));
        const int lane = tid & 63, fr = lane & 15, fq = lane >> 4;
        LAS float* ac = (LAS float*)lds; LAS float* adt = ac + 512;
        const int l = 16 * wave + fr;
        bf16x8 fc[4];
#pragma unroll
        for (int ks = 0; ks < 4; ++ks) fc[ks] = *(const bf16x8*)(CC + (size_t)(tok0 + l) * 1024 + g * 128 + 32 * ks + 8 * fq);
        {
            const bf16_t* pg = PREV + (size_t)(bc * 8 + g) * 4096 * 8;
            u32x4 pv[8];
#pragma unroll
            for (int i = 0; i < 8; ++i) pv[i] = *(const u32x4*)(pg + ((size_t)i * 512 + tid) * 8);
            const int mt_ = (tid >> 8) & 1, q_ = (tid >> 6) & 3, fr_ = tid & 15, fq_ = (tid >> 4) & 3;
#pragma unroll
            for (int i = 0; i < 8; ++i) { const int row = (i >> 1) * 64 + 32 * (i & 1) + 8 * (fr_ >> 2) + 4 * mt_ + (fr_ & 3);
                *(LAS u32x4*)(lds + 4096 + row * CB_STRIDE + (32 * q_ + 8 * fq_) * 2) = pv[i]; }
        }
        (void)chunk_prefix(adt, ac, DT, A.a_log, tok0, g, tid);
        f32x4 y[4][4];
        float ss = 0.f;
        bf16_t* zp = YAB + (size_t)(tok0 + l) * 4096 + 2048 + g * 256 + 8 * fq;
        const bf16_t* ydp = YD + ((size_t)(j * 8 + wave) * 8 * 64 + lane) * 8;
        const int prow0 = pg8::perm32(fr), prow1 = pg8::perm32(16 + fr);
#pragma unroll
        for (int k = 0; k < 4; ++k) {
            const int h = g * 4 + k; const float ea = __expf(ac[k * 128 + l]);
            const LAS unsigned char* pp = lds + 4096 + (k * 64) * CB_STRIDE + 16 * fq;
            f32x4 ao[4];
#pragma unroll
            for (int pt = 0; pt < 4; ++pt) ao[pt] = (f32x4){0.f, 0.f, 0.f, 0.f};
            u32x4 zv4[2], yv4[2];
#pragma unroll
            for (int q = 0; q < 2; ++q) { zv4[q] = *(const u32x4*)(zp + k * 64 + q * 32); yv4[q] = *(const u32x4*)(ydp + (size_t)(k * 2 + q) * 512); }
#pragma unroll
            for (int ks = 0; ks < 4; ++ks) {
                bf16x8 fpw[4];
#pragma unroll
                for (int pt = 0; pt < 4; ++pt) fpw[pt] = *(const LAS bf16x8*)(pp + (32 * (pt >> 1) + ((pt & 1) ? prow1 : prow0)) * CB_STRIDE + 64 * ks);
#pragma unroll
                for (int pt = 0; pt < 4; ++pt) ao[pt] = __builtin_amdgcn_mfma_f32_16x16x32_bf16(fpw[pt], fc[ks], ao[pt], 0, 0, 0);
            }
#pragma unroll
            for (int pt = 0; pt < 4; ++pt) { const u32x4 z4 = zv4[pt >> 1], y4 = yv4[pt >> 1];
                const unsigned zlo = (pt & 1) ? z4.z : z4.x, zhi = (pt & 1) ? z4.w : z4.y, ylo = (pt & 1) ? y4.z : y4.x, yhi = (pt & 1) ? y4.w : y4.y;
                f32x4 v = ao[pt] * ea; v[0] = (v[0] + bflo(ylo)) * bflo(zlo); v[1] = (v[1] + bfhi(ylo)) * bfhi(zlo); v[2] = (v[2] + bflo(yhi)) * bflo(zhi); v[3] = (v[3] + bfhi(yhi)) * bfhi(zhi);
                ss += (v[0] * v[0] + v[1] * v[1]) + (v[2] * v[2] + v[3] * v[3]); y[k][pt] = v; }
        }
        ss += __shfl_xor(ss, 16); ss += __shfl_xor(ss, 32);
        const float rstd = 1.0f / sqrtf(ss * (1.0f / 256.0f) + EPS);
        const float* nw = A.ssm_nw + g * 256 + 8 * fq;
        u32x4 ov[4][2];
#pragma unroll
        for (int k = 0; k < 4; ++k)
#pragma unroll
            for (int q = 0; q < 2; ++q) { const f32x4 w0 = *(const f32x4*)(nw + k * 64 + q * 32), w1 = *(const f32x4*)(nw + k * 64 + q * 32 + 4); const f32x4 v0 = y[k][2 * q], v1 = y[k][2 * q + 1];
                ov[k][q].x = cvt_pk_bf16(v0[0] * rstd * w0[0], v0[1] * rstd * w0[1]); ov[k][q].y = cvt_pk_bf16(v0[2] * rstd * w0[2], v0[3] * rstd * w0[3]);
                ov[k][q].z = cvt_pk_bf16(v1[0] * rstd * w1[0], v1[1] * rstd * w1[1]); ov[k][q].w = cvt_pk_bf16(v1[2] * rstd * w1[2], v1[3] * rstd * w1[3]); }
#pragma unroll
        for (int k = 0; k < 4; ++k)
#pragma unroll
            for (int q = 0; q < 2; ++q) *(u32x4*)(zp + k * 64 + q * 32) = ov[k][q];
        __syncthreads();
    }
    GRID_SYNC(5);

    if constexpr ((PH_MASK >> 5) & 1)
    {
        pg8::Gemm g{YAB, WbT, M_TOK, DM, DM, 2 * DM}; SplitKOrder S; S.init(M_TOK, DM, G, bx, WGM_P5);
        EpiMerge E{RG, GB, MERGED};
        pg8::gemm_phase<EpiMerge, SplitKOrder, true, true>(lds, g, S, E);
    }
    GRID_SYNC(6);

    if constexpr ((PH_MASK >> 6) & 1)
    {
        pg8::Gemm g{MERGED, WoT, M_TOK, DM, DM, DM}; pg8::StaticOrder S; S.init(M_TOK, DM, G, bx, WGM_P6);
        EpiAcc E{YAB};
        pg8::gemm_phase<EpiAcc, pg8::StaticOrder, true, true>(lds, g, S, E);
    }
    GRID_SYNC(7);

    if constexpr ((PH_MASK >> 7) & 1)
    for (int m = gw; m < M_TOK; m += 2 * NGW) {
        const int m2 = m + NGW;
        int tid_ = threadIdx.x; asm volatile("" : "+v"(tid_)); const int lane = tid_ & 63;
        const f32x4* xr = (const f32x4*)(A.x + (size_t)m * DM) + lane; const f32x4* xr2 = (const f32x4*)(A.x + (size_t)m2 * DM) + lane;
        const u32x2* ar = (const u32x2*)(YAB + (size_t)m * DM) + lane; const u32x2* ar2 = (const u32x2*)(YAB + (size_t)m2 * DM) + lane;
        const f32x4* wr4 = (const f32x4*)A.fnw + lane;
        f32x4 v[8], v2[8]; u32x2 a[8], a2[8]; float s = 0.f, s2 = 0.f;
#pragma unroll
        for (int j = 0; j < 8; ++j) { v[j] = xr[64 * j]; v2[j] = xr2[64 * j]; a[j] = ar[64 * j]; a2[j] = ar2[64 * j]; }
#pragma unroll
        for (int j = 0; j < 8; ++j) {
            v[j][0] += bflo(a[j].x); v[j][1] += bfhi(a[j].x); v[j][2] += bflo(a[j].y); v[j][3] += bfhi(a[j].y);
            v2[j][0] += bflo(a2[j].x); v2[j][1] += bfhi(a2[j].x); v2[j][2] += bflo(a2[j].y); v2[j][3] += bfhi(a2[j].y);
            s += (v[j][0] * v[j][0] + v[j][1] * v[j][1]) + (v[j][2] * v[j][2] + v[j][3] * v[j][3]); s2 += (v2[j][0] * v2[j][0] + v2[j][1] * v2[j][1]) + (v2[j][2] * v2[j][2] + v2[j][3] * v2[j][3]); }
        const float rstd = 1.0f / sqrtf(wave_sum(s) * (1.0f / DM) + EPS), rstd2 = 1.0f / sqrtf(wave_sum(s2) * (1.0f / DM) + EPS);
        f32x4* orow = (f32x4*)(A.out + (size_t)m * DM) + lane; f32x4* orow2 = (f32x4*)(A.out + (size_t)m2 * DM) + lane;
#pragma unroll
        for (int j = 0; j < 8; ++j) { const f32x4 w4 = wr4[64 * j]; orow[64 * j] = v[j] * rstd * w4; orow2[64 * j] = v2[j] * rstd2 * w4; }
    }
#ifdef SPIN_SUB
    if (bx == 0 && tid == 0) {
        const unsigned long long* st = (const unsigned long long*)(BAR + 16) + 16;
        const unsigned long long d = (st[SPIN_SUB + 1] - st[SPIN_SUB]) * SPIN_MULT, t0 = __builtin_amdgcn_s_memrealtime();
        while (__builtin_amdgcn_s_memrealtime() - t0 < d) __builtin_amdgcn_s_sleep(10);
    }
#endif
#ifdef SPIN_PHASE
    STAMP(8);
    if (bx == 0 && tid == 0) {
        const unsigned long long* st = (const unsigned long long*)(BAR + 16);
        const unsigned long long d = (st[SPIN_PHASE + 1] - st[SPIN_PHASE]) * SPIN_MULT, t0 = __builtin_amdgcn_s_memrealtime();
        while (__builtin_amdgcn_s_memrealtime() - t0 < d) __builtin_amdgcn_s_sleep(10);
    }
#endif
}

extern "C" void kernel_launch(void* const* d_in, const int* in_sizes, int n_in, void* d_out, int out_size, void* d_ws, size_t ws_size, hipStream_t stream) {
    static int grid = 0;
    if (grid == 0) {
        if (n_in != 17 || out_size != M_TOK * DM || ws_size < WS_END) { fprintf(stderr, "kernel_launch: unexpected shapes (n_in %d out %d ws %zu)\n", n_in, out_size, ws_size); grid = -1; return; }
        int dev = 0, cus = 0, per_cu = 0;
        hipGetDevice(&dev); hipDeviceGetAttribute(&cus, hipDeviceAttributeMultiprocessorCount, dev);
        if (hipFuncSetAttribute((const void*)fwd_megakernel, hipFuncAttributeMaxDynamicSharedMemorySize, LDS_BYTES) != hipSuccess) { fprintf(stderr, "kernel_launch: hipFuncSetAttribute failed\n"); grid = -1; return; }
        if (hipOccupancyMaxActiveBlocksPerMultiprocessor(&per_cu, (const void*)fwd_megakernel, NT, LDS_BYTES) != hipSuccess || per_cu < 1) { fprintf(stderr, "kernel_launch: occupancy query says %d\n", per_cu); per_cu = 1; }
        (void)hipGetLastError();
        grid = cus * 1;
    }
    if (grid < 0) return;
    Args a{};
    a.x = (const float*)d_in[0]; a.norm_w = (const float*)d_in[1]; a.w_in = (const float*)d_in[2]; a.b_gate = (const float*)d_in[3]; a.ln_w = (const float*)d_in[4]; a.ln_b = (const float*)d_in[5];
    a.w_sp = (const float*)d_in[6]; a.b_sp = (const float*)d_in[7]; a.conv_w = (const float*)d_in[8]; a.conv_b = (const float*)d_in[9]; a.dt_bias = (const float*)d_in[10]; a.a_log = (const float*)d_in[11];
    a.d_skip = (const float*)d_in[12]; a.ssm_nw = (const float*)d_in[13]; a.w_branch = (const float*)d_in[14]; a.w_out = (const float*)d_in[15]; a.fnw = (const float*)d_in[16];
    a.out = (float*)d_out; a.ws = (unsigned char*)d_ws;
    if (hipMemsetAsync((char*)d_ws + WS_BAR, 0, 256, stream) != hipSuccess) { fprintf(stderr, "kernel_launch: memset failed\n"); return; }
    void* args[] = {&a};
    hipError_t e = hipLaunchCooperativeKernel((const void*)fwd_megakernel, dim3(grid), dim3(NT), args, LDS_BYTES, stream);
    if (e != hipSuccess) fprintf(stderr, "cooperative launch failed: %s (grid %d)\n", hipGetErrorString(e), grid);
}
```

```cpp
#include <hip/hip_runtime.h>
#include <hip/hip_cooperative_groups.h>
#include <cstdio>
#include <cstdint>
namespace cg = cooperative_groups;
namespace pg8 {
#define PG8_LAS __attribute__((address_space(3)))
typedef unsigned short bf16_t;
typedef short bf16x8 __attribute__((ext_vector_type(8)));
typedef float f32x4 __attribute__((ext_vector_type(4)));
typedef unsigned u32x4 __attribute__((ext_vector_type(4)));
constexpr int BM = 256, BK = 64, HALF = 128, HTB = HALF * BK * 2  , STAGE_BYTES = 8 * HTB, NXCD = 8, WGM = 8;

__host__ __device__ __forceinline__ int lds_byte(int r, int c) { const int st = (r >> 4) * 2 + (c >> 5), rr = r & 15, cc = c & 31, ob = rr * 64 + cc * 2; return st * 1024 + (ob ^ (((ob >> 9) & 1) << 5)); }
__host__ __device__ __forceinline__ void stage_rc(int b, int& R, int& C) { const int st = b / 1024, sb = b % 1024, swz = sb ^ (((sb >> 9) & 1) << 5); R = (st >> 1) * 16 + swz / 64; C = (st & 1) * 32 + (swz % 64) / 2; }
__host__ __device__ __forceinline__ int perm32(int rho) { const int n = rho >> 4, i = rho & 15; return 8 * (i >> 2) + 4 * n + (i & 3); }

struct Unit { int pm, pn, kh; };
struct Gemm { const bf16_t* A; const bf16_t* Bt; int M, N, K, ld; };

struct StaticOrder {
    int nM, nN, nwg, G, c, wgm;
    __host__ __device__ void init(int M, int N, int G_, int c_, int wgm_ = WGM) { nM = M / BM; nN = N / BM; nwg = nM * nN; G = G_; c = c_; wgm = wgm_; }
    __host__ __device__ bool next(int i, Unit& u) const {
        const long L = (long)i * G + c; if (L >= nwg) return false;
        int wgid = (int)L; { const int q = nwg / NXCD, r = nwg % NXCD, xcd = wgid % NXCD, off = wgid / NXCD; wgid = (xcd < r ? xcd * (q + 1) : r * (q + 1) + (xcd - r) * q) + off; }
        const int nig = wgm * nN, gid = wgid / nig, fm = gid * wgm, gsz = (nM - fm) < wgm ? (nM - fm) : wgm;
        u.pm = fm + ((wgid % nig) % gsz); u.pn = (wgid % nig) / gsz; u.kh = 0; return true;
    }
    __device__ __forceinline__ void a_ready(const Unit&) const {}
    __device__ __forceinline__ void done(const Unit&) const {}
};
typedef float f32x2_t_ __attribute__((ext_vector_type(2)));
typedef __bf16 bf16x2_t_ __attribute__((ext_vector_type(2)));
__device__ __forceinline__ unsigned cvt_pk_bf16(float lo, float hi) { const f32x2_t_ v = {lo, hi}; const bf16x2_t_ b = __builtin_convertvector(v, bf16x2_t_); return __builtin_bit_cast(unsigned, b); }
template <class Epi, class Sched, bool ALIGN_EPI = false, bool SP2 = false>
__device__ __forceinline__ void gemm_phase(PG8_LAS unsigned char* lds, const Gemm g, const Sched& S, const Epi& E) {
    int tid_ = threadIdx.x; asm volatile("" : "+v"(tid_));
    const int tid = tid_, wid = __builtin_amdgcn_readfirstlane(tid >> 6), lane = tid & 63, wr = wid >> 2, wc = wid & 3, fr = lane & 15, fq = lane >> 4;
    const int K = g.K, nt = K / BK, ld = g.ld;
    unsigned voffA[2], voffB[2];
#pragma unroll
    for (int i = 0; i < 2; ++i) { int R, C; stage_rc(tid * 16 + i * 8192, R, C); const int Rb = Epi::PERM ? ((R & ~31) + perm32(R & 31)) : R;
        voffA[i] = (unsigned)(R * ld + C) * 2u; voffB[i] = (unsigned)(Rb * ld + C) * 2u; }
    const size_t kstep = (size_t)(BK * 2);
    const size_t hstep = (size_t)HALF * ld * 2;
    const size_t tstep = 2 * hstep;
    const unsigned ldsw = (unsigned)wid * 1024u;
    const int aoff = lds_byte(wr * 64 + fr, fq * 8), boff = lds_byte(wc * 32 + fr, fq * 8);
#define PG8_SA(b, h) (((b) * 2 + (h)) * HTB)
#define PG8_SB(b, h) ((4 + (b) * 2 + (h)) * HTB)
#define PG8_STAGE(bufoff, gbase, voff) do { _Pragma("unroll") for (int _i = 0; _i < 2; ++_i) \
        __builtin_amdgcn_global_load_lds((const unsigned*)((const char*)(gbase) + (voff)[_i]), (PG8_LAS unsigned*)(lds + (bufoff) + ldsw + _i * 8192), 16, 0, 0); } while (0)
#define PG8_LDA(dst, b, h) do { _Pragma("unroll") for (int m = 0; m < 4; ++m) _Pragma("unroll") for (int k = 0; k < 2; ++k) dst[m][k] = *(const PG8_LAS bf16x8*)(lds + PG8_SA(b, h) + aoff + m * 2048 + k * 1024); } while (0)
#define PG8_LDB(dst, b, h) do { _Pragma("unroll") for (int n = 0; n < 2; ++n) _Pragma("unroll") for (int k = 0; k < 2; ++k) dst[n][k] = *(const PG8_LAS bf16x8*)(lds + PG8_SB(b, h) + boff + n * 2048 + k * 1024); } while (0)
#define PG8_MMA(ai, bj, At, Bt) do { __builtin_amdgcn_s_setprio(1); _Pragma("unroll") for (int m = 0; m < 4; ++m) _Pragma("unroll") for (int n = 0; n < 2; ++n) _Pragma("unroll") for (int k = 0; k < 2; ++k) \
        acc[ai][bj][m][n] = __builtin_amdgcn_mfma_f32_16x16x32_bf16(Bt[n][k], At[m][k], acc[ai][bj][m][n], 0, 0, 0); __builtin_amdgcn_s_setprio(0); } while (0)
#define PG8_WAIT_V(n) asm volatile("s_waitcnt vmcnt(" #n ")" ::: "memory")
#define PG8_WAIT_L(n) asm volatile("s_waitcnt lgkmcnt(" #n ")" ::: "memory")
#define PG8_BAR __builtin_amdgcn_s_barrier()
#define PG8_SCHED __builtin_amdgcn_sched_barrier(0)
    Unit cur, nxt; int ui = 0;
    if (!S.next(0, cur)) return;
    f32x4 acc[2][2][4][2];
#pragma unroll
    for (int a = 0; a < 2; ++a)
#pragma unroll
        for (int b = 0; b < 2; ++b)
#pragma unroll
            for (int m = 0; m < 4; ++m)
#pragma unroll
                for (int n = 0; n < 2; ++n) acc[a][b][m][n] = (f32x4){0.f, 0.f, 0.f, 0.f};
    bf16x8 At[4][2], B0[2][2], B1[2][2];
    const char* cA = (const char*)g.A + (size_t)cur.pm * tstep + (size_t)cur.kh * K * 2; const char* cB = (const char*)g.Bt + (size_t)cur.pn * tstep + (size_t)cur.kh * K * 2;
    S.a_ready(cur);
    if constexpr (SP2) {
        PG8_STAGE(PG8_SB(0, 0), cB, voffB); PG8_STAGE(PG8_SB(0, 1), cB + hstep, voffB); PG8_STAGE(PG8_SA(0, 0), cA, voffA); PG8_STAGE(PG8_SA(0, 1), cA + hstep, voffA);
        if (wr == 1) PG8_BAR;
        PG8_WAIT_V(2); PG8_BAR;
        PG8_STAGE(PG8_SB(1, 0), cB + kstep, voffB); PG8_STAGE(PG8_SA(1, 0), cA + kstep, voffA); PG8_STAGE(PG8_SB(1, 1), cB + hstep + kstep, voffB);
        PG8_WAIT_V(6); PG8_BAR;
    } else {
        PG8_STAGE(PG8_SB(0, 0), cB, voffB); PG8_STAGE(PG8_SA(0, 0), cA, voffA); PG8_STAGE(PG8_SB(0, 1), cB + hstep, voffB); PG8_STAGE(PG8_SA(0, 1), cA + hstep, voffA);
        if (wr == 1) PG8_BAR;
        PG8_WAIT_V(4); PG8_BAR;
        PG8_STAGE(PG8_SB(1, 0), cB + kstep, voffB); PG8_STAGE(PG8_SA(1, 0), cA + kstep, voffA); PG8_STAGE(PG8_SB(1, 1), cB + hstep + kstep, voffB);
        PG8_WAIT_V(6); PG8_BAR;
    }
    for (;;) {
        const bool has_next = S.next(ui + 1, nxt);
        const char* nA = has_next ? (const char*)g.A + (size_t)nxt.pm * tstep + (size_t)nxt.kh * K * 2 : cA; const char* nB = has_next ? (const char*)g.Bt + (size_t)nxt.pn * tstep + (size_t)nxt.kh * K * 2 : cB;
        for (int t = 0; t < nt; t += 2) {
            const bool last = (t == nt - 2);
            const char* a1 = cA + (size_t)(t + 1) * kstep;
            const char* a2 = last ? nA : cA + (size_t)(t + 2) * kstep; const char* b2 = last ? nB : cB + (size_t)(t + 2) * kstep;
            const char* a3 = a2 + kstep; const char* b3 = b2 + kstep;
            if (last && has_next) S.a_ready(nxt);
            if constexpr (SP2) {
            PG8_LDB(B0, 0, 0); PG8_LDB(B1, 0, 1); PG8_SCHED; PG8_LDA(At, 0, 0); PG8_STAGE(PG8_SA(1, 1), a1 + hstep, voffA);
            PG8_WAIT_V(8); PG8_WAIT_L(0); PG8_BAR; PG8_MMA(0, 0, At, B0); PG8_MMA(0, 1, At, B1); PG8_BAR; PG8_SCHED;
            PG8_LDA(At, 0, 1); PG8_STAGE(PG8_SB(0, 0), b2, voffB); PG8_STAGE(PG8_SB(0, 1), b2 + hstep, voffB); PG8_STAGE(PG8_SA(0, 0), a2, voffA);
            PG8_WAIT_V(8); PG8_WAIT_L(0); PG8_BAR; PG8_MMA(1, 0, At, B0); PG8_MMA(1, 1, At, B1); PG8_BAR; PG8_SCHED;
            PG8_LDB(B0, 1, 0); PG8_LDB(B1, 1, 1); PG8_SCHED; PG8_LDA(At, 1, 0); PG8_STAGE(PG8_SA(0, 1), a2 + hstep, voffA);
            PG8_WAIT_V(8); PG8_WAIT_L(0); PG8_BAR; PG8_MMA(0, 0, At, B0); PG8_MMA(0, 1, At, B1); PG8_BAR; PG8_SCHED;
            PG8_LDA(At, 1, 1); PG8_STAGE(PG8_SB(1, 0), b3, voffB); PG8_STAGE(PG8_SB(1, 1), b3 + hstep, voffB); PG8_STAGE(PG8_SA(1, 0), a3, voffA);
            PG8_WAIT_V(8); PG8_WAIT_L(0); PG8_BAR; PG8_MMA(1, 0, At, B0); PG8_MMA(1, 1, At, B1); PG8_BAR; PG8_SCHED;
            } else {
            PG8_LDB(B0, 0, 0); PG8_SCHED; PG8_LDA(At, 0, 0); PG8_STAGE(PG8_SA(1, 1), a1 + hstep, voffA);
            PG8_WAIT_L(8); PG8_BAR; PG8_WAIT_L(0); PG8_MMA(0, 0, At, B0); PG8_BAR; PG8_SCHED;
            PG8_LDB(B1, 0, 1); PG8_STAGE(PG8_SB(0, 0), b2, voffB);
            PG8_BAR; PG8_WAIT_L(0); PG8_MMA(0, 1, At, B1); PG8_BAR;
            PG8_LDA(At, 0, 1); PG8_STAGE(PG8_SA(0, 0), a2, voffA);
            PG8_BAR; PG8_WAIT_L(0); PG8_MMA(1, 0, At, B0); PG8_BAR; PG8_SCHED;
            PG8_STAGE(PG8_SB(0, 1), b2 + hstep, voffB);
            PG8_WAIT_V(6); PG8_BAR; PG8_MMA(1, 1, At, B1); PG8_BAR;
            PG8_LDB(B0, 1, 0); PG8_SCHED; PG8_LDA(At, 1, 0); PG8_STAGE(PG8_SA(0, 1), a2 + hstep, voffA);
            PG8_WAIT_L(8); PG8_BAR; PG8_WAIT_L(0); PG8_MMA(0, 0, At, B0); PG8_BAR; PG8_SCHED;
            PG8_LDB(B1, 1, 1); PG8_STAGE(PG8_SB(1, 0), b3, voffB);
            PG8_BAR; PG8_WAIT_L(0); PG8_MMA(0, 1, At, B1); PG8_BAR;
            PG8_LDA(At, 1, 1); PG8_STAGE(PG8_SA(1, 0), a3, voffA);
            PG8_BAR; PG8_WAIT_L(0); PG8_MMA(1, 0, At, B0); PG8_BAR; PG8_SCHED;
            PG8_STAGE(PG8_SB(1, 1), b3 + hstep, voffB);
            PG8_WAIT_V(6); PG8_BAR; PG8_MMA(1, 1, At, B1); PG8_BAR;
            }
        }
        if constexpr (ALIGN_EPI) { if (wr == 0) PG8_BAR; }
        if constexpr (!Epi::AFTER_DRAIN) { E(acc, cur, wr, wc, fr, fq); S.done(cur); }
        if (!has_next) break;
        if (!E.keep(cur))
#pragma unroll
        for (int a = 0; a < 2; ++a)
#pragma unroll
            for (int b = 0; b < 2; ++b)
#pragma unroll
                for (int m = 0; m < 4; ++m)
#pragma unroll
                    for (int n = 0; n < 2; ++n) acc[a][b][m][n] = (f32x4){0.f, 0.f, 0.f, 0.f};
        cur = nxt; cA = nA; cB = nB; ++ui;
        if constexpr (ALIGN_EPI) { if (wr == 1) PG8_BAR; }
    }
    PG8_WAIT_V(0);
    if constexpr (!ALIGN_EPI) { if (wr == 0) PG8_BAR; }
    PG8_BAR;
    if constexpr (Epi::AFTER_DRAIN) { E.fused(acc, cur, wr, wc, fr, fq, lds, wid, lane); S.done(cur); }
#undef PG8_SA
#undef PG8_SB
#undef PG8_STAGE
#undef PG8_LDA
#undef PG8_LDB
#undef PG8_MMA
#undef PG8_WAIT_V
#undef PG8_WAIT_L
#undef PG8_BAR
#undef PG8_SCHED
}
}

#define LAS __attribute__((address_space(3)))
using pg8::bf16_t; using pg8::bf16x8; using pg8::f32x4; using pg8::u32x4; using pg8::cvt_pk_bf16;
typedef unsigned u32x2 __attribute__((ext_vector_type(2)));
typedef short s16x4 __attribute__((ext_vector_type(4)));

constexpr int NT = 512, NWAVES = 8;
constexpr int M_TOK = 16384, DM = 2048, SEQ = 4096, NCH = 32, CL_ = 128;
constexpr int NIN = 16416;
constexpr int NPROJ = 16384;
constexpr float EPS = 1e-5f;
constexpr int LDS_BYTES = 147456;
#ifndef WGM_P1
#define WGM_P1 4
#endif
#ifndef WGM_P5
#define WGM_P5 4
#endif
#ifndef WGM_P6
#define WGM_P6 4
#endif
#ifndef PH_MASK
#define PH_MASK 0xFF
#endif

constexpr size_t MiB = 1048576;
constexpr size_t WS_BAR = 3 * MiB + 65536;
constexpr size_t WS_WDT = 0, WS_WSB = 131072, WS_STATS = 393216, WS_SSQ = 524288, WS_CD = 589824, WS_DT = 1 * MiB;
constexpr size_t WS_WB = 4 * MiB, WS_WO = 20 * MiB, WS_YAB = 28 * MiB, WS_V = 156 * MiB, WS_XBC = 220 * MiB, WS_R = 348 * MiB, WS_GB = 412 * MiB, WS_CC = 476 * MiB, WS_END = 508 * MiB;

__device__ __forceinline__ float bf2f(unsigned short u) { return __uint_as_float(((unsigned)u) << 16); }
__device__ __forceinline__ float bflo(unsigned w) { return __uint_as_float(w << 16); }
__device__ __forceinline__ float bfhi(unsigned w) { return __uint_as_float(w & 0xffff0000u); }
__device__ __forceinline__ float silu_f(float v) { return v * __builtin_amdgcn_rcpf(1.0f + __expf(-v)); }
__device__ __forceinline__ float sigmoid_f(float v) { return __builtin_amdgcn_rcpf(1.0f + __expf(-v)); }
__device__ __forceinline__ float wave_sum(float v) {
#pragma unroll
    for (int o = 1; o < 64; o <<= 1) v += __shfl_xor(v, o);
    return v;
}
__device__ __forceinline__ void atomic_addf(float* p, float v) { __hip_atomic_fetch_add(p, v, __ATOMIC_RELAXED, __HIP_MEMORY_SCOPE_AGENT); }

template <int OFF> __device__ __forceinline__ bf16x8 tr_frag(unsigned a) {
    s16x4 lo, hi;
    asm volatile("ds_read_b64_tr_b16 %0, %2\n\tds_read_b64_tr_b16 %1, %2 offset:%3\n\ts_waitcnt lgkmcnt(0)" : "=&v"(lo), "=&v"(hi) : "v"(a), "n"(OFF) : "memory");
    return (bf16x8){lo[0], lo[1], lo[2], lo[3], hi[0], hi[1], hi[2], hi[3]};
}

template <int OFF, int STEP> __device__ __forceinline__ void tr_frag2(unsigned a, bf16x8& f0, bf16x8& f1) {
    s16x4 l0, h0, l1, h1;
    asm volatile("ds_read_b64_tr_b16 %0, %4\n\tds_read_b64_tr_b16 %1, %4 offset:%5\n\tds_read_b64_tr_b16 %2, %4 offset:%6\n\tds_read_b64_tr_b16 %3, %4 offset:%7\n\ts_waitcnt lgkmcnt(0)"
                 : "=&v"(l0), "=&v"(h0), "=&v"(l1), "=&v"(h1) : "v"(a), "n"(OFF), "n"(STEP), "n"(STEP + OFF) : "memory");
    f0 = (bf16x8){l0[0], l0[1], l0[2], l0[3], h0[0], h0[1], h0[2], h0[3]}; f1 = (bf16x8){l1[0], l1[1], l1[2], l1[3], h1[0], h1[1], h1[2], h1[3]};
}
template <int OFF, int STEP> __device__ __forceinline__ void tr_frag4(unsigned a, bf16x8& f0, bf16x8& f1, bf16x8& f2, bf16x8& f3) {
    s16x4 l0, h0, l1, h1, l2, h2, l3, h3;
    asm volatile("ds_read_b64_tr_b16 %0, %8\n\tds_read_b64_tr_b16 %1, %8 offset:%9\n\tds_read_b64_tr_b16 %2, %8 offset:%10\n\tds_read_b64_tr_b16 %3, %8 offset:%11\n\t"
                 "ds_read_b64_tr_b16 %4, %8 offset:%12\n\tds_read_b64_tr_b16 %5, %8 offset:%13\n\tds_read_b64_tr_b16 %6, %8 offset:%14\n\tds_read_b64_tr_b16 %7, %8 offset:%15\n\ts_waitcnt lgkmcnt(0)"
                 : "=&v"(l0), "=&v"(h0), "=&v"(l1), "=&v"(h1), "=&v"(l2), "=&v"(h2), "=&v"(l3), "=&v"(h3)
                 : "v"(a), "n"(OFF), "n"(STEP), "n"(STEP + OFF), "n"(2 * STEP), "n"(2 * STEP + OFF), "n"(3 * STEP), "n"(3 * STEP + OFF) : "memory");
    f0 = (bf16x8){l0[0], l0[1], l0[2], l0[3], h0[0], h0[1], h0[2], h0[3]}; f1 = (bf16x8){l1[0], l1[1], l1[2], l1[3], h1[0], h1[1], h1[2], h1[3]};
    f2 = (bf16x8){l2[0], l2[1], l2[2], l2[3], h2[0], h2[1], h2[2], h2[3]}; f3 = (bf16x8){l3[0], l3[1], l3[2], l3[3], h3[0], h3[1], h3[2], h3[3]};
}

struct Args {
    const float* x; const float* norm_w; const float* w_in; const float* b_gate; const float* ln_w; const float* ln_b; const float* w_sp; const float* b_sp;
    const float* conv_w; const float* conv_b; const float* dt_bias; const float* a_log; const float* d_skip; const float* ssm_nw; const float* w_branch; const float* w_out; const float* fnw;
    float* out; unsigned char* ws;
};

struct EpiProj {
    static constexpr bool PERM = true, AFTER_DRAIN = false;
    __device__ __forceinline__ bool keep(const pg8::Unit&) const { return false; }
    bf16_t* YAB; bf16_t* V; bf16_t* XBC; bf16_t* R; bf16_t* GB; float* stats; const float* b_gate;
    __device__ __forceinline__ void operator()(const f32x4 (&acc)[2][2][4][2], const pg8::Unit& u, int wr, int wc, int fr, int fq) const {
        const int row0 = u.pm * 256 + wr * 64 + fr, pn = u.pn, cl = wc * 32 + 8 * fq;
        if (pn < 16) {
#pragma unroll
            for (int ai = 0; ai < 2; ++ai)
#pragma unroll
                for (int m = 0; m < 4; ++m) {
                    const f32x4 u0 = acc[ai][0][m][0], u1 = acc[ai][0][m][1], z0 = acc[ai][1][m][0], z1 = acc[ai][1][m][1];
                    u32x4 w;
                    w.x = cvt_pk_bf16(silu_f(z0[0]) * u0[0], silu_f(z0[1]) * u0[1]); w.y = cvt_pk_bf16(silu_f(z0[2]) * u0[2], silu_f(z0[3]) * u0[3]);
                    w.z = cvt_pk_bf16(silu_f(z1[0]) * u1[0], silu_f(z1[1]) * u1[1]); w.w = cvt_pk_bf16(silu_f(z1[2]) * u1[2], silu_f(z1[3]) * u1[3]);
                    *(u32x4*)(YAB + (size_t)(row0 + ai * 128 + m * 16) * 4096 + pn * 128 + cl) = w;
                }
        } else if (pn < 24) {
            const int c0 = (pn - 16) * 256 + cl;
#pragma unroll
            for (int ai = 0; ai < 2; ++ai)
#pragma unroll
                for (int m = 0; m < 4; ++m) {
                    const int row = row0 + ai * 128 + m * 16; float s = 0.f, q = 0.f;
#pragma unroll
                    for (int bj = 0; bj < 2; ++bj) {
                        const f32x4 v0 = acc[ai][bj][m][0], v1 = acc[ai][bj][m][1];
                        s += (v0[0] + v0[1]) + (v0[2] + v0[3]) + (v1[0] + v1[1]) + (v1[2] + v1[3]);
                        q += (v0[0] * v0[0] + v0[1] * v0[1]) + (v0[2] * v0[2] + v0[3] * v0[3]) + (v1[0] * v1[0] + v1[1] * v1[1]) + (v1[2] * v1[2] + v1[3] * v1[3]);
                        u32x4 w; w.x = cvt_pk_bf16(v0[0], v0[1]); w.y = cvt_pk_bf16(v0[2], v0[3]); w.z = cvt_pk_bf16(v1[0], v1[1]); w.w = cvt_pk_bf16(v1[2], v1[3]);
                        *(u32x4*)(V + (size_t)row * 2048 + c0 + bj * 128) = w;
                    }
                    s += __shfl_xor(s, 16); s += __shfl_xor(s, 32); q += __shfl_xor(q, 16); q += __shfl_xor(q, 32);
                    if (fq == 0) { atomic_addf(stats + 2 * row, s); atomic_addf(stats + 2 * row + 1, q); }
                }
        } else if (pn < 32) {
            const int c0 = (pn - 24) * 256 + cl;
#pragma unroll
            for (int ai = 0; ai < 2; ++ai)
#pragma unroll
                for (int m = 0; m < 4; ++m)
#pragma unroll
                    for (int bj = 0; bj < 2; ++bj) {
                        const f32x4 v0 = acc[ai][bj][m][0], v1 = acc[ai][bj][m][1];
                        u32x4 w; w.x = cvt_pk_bf16(silu_f(v0[0]), silu_f(v0[1])); w.y = cvt_pk_bf16(silu_f(v0[2]), silu_f(v0[3])); w.z = cvt_pk_bf16(silu_f(v1[0]), silu_f(v1[1])); w.w = cvt_pk_bf16(silu_f(v1[2]), silu_f(v1[3]));
                        *(u32x4*)(YAB + (size_t)(row0 + ai * 128 + m * 16) * 4096 + 2048 + c0 + bj * 128) = w;
                    }
        } else if (pn < 48) {
            const int c0 = (pn - 32) * 256 + cl;
#pragma unroll
            for (int ai = 0; ai < 2; ++ai)
#pragma unroll
                for (int m = 0; m < 4; ++m)
#pragma unroll
                    for (int bj = 0; bj < 2; ++bj) {
                        const f32x4 v0 = acc[ai][bj][m][0], v1 = acc[ai][bj][m][1];
                        u32x4 w; w.x = cvt_pk_bf16(v0[0], v0[1]); w.y = cvt_pk_bf16(v0[2], v0[3]); w.z = cvt_pk_bf16(v1[0], v1[1]); w.w = cvt_pk_bf16(v1[2], v1[3]);
                        *(u32x4*)(XBC + (size_t)(row0 + ai * 128 + m * 16) * 4096 + c0 + bj * 128) = w;
                    }
        } else {
            const int c0 = (pn - 48) * 128 + cl;
            const f32x4 ba0 = *(const f32x4*)(b_gate + c0), ba1 = *(const f32x4*)(b_gate + c0 + 4), bb0 = *(const f32x4*)(b_gate + 2048 + c0), bb1 = *(const f32x4*)(b_gate + 2048 + c0 + 4);
#pragma unroll
            for (int ai = 0; ai < 2; ++ai)
#pragma unroll
                for (int m = 0; m < 4; ++m) {
                    f32x4 a0 = acc[ai][0][m][0] + ba0, a1 = acc[ai][0][m][1] + ba1, b0 = acc[ai][1][m][0] + bb0, b1 = acc[ai][1][m][1] + bb1;
#pragma unroll
                    for (int j = 0; j < 4; ++j) { a0[j] = fminf(fmaxf(a0[j], -30.f), 30.f); a1[j] = fminf(fmaxf(a1[j], -30.f), 30.f); b0[j] = fminf(fmaxf(b0[j], -30.f), 30.f); b1[j] = fminf(fmaxf(b1[j], -30.f), 30.f); }
                    float ea[8], eb[8], rr[8], gb[8];
#pragma unroll
                    for (int j = 0; j < 4; ++j) { ea[j] = 1.0f + __expf(-a0[j]); ea[4 + j] = 1.0f + __expf(-a1[j]); eb[j] = 1.0f + __expf(-b0[j]); eb[4 + j] = 1.0f + __expf(-b1[j]); }
#pragma unroll
                    for (int j = 0; j < 8; ++j) { rr[j] = eb[j] * __builtin_amdgcn_rcpf(ea[j]); gb[j] = 1.0f * __builtin_amdgcn_rcpf(eb[j]); }
                    u32x4 wr_, wg_;
                    wr_.x = cvt_pk_bf16(rr[0], rr[1]); wr_.y = cvt_pk_bf16(rr[2], rr[3]); wr_.z = cvt_pk_bf16(rr[4], rr[5]); wr_.w = cvt_pk_bf16(rr[6], rr[7]);
                    wg_.x = cvt_pk_bf16(gb[0], gb[1]); wg_.y = cvt_pk_bf16(gb[2], gb[3]); wg_.z = cvt_pk_bf16(gb[4], gb[5]); wg_.w = cvt_pk_bf16(gb[6], gb[7]);
                    const size_t o = ((((((size_t)u.pm * 8 + ((pn - 48) >> 1)) * 2 + ((pn - 48) & 1)) * 2 + ai) * 4 + m) * 8 + (wr * 4 + wc)) * 512 + (size_t)(fr + 16 * fq) * 8;
                    *(u32x4*)(R + o) = wr_; *(u32x4*)(GB + o) = wg_;
                }
        }
    }
};
__device__ __forceinline__ void merge_store(const bf16_t* __restrict__ GB, bf16_t* __restrict__ merged, const f32x4 (&acc)[2][2][4][2], int row0, int col0, size_t gbase, int wl) {
#pragma unroll
    for (int ai = 0; ai < 2; ++ai) {
        u32x4 gv[4][2];
#pragma unroll
        for (int m = 0; m < 4; ++m)
#pragma unroll
            for (int bj = 0; bj < 2; ++bj) gv[m][bj] = *(const u32x4*)(GB + ((((gbase * 2 + bj) * 2 + ai) * 4 + m) * 8) * 512 + wl);
#pragma unroll
        for (int m = 0; m < 4; ++m)
#pragma unroll
            for (int bj = 0; bj < 2; ++bj) { const u32x4 g = gv[m][bj]; const f32x4 v0 = acc[ai][bj][m][0], v1 = acc[ai][bj][m][1];
                u32x4 w; w.x = cvt_pk_bf16(v0[0] * bflo(g.x), v0[1] * bfhi(g.x)); w.y = cvt_pk_bf16(v0[2] * bflo(g.y), v0[3] * bfhi(g.y));
                w.z = cvt_pk_bf16(v1[0] * bflo(g.z), v1[1] * bfhi(g.z)); w.w = cvt_pk_bf16(v1[2] * bflo(g.w), v1[3] * bfhi(g.w));
                *(u32x4*)(merged + (size_t)(row0 + ai * 128 + m * 16) * 2048 + col0 + bj * 128) = w; }
    }
}
struct EpiMerge {
    static constexpr bool PERM = true, AFTER_DRAIN = false;
    const bf16_t* R; const bf16_t* GB; bf16_t* merged;
    __device__ __forceinline__ bool keep(const pg8::Unit& u) const { return u.kh == 0; }
    __device__ __forceinline__ void operator()(f32x4 (&acc)[2][2][4][2], const pg8::Unit& u, int wr, int wc, int fr, int fq) const {
        const int row0 = u.pm * 256 + wr * 64 + fr, col0 = u.pn * 256 + wc * 32 + 8 * fq;
        const size_t gbase = (size_t)u.pm * 8 + u.pn; const int wl = (wr * 4 + wc) * 512 + (fr + 16 * fq) * 8;
        if (u.kh == 0) {
#pragma unroll
            for (int ai = 0; ai < 2; ++ai) {
                u32x4 rv[4][2];
#pragma unroll
                for (int m = 0; m < 4; ++m)
#pragma unroll
                    for (int bj = 0; bj < 2; ++bj) rv[m][bj] = *(const u32x4*)(R + ((((gbase * 2 + bj) * 2 + ai) * 4 + m) * 8) * 512 + wl);
#pragma unroll
                for (int m = 0; m < 4; ++m)
#pragma unroll
                    for (int bj = 0; bj < 2; ++bj) { const u32x4 g = rv[m][bj];
                        f32x4 v0 = acc[ai][bj][m][0], v1 = acc[ai][bj][m][1];
                        v0[0] *= bflo(g.x); v0[1] *= bfhi(g.x); v0[2] *= bflo(g.y); v0[3] *= bfhi(g.y); v1[0] *= bflo(g.z); v1[1] *= bfhi(g.z); v1[2] *= bflo(g.w); v1[3] *= bfhi(g.w);
                        acc[ai][bj][m][0] = v0; acc[ai][bj][m][1] = v1; }
            }
        } else merge_store(GB, merged, acc, row0, col0, gbase, wl);
    }
};
struct SplitKOrder : pg8::StaticOrder {
    __device__ bool next(int i, pg8::Unit& u) const { const bool ok = pg8::StaticOrder::next(i >> 1, u); u.kh = i & 1; return ok; }
};
__device__ __forceinline__ void out_store(const float* __restrict__ x, float* __restrict__ out, float* __restrict__ ssq, const f32x4 (&acc)[2][2][4][2], int row0, int col0, int fq) {
    f32x4 xv[2][4];
#pragma unroll
    for (int bj = 0; bj < 2; ++bj)
#pragma unroll
        for (int n = 0; n < 2; ++n) xv[0][bj * 2 + n] = *(const f32x4*)(x + (size_t)row0 * 2048 + col0 + bj * 128 + n * 16);
#pragma unroll
    for (int gi = 0; gi < 8; ++gi) {
        const int ai = gi >> 2, m = gi & 3;
        if (gi < 7) { const int ai2 = (gi + 1) >> 2, m2 = (gi + 1) & 3;
#pragma unroll
            for (int bj = 0; bj < 2; ++bj)
#pragma unroll
                for (int n = 0; n < 2; ++n) xv[(gi + 1) & 1][bj * 2 + n] = *(const f32x4*)(x + (size_t)(row0 + ai2 * 128 + m2 * 16) * 2048 + col0 + bj * 128 + n * 16); }
        const size_t row = (size_t)(row0 + ai * 128 + m * 16); float q = 0.f;
#pragma unroll
        for (int bj = 0; bj < 2; ++bj)
#pragma unroll
            for (int n = 0; n < 2; ++n) { const f32x4 r = xv[gi & 1][bj * 2 + n] + acc[ai][bj][m][n];
                q += (r[0] * r[0] + r[1] * r[1]) + (r[2] * r[2] + r[3] * r[3]);
                *(f32x4*)(out + row * 2048 + col0 + bj * 128 + n * 16) = r; }
        q += __shfl_xor(q, 16); q += __shfl_xor(q, 32);
        if (fq == 0) atomic_addf(ssq + row, q);
    }
}
struct EpiOut {
    static constexpr bool PERM = false, AFTER_DRAIN = false;
    __device__ __forceinline__ bool keep(const pg8::Unit&) const { return false; }
    const float* x; float* out; float* ssq;
    __device__ __forceinline__ void operator()(const f32x4 (&acc)[2][2][4][2], const pg8::Unit& u, int wr, int wc, int fr, int fq) const {
        out_store(x, out, ssq, acc, u.pm * 256 + wr * 64 + fr, u.pn * 256 + wc * 32 + 4 * fq, fq);
    }
};

struct EpiAcc {
    static constexpr bool PERM = true, AFTER_DRAIN = false;
    __device__ __forceinline__ bool keep(const pg8::Unit&) const { return false; }
    bf16_t* O;
    __device__ __forceinline__ void operator()(const f32x4 (&acc)[2][2][4][2], const pg8::Unit& u, int wr, int wc, int fr, int fq) const {
        const int row0 = u.pm * 256 + wr * 64 + fr, col0 = u.pn * 256 + wc * 32 + 8 * fq;
#pragma unroll
        for (int ai = 0; ai < 2; ++ai)
#pragma unroll
            for (int m = 0; m < 4; ++m)
#pragma unroll
                for (int bj = 0; bj < 2; ++bj) {
                    const f32x4 v0 = acc[ai][bj][m][0], v1 = acc[ai][bj][m][1];
                    u32x4 w; w.x = cvt_pk_bf16(v0[0], v0[1]); w.y = cvt_pk_bf16(v0[2], v0[3]); w.z = cvt_pk_bf16(v1[0], v1[1]); w.w = cvt_pk_bf16(v1[2], v1[3]);
                    *(u32x4*)(O + (size_t)(row0 + ai * 128 + m * 16) * 2048 + col0 + bj * 128) = w;
                }
    }
};

__device__ __forceinline__ void transpose_item(const float* W, int ldw, int K, int k0, int n0, bf16_t* dst, LAS float* scr, int lane, int kd = -1) {
    if (kd < 0) kd = k0;
#pragma unroll 8
    for (int i = 0; i < 32; ++i) { const int kk = 2 * i + (lane >> 5); scr[kk * 33 + (lane & 31)] = W[(size_t)(k0 + kk) * ldw + n0 + (lane & 31)]; }
    asm volatile("s_waitcnt lgkmcnt(0)" ::: "memory");
    const int c = lane & 7;
#pragma unroll
    for (int j = 0; j < 4; ++j) { const int n = (lane >> 3) + 8 * j; const LAS float* s = scr + (8 * c) * 33 + n;
        u32x4 o; o.x = cvt_pk_bf16(s[0 * 33], s[1 * 33]); o.y = cvt_pk_bf16(s[2 * 33], s[3 * 33]); o.z = cvt_pk_bf16(s[4 * 33], s[5 * 33]); o.w = cvt_pk_bf16(s[6 * 33], s[7 * 33]);
        *(u32x4*)(dst + (size_t)n * K + kd + 8 * c) = o; }
    asm volatile("s_waitcnt lgkmcnt(0)" ::: "memory");
}
struct TItem { const float* src; bf16_t* dst; int ldw, ldd; };
__device__ __forceinline__ void titem_load(const TItem& t, f32x4 (&v)[16], int lane) {
    const int r4 = lane >> 4, c4 = lane & 15;
#pragma unroll
    for (int i = 0; i < 16; ++i) v[i] = __builtin_nontemporal_load((const f32x4*)(t.src + (size_t)(4 * i + r4) * t.ldw + 4 * c4));
}
__device__ __forceinline__ void titem_finish(const TItem& t, const f32x4 (&v)[16], LAS float* scr, int lane) {
    const int r4 = lane >> 4, c4 = lane & 15;
#pragma unroll
    for (int i = 0; i < 16; ++i) { LAS float* p = scr + (4 * i + r4) * 65 + 4 * c4; p[0] = v[i][0]; p[1] = v[i][1]; p[2] = v[i][2]; p[3] = v[i][3]; }
    asm volatile("s_waitcnt lgkmcnt(0)" ::: "memory");
    const int c = lane & 7;
#pragma unroll
    for (int i = 0; i < 8; ++i) { const int n = (lane >> 3) + 8 * i; const LAS float* s = scr + (8 * c) * 65 + n;
        u32x4 o; o.x = cvt_pk_bf16(s[0 * 65], s[1 * 65]); o.y = cvt_pk_bf16(s[2 * 65], s[3 * 65]); o.z = cvt_pk_bf16(s[4 * 65], s[5 * 65]); o.w = cvt_pk_bf16(s[6 * 65], s[7 * 65]);
        *(u32x4*)(t.dst + (size_t)n * t.ldd + 8 * c) = o; }
    asm volatile("s_waitcnt lgkmcnt(0)" ::: "memory");
}
__device__ __forceinline__ int proj_row(int n0) {
    if (n0 < 2048) return 256 * (n0 >> 7) + (n0 & 127);
    if (n0 < 4096) return 4096 + (n0 - 2048);
    if (n0 < 6144) { const int ch = n0 - 4096; return 256 * (ch >> 7) + 128 + (ch & 127); }
    if (n0 < 12288) return n0;
    if (n0 < 12320) return -1;
    { const int c = n0 - 12320, n = c >> 11, ch = c & 2047; return 12288 + 256 * (ch >> 7) + 128 * n + (ch & 127); }
}

template <int W> struct ConvRaw { static constexpr int CG = W / 8, RB = NT / CG, RPT = 128 / RB; u32x4 r[RPT + 3]; };
template <int W>
__device__ __forceinline__ void stage_conv_load(ConvRaw<W>& raw, const bf16_t* xbc, int tok0, int cidx, int col0, int tid) {
    constexpr int CG = ConvRaw<W>::CG, RPT = ConvRaw<W>::RPT;
    const int cgi = tid % CG, rb = tid / CG, r0 = rb * RPT;
    const bf16_t* src = xbc + (size_t)tok0 * 4096 + col0 + cgi * 8;
#pragma unroll
    for (int i = 0; i < RPT + 3; ++i) { const int r = r0 - 3 + i;
        if (cidx == 0 && r < 0) raw.r[i] = (u32x4){0u, 0u, 0u, 0u}; else raw.r[i] = *(const u32x4*)(src + (ptrdiff_t)r * 4096); }
}
template <int W>
__device__ __forceinline__ void stage_conv_finish(const ConvRaw<W>& raw, LAS unsigned char* dst, int stride, int col0, const float* conv_w, const float* conv_b, const LAS float* scale, int tid, bf16_t* gdst = nullptr, int gstride = 0) {
    constexpr int CG = ConvRaw<W>::CG, RPT = ConvRaw<W>::RPT;
    const int cgi = tid % CG, rb = tid / CG, r0 = rb * RPT, ch0 = col0 + cgi * 8;
    float w[4][8], bias[8], h0[8], h1[8], h2[8];
#pragma unroll
    for (int k = 0; k < 4; ++k) { const f32x4 a = *(const f32x4*)(conv_w + k * 4096 + ch0), b = *(const f32x4*)(conv_w + k * 4096 + ch0 + 4);
#pragma unroll
        for (int j = 0; j < 4; ++j) { w[k][j] = a[j]; w[k][4 + j] = b[j]; } }
    { const f32x4 a = *(const f32x4*)(conv_b + ch0), b = *(const f32x4*)(conv_b + ch0 + 4);
#pragma unroll
      for (int j = 0; j < 4; ++j) { bias[j] = a[j]; bias[4 + j] = b[j]; } }
#define UNPK(v_, o) do { o[0] = bflo(v_.x); o[1] = bfhi(v_.x); o[2] = bflo(v_.y); o[3] = bfhi(v_.y); o[4] = bflo(v_.z); o[5] = bfhi(v_.z); o[6] = bflo(v_.w); o[7] = bfhi(v_.w); } while (0)
    UNPK(raw.r[0], h0); UNPK(raw.r[1], h1); UNPK(raw.r[2], h2);
#pragma unroll
    for (int i = 0; i < RPT; ++i) {
        float cur[8], o[8]; UNPK(raw.r[3 + i], cur);
        float sc = 1.0f; if (scale) sc = scale[(cgi >> 3) * 128 + r0 + i];
#pragma unroll
        for (int j = 0; j < 8; ++j) { float v = bias[j] + w[0][j] * h0[j] + w[1][j] * h1[j] + w[2][j] * h2[j] + w[3][j] * cur[j]; o[j] = silu_f(v) * sc; h0[j] = h1[j]; h1[j] = h2[j]; h2[j] = cur[j]; }
        u32x4 pk; pk.x = cvt_pk_bf16(o[0], o[1]); pk.y = cvt_pk_bf16(o[2], o[3]); pk.z = cvt_pk_bf16(o[4], o[5]); pk.w = cvt_pk_bf16(o[6], o[7]);
        { LAS unsigned char* q_ = dst + (r0 + i) * stride + (32 * (cgi >> 2) + 4 * (cgi & 3)) * 2;
          *(LAS u32x2*)q_ = (u32x2){pk.x, pk.y}; *(LAS u32x2*)(q_ + 32) = (u32x2){pk.z, pk.w}; }
        if (gdst) *(u32x4*)(gdst + (size_t)(r0 + i) * gstride + cgi * 8) = pk;
    }
#undef UNPK
}
__device__ __forceinline__ float chunk_prefix(LAS float* adt, LAS float* ac, const float* DT, const float* a_log, int tok0, int g, int tid) {
    const int k = tid >> 7, l = tid & 127, h = g * 4 + k, lane = tid & 63;
    const float dtv = DT[(size_t)h * M_TOK + tok0 + l];
    const float a = -expf(a_log[h]);
    float s = dtv * a;
#pragma unroll
    for (int o = 1; o < 64; o <<= 1) { const float t = __shfl_up(s, o); if (lane >= o) s += t; }
    if (lane == 63) adt[tid >> 6] = s;
    __syncthreads();
    if (l >= 64) s += adt[(tid >> 6) - 1];
    ac[k * 128 + l] = s;
    __syncthreads();
    return dtv;
}

constexpr int XS_STRIDE = 528, CB_STRIDE = 272;

__device__ __forceinline__ void own_barrier(unsigned* bar, unsigned target) {
    if (threadIdx.x == 0) {
        __hip_atomic_fetch_add(bar, 1u, __ATOMIC_RELAXED, __HIP_MEMORY_SCOPE_AGENT);
        const unsigned long long t0 = __builtin_amdgcn_s_memrealtime();
        while (__hip_atomic_load(bar, __ATOMIC_RELAXED, __HIP_MEMORY_SCOPE_AGENT) < target) {
            __builtin_amdgcn_s_sleep(2);
            if (__builtin_amdgcn_s_memrealtime() - t0 > 200000000ull) break;
        }
    }
    __syncthreads();
}
#define GRID_SYNC(i) do { asm volatile("s_waitcnt vmcnt(0) lgkmcnt(0)" ::: "memory"); grid.sync(); \
    __builtin_amdgcn_fence(__ATOMIC_ACQUIRE, "agent"); asm volatile("s_waitcnt vmcnt(0)" ::: "memory"); __syncthreads(); STAMP(i); } while (0)
#ifdef SPIN_PHASE
#define STAMP(i) do { if (bx == 0 && tid == 0) { ((unsigned long long*)(BAR + 16))[i] = __builtin_amdgcn_s_memrealtime(); } } while (0)
#else
#define STAMP(i) do { } while (0)
#endif
#ifdef SPIN_SUB
#define SUBSTAMP(i) do { if (bx == 0 && tid == 0 && j == 0) ((unsigned long long*)(BAR + 16))[16 + (i)] = __builtin_amdgcn_s_memrealtime(); } while (0)
#else
#define SUBSTAMP(i) do { } while (0)
#endif
__global__ void __launch_bounds__(NT, 2) fwd_megakernel(Args A) {
    extern __shared__ __attribute__((aligned(16))) unsigned char lds_raw[];
    LAS unsigned char* lds = (LAS unsigned char*)lds_raw;
    const unsigned lds_u32 = (unsigned)(size_t)lds_raw;
    cg::grid_group grid = cg::this_grid();
    const int tid = threadIdx.x, lane = tid & 63, wave = __builtin_amdgcn_readfirstlane(tid >> 6), fr = lane & 15, fq = lane >> 4;
    const int G = gridDim.x, bx = blockIdx.x;
    const int gw = bx * NWAVES + wave, NGW = G * NWAVES;
    unsigned char* ws = A.ws;
    bf16_t* WinT = (bf16_t*)A.out; bf16_t* H = (bf16_t*)((unsigned char*)A.out + 64 * MiB);
    bf16_t* STATES = (bf16_t*)A.out;
    bf16_t* WdtT = (bf16_t*)(ws + WS_WDT); bf16_t* WsB = (bf16_t*)(ws + WS_WSB); float* STATS = (float*)(ws + WS_STATS); float* SSQ = (float*)(ws + WS_SSQ);
    float* CD = (float*)(ws + WS_CD); float* DT = (float*)(ws + WS_DT); unsigned* BAR = (unsigned*)(ws + WS_BAR); unsigned bar_epoch = 0;
    bf16_t* WbT = (bf16_t*)(ws + WS_WB); bf16_t* WoT = (bf16_t*)(ws + WS_WO); bf16_t* YAB = (bf16_t*)(ws + WS_YAB); bf16_t* V = (bf16_t*)(ws + WS_V);
    bf16_t* PREV = (bf16_t*)(ws + WS_V); bf16_t* MERGED = (bf16_t*)(ws + WS_V);
    bf16_t* CC = (bf16_t*)(ws + WS_CC); bf16_t* YD = (bf16_t*)((unsigned char*)A.out + 64 * MiB);
    bf16_t* XBC = (bf16_t*)(ws + WS_XBC); bf16_t* RG = (bf16_t*)(ws + WS_R); bf16_t* GB = (bf16_t*)(ws + WS_GB);

    STAMP(0);
    if constexpr ((PH_MASK >> 0) & 1)
    {
        LAS float* scr = (LAS float*)(lds + wave * 16640);
        constexpr int I_IN = 32 * 256, I_B = 32 * 32, I_O = 32 * 32, NITEMS = I_IN + 2 * I_B + I_O;
        auto item_of = [&](int it) -> TItem {
            TItem t; int r = it;
            if (r < I_IN) { const int kb = r >> 8, nb = r & 255, n0 = nb < 192 ? 64 * nb : 12320 + 64 * (nb - 192);
                t.src = A.w_in + (size_t)(64 * kb) * NIN + n0; t.ldw = NIN; t.dst = WinT + (size_t)proj_row(n0) * 2048 + 64 * kb; t.ldd = 2048; return t; }
            r -= I_IN;
            if (r < 2 * I_B) { const int nbr = r / I_B, rr = r % I_B, kb = rr >> 5, nb = rr & 31;
                t.src = A.w_branch + (size_t)nbr * 2048 * 2048 + (size_t)(64 * kb) * 2048 + 64 * nb; t.ldw = 2048; t.dst = WbT + (size_t)(64 * nb) * 4096 + nbr * 2048 + 64 * kb; t.ldd = 4096; return t; }
            r -= 2 * I_B;
            { const int kb = r >> 5, nb = r & 31; t.src = A.w_out + (size_t)(64 * kb) * 2048 + 64 * nb; t.ldw = 2048; t.dst = WoT + (size_t)(64 * nb) * 2048 + 64 * kb; t.ldd = 2048; return t; }
        };
        {
            f32x4 va[16], vb[16]; int it = gw; TItem ta, tb;
            if (it < NITEMS) { ta = item_of(it); titem_load(ta, va, lane); }
            while (it < NITEMS) {
                const int it2 = it + NGW, it3 = it2 + NGW;
                if (it2 < NITEMS) { tb = item_of(it2); titem_load(tb, vb, lane); }
                titem_finish(ta, va, scr, lane);
                if (it3 < NITEMS) { ta = item_of(it3); titem_load(ta, va, lane); }
                if (it2 < NITEMS) titem_finish(tb, vb, scr, lane);
                it = it3;
            }
        }
        for (int r = gw; r < 32; r += NGW) transpose_item(A.w_in, NIN, 2048, 64 * r, 12288, WdtT, scr, lane);
        for (int i = bx * NT + tid; i < 8 * 128 * 128; i += G * NT) { const int t = (i >> 7) & 127, s = i & 127; const float v = (s <= t) ? A.w_sp[i] : 0.f; WsB[i] = (bf16_t)(cvt_pk_bf16(v, 0.f) & 0xffffu); }
        for (int i = bx * NT + tid; i < 2 * M_TOK; i += G * NT) STATS[i] = 0.f;
        for (int i = bx * NT + tid; i < M_TOK; i += G * NT) SSQ[i] = 0.f;
        for (int m = gw; m < M_TOK; m += 2 * NGW) {
            const int m2 = m + NGW;
            const f32x4* xr = (const f32x4*)(A.x + (size_t)m * DM) + lane; const f32x4* xr2 = (const f32x4*)(A.x + (size_t)m2 * DM) + lane; const f32x4* wr4 = (const f32x4*)A.norm_w + lane;
            f32x4 v[8], v2[8]; float s = 0.f, s2 = 0.f;
#pragma unroll
            for (int j = 0; j < 8; ++j) { v[j] = __builtin_nontemporal_load(xr + 64 * j); v2[j] = __builtin_nontemporal_load(xr2 + 64 * j); }
#pragma unroll
            for (int j = 0; j < 8; ++j) { s += (v[j][0] * v[j][0] + v[j][1] * v[j][1]) + (v[j][2] * v[j][2] + v[j][3] * v[j][3]); s2 += (v2[j][0] * v2[j][0] + v2[j][1] * v2[j][1]) + (v2[j][2] * v2[j][2] + v2[j][3] * v2[j][3]); }
            const float rstd = 1.0f / sqrtf(wave_sum(s) * (1.0f / DM) + EPS), rstd2 = 1.0f / sqrtf(wave_sum(s2) * (1.0f / DM) + EPS);
            u32x2* o8 = (u32x2*)(H + (size_t)m * DM) + lane; u32x2* o82 = (u32x2*)(H + (size_t)m2 * DM) + lane;
#pragma unroll
            for (int j = 0; j < 8; ++j) { const f32x4 w4 = wr4[64 * j];
                u32x2 o; o.x = cvt_pk_bf16(v[j][0] * rstd * w4[0], v[j][1] * rstd * w4[1]); o.y = cvt_pk_bf16(v[j][2] * rstd * w4[2], v[j][3] * rstd * w4[3]); o8[64 * j] = o;
                u32x2 o2; o2.x = cvt_pk_bf16(v2[j][0] * rstd2 * w4[0], v2[j][1] * rstd2 * w4[1]); o2.y = cvt_pk_bf16(v2[j][2] * rstd2 * w4[2], v2[j][3] * rstd2 * w4[3]); o82[64 * j] = o2; }
        }
    }
    GRID_SYNC(1);

    if constexpr ((PH_MASK >> 1) & 1)
    {
        pg8::Gemm g{H, WinT, M_TOK, NPROJ, DM, DM}; pg8::StaticOrder S; S.init(M_TOK, NPROJ, G, bx, WGM_P1);
        EpiProj E{YAB, V, XBC, RG, GB, STATS, A.b_gate};
        pg8::gemm_phase<EpiProj, pg8::StaticOrder, true, true>(lds, g, S, E);
        {
            constexpr int WROW = 4112;
#pragma unroll
            for (int i = 0; i < 16; ++i) { const int row = 2 * i + (tid >> 8), ch = tid & 255;
                *(LAS u32x4*)(lds + row * WROW + ch * 16) = *(const u32x4*)(WdtT + (size_t)row * DM + ch * 8); }
            __syncthreads();
            for (int t0 = bx * 4; t0 < M_TOK / 16; t0 += G * 4) {
                const int t = t0 + (wave >> 1), kh = wave & 1;
                f32x4 acc0 = {0.f, 0.f, 0.f, 0.f}, acc1 = {0.f, 0.f, 0.f, 0.f};
                const bf16_t* ap = H + (size_t)(16 * t + fr) * DM + 8 * fq + kh * 1024;
                const LAS unsigned char* bp = lds + fr * WROW + (8 * fq + kh * 1024) * 2;
#pragma unroll 16
                for (int ks = 0; ks < 32; ++ks) {
                    const bf16x8 fa = *(const bf16x8*)(ap + 32 * ks), fb0 = *(const LAS bf16x8*)(bp + 64 * ks), fb1 = *(const LAS bf16x8*)(bp + 16 * WROW + 64 * ks);
                    acc0 = __builtin_amdgcn_mfma_f32_16x16x32_bf16(fb0, fa, acc0, 0, 0, 0);
                    acc1 = __builtin_amdgcn_mfma_f32_16x16x32_bf16(fb1, fa, acc1, 0, 0, 0);
                }
                LAS f32x4* xch = (LAS f32x4*)(lds + 32 * WROW) + (wave >> 1) * 128 + lane * 2;
                if (kh) { xch[0] = acc0; xch[1] = acc1; }
                __syncthreads();
                if (!kh) {
                    acc0 += xch[0]; acc1 += xch[1];
                    const f32x4 bb0 = *(const f32x4*)(A.dt_bias + 4 * fq), bb1 = *(const f32x4*)(A.dt_bias + 16 + 4 * fq);
                    f32x4 o0, o1;
#pragma unroll
                    for (int j = 0; j < 4; ++j) { const float v0 = acc0[j] + bb0[j], v1 = acc1[j] + bb1[j];
                        o0[j] = fmaxf(v0, 0.f) + log1pf(expf(-fabsf(v0))); o1[j] = fmaxf(v1, 0.f) + log1pf(expf(-fabsf(v1))); }
                    float* dp = DT + (size_t)(4 * fq) * M_TOK + 16 * t + fr;
#pragma unroll
                    for (int j = 0; j < 4; ++j) { dp[(size_t)j * M_TOK] = o0[j]; dp[(size_t)(16 + j) * M_TOK] = o1[j]; }
                }
                __syncthreads();
            }
        }
    }
    GRID_SYNC(2);

    if constexpr ((PH_MASK >> 2) & 1)
    for (int j = bx; j < 2048; j += G) {
        const int jj = j & 1023, g = jj & 7, bc = jj >> 3, tok0 = bc * 128, cidx = bc & 31;
        int tid = threadIdx.x; asm volatile("" : "+v"(tid));
        const int lane = tid & 63, fr = lane & 15, fq = lane >> 4;
        if (j < 1024) {
            {
                const bf16_t* wsrc = WsB + (size_t)g * 16384;
                u32x4 wv[4];
#pragma unroll
                for (int i = 0; i < 4; ++i) wv[i] = *(const u32x4*)(wsrc + (size_t)(i * 32 + (tid >> 4)) * 128 + (tid & 15) * 8);
#pragma unroll
                for (int i = 0; i < 4; ++i) *(LAS u32x4*)(lds + 67584 + (i * 32 + (tid >> 4)) * CB_STRIDE + (tid & 15) * 16) = wv[i];
            }
            bf16_t* p0 = YAB + (size_t)(tok0 + fr) * 4096 + g * 256 + 32 * wave + 8 * fq;
            u32x4 sv[8]; float bs[8];
#pragma unroll
            for (int mt = 0; mt < 8; ++mt) { bs[mt] = A.b_sp[g * 128 + 16 * mt + fr]; sv[mt] = *(const u32x4*)(p0 + (size_t)(16 * mt) * 4096); }
            {
                const int cgi = tid & 31, rb = tid >> 5, d0 = g * 256 + cgi * 8;
                const f32x4 lw0 = *(const f32x4*)(A.ln_w + d0), lw1 = *(const f32x4*)(A.ln_w + d0 + 4), lb0 = *(const f32x4*)(A.ln_b + d0), lb1 = *(const f32x4*)(A.ln_b + d0 + 4);
#pragma unroll
                for (int i = 0; i < 8; ++i) {
                    const int r = rb * 8 + i, tok = tok0 + r;
                    const float2 st2 = *(const float2*)(STATS + 2 * tok); const float mean = st2.x * (1.0f / 2048.0f), var = st2.y * (1.0f / 2048.0f) - mean * mean, rstd = 1.0f / sqrtf(fmaxf(var, 0.f) + EPS);
                    const u32x4 v = *(const u32x4*)(V + (size_t)tok * 2048 + d0);
                    u32x4 pk;
                    pk.x = cvt_pk_bf16((bflo(v.x) - mean) * rstd * lw0[0] + lb0[0], (bfhi(v.x) - mean) * rstd * lw0[1] + lb0[1]);
                    pk.y = cvt_pk_bf16((bflo(v.y) - mean) * rstd * lw0[2] + lb0[2], (bfhi(v.y) - mean) * rstd * lw0[3] + lb0[3]);
                    pk.z = cvt_pk_bf16((bflo(v.z) - mean) * rstd * lw1[0] + lb1[0], (bfhi(v.z) - mean) * rstd * lw1[1] + lb1[1]);
                    pk.w = cvt_pk_bf16((bflo(v.w) - mean) * rstd * lw1[2] + lb1[2], (bfhi(v.w) - mean) * rstd * lw1[3] + lb1[3]);
                    { LAS unsigned char* q_ = lds + r * XS_STRIDE + (32 * (cgi >> 2) + 4 * (cgi & 3)) * 2; *(LAS u32x2*)q_ = (u32x2){pk.x, pk.y}; *(LAS u32x2*)(q_ + 32) = (u32x2){pk.z, pk.w}; }
                }
            }
            __syncthreads();
            f32x4 acc[8][2];
#pragma unroll
            for (int mt = 0; mt < 8; ++mt) { acc[mt][0] = (f32x4){0.f, 0.f, 0.f, 0.f}; acc[mt][1] = (f32x4){0.f, 0.f, 0.f, 0.f}; }
            const unsigned tra = lds_u32 + (8 * fq + (fr >> 2)) * XS_STRIDE + (32 * wave + 4 * (lane & 3)) * 2;
#pragma unroll
            for (int ks = 0; ks < 4; ++ks) {
                bf16x8 fn0, fn1; tr_frag2<4 * XS_STRIDE, 32>(tra + 32 * ks * XS_STRIDE, fn0, fn1);
#pragma unroll
                for (int mt = 2 * ks; mt < 8; ++mt) {
                    const bf16x8 fm = *(const LAS bf16x8*)(lds + 67584 + (16 * mt + fr) * CB_STRIDE + (32 * ks + 8 * fq) * 2);
                    acc[mt][0] = __builtin_amdgcn_mfma_f32_16x16x32_bf16(fn0, fm, acc[mt][0], 0, 0, 0);
                    acc[mt][1] = __builtin_amdgcn_mfma_f32_16x16x32_bf16(fn1, fm, acc[mt][1], 0, 0, 0);
                }
            }
            {
#pragma unroll
                for (int mt = 0; mt < 8; ++mt) { const f32x4 a0 = acc[mt][0], a1 = acc[mt][1]; const u32x4 s4 = sv[mt]; const float b = bs[mt];
                    u32x4 o; o.x = cvt_pk_bf16(bflo(s4.x) * (a0[0] + b), bfhi(s4.x) * (a0[1] + b)); o.y = cvt_pk_bf16(bflo(s4.y) * (a0[2] + b), bfhi(s4.y) * (a0[3] + b));
                    o.z = cvt_pk_bf16(bflo(s4.z) * (a1[0] + b), bfhi(s4.z) * (a1[1] + b)); o.w = cvt_pk_bf16(bflo(s4.w) * (a1[2] + b), bfhi(s4.w) * (a1[3] + b));
                    *(u32x4*)(p0 + (size_t)(16 * mt) * 4096) = o; }
            }
            __syncthreads();
        } else {
            LAS float* ac = (LAS float*)(lds + 137216); LAS float* dtl = ac + 512; LAS float* adt = dtl + 512; LAS float* wg = adt + 512;
            ConvRaw<128> rc, rbb; ConvRaw<256> rx;
            stage_conv_load<128>(rc, XBC, tok0, cidx, 3072 + g * 128, tid); stage_conv_load<128>(rbb, XBC, tok0, cidx, 2048 + g * 128, tid); stage_conv_load<256>(rx, XBC, tok0, cidx, g * 256, tid);
            { const float dtv = chunk_prefix(adt, ac, DT, A.a_log, tok0, g, tid); dtl[tid] = dtv;
              const int k = tid >> 7, l_ = tid & 127; const float aend = ac[k * 128 + 127]; wg[tid] = expf(aend - ac[tid]) * dtv; if (l_ == 127) CD[bc * 32 + g * 4 + k] = expf(aend); }
            stage_conv_finish<128>(rc, lds, CB_STRIDE, 3072 + g * 128, A.conv_w, A.conv_b, nullptr, tid, CC + (size_t)tok0 * 1024 + g * 128, 1024);
            stage_conv_finish<128>(rbb, lds + 34816, CB_STRIDE, 2048 + g * 128, A.conv_w, A.conv_b, nullptr, tid);
            stage_conv_finish<256>(rx, lds + 69632, XS_STRIDE, g * 256, A.conv_w, A.conv_b, nullptr, tid);
            __syncthreads();
            const int l = 16 * wave + fr;
            f32x4 cb[8];
            {
                bf16x8 fc[4];
#pragma unroll
                for (int ks = 0; ks < 4; ++ks) fc[ks] = *(const LAS bf16x8*)(lds + l * CB_STRIDE + (32 * ks + 8 * fq) * 2);
#pragma unroll
                for (int nt = 0; nt < 8; ++nt) {
                    cb[nt] = (f32x4){0.f, 0.f, 0.f, 0.f};
                    if (nt <= wave) {
#pragma unroll
                        for (int ks = 0; ks < 4; ++ks) { const bf16x8 fb = *(const LAS bf16x8*)(lds + 34816 + (16 * nt + fr) * CB_STRIDE + (32 * ks + 8 * fq) * 2);
                            cb[nt] = __builtin_amdgcn_mfma_f32_16x16x32_bf16(fb, fc[ks], cb[nt], 0, 0, 0); }
                    }
                }
            }
            {
                const int k = wave >> 1, ph = wave & 1;
                f32x4 acc[2][8];
#pragma unroll
                for (int mt = 0; mt < 2; ++mt)
#pragma unroll
                    for (int nt = 0; nt < 8; ++nt) acc[mt][nt] = (f32x4){0.f, 0.f, 0.f, 0.f};
                const unsigned xa = lds_u32 + 69632 + (8 * fq + (fr >> 2)) * XS_STRIDE + (k * 64 + 32 * ph + 4 * (lane & 3)) * 2;
                const unsigned ba = lds_u32 + 34816 + (8 * fq + (fr >> 2)) * CB_STRIDE + (4 * (lane & 3)) * 2;
#pragma unroll
                for (int ks = 0; ks < 4; ++ks) {
                    bf16x8 fm0, fm1; tr_frag2<4 * XS_STRIDE, 32>(xa + 32 * ks * XS_STRIDE, fm0, fm1);
                    const f32x4 w0 = *(const LAS f32x4*)(wg + k * 128 + 32 * ks + 8 * fq), w1 = *(const LAS f32x4*)(wg + k * 128 + 32 * ks + 8 * fq + 4);
                    const float wv[8] = {w0[0], w0[1], w0[2], w0[3], w1[0], w1[1], w1[2], w1[3]};
                    bf16x8 sm0, sm1;
#pragma unroll
                    for (int e = 0; e < 8; e += 2) {
                        const unsigned a0 = cvt_pk_bf16(bf2f((unsigned short)fm0[e]) * wv[e], bf2f((unsigned short)fm0[e + 1]) * wv[e + 1]);
                        const unsigned a1 = cvt_pk_bf16(bf2f((unsigned short)fm1[e]) * wv[e], bf2f((unsigned short)fm1[e + 1]) * wv[e + 1]);
                        sm0[e] = (short)(a0 & 0xffffu); sm0[e + 1] = (short)(a0 >> 16); sm1[e] = (short)(a1 & 0xffffu); sm1[e + 1] = (short)(a1 >> 16);
                    }
#pragma unroll
                    for (int nq = 0; nq < 2; ++nq) {
                        bf16x8 fn[4]; tr_frag4<4 * CB_STRIDE, 32>(ba + 32 * ks * CB_STRIDE + 128 * nq, fn[0], fn[1], fn[2], fn[3]);
#pragma unroll
                        for (int i = 0; i < 4; ++i) {
                            acc[0][4 * nq + i] = __builtin_amdgcn_mfma_f32_16x16x32_bf16(fn[i], sm0, acc[0][4 * nq + i], 0, 0, 0);
                            acc[1][4 * nq + i] = __builtin_amdgcn_mfma_f32_16x16x32_bf16(fn[i], sm1, acc[1][4 * nq + i], 0, 0, 0);
                        }
                    }
                }
                bf16_t* sp = STATES + ((size_t)(bc * 8 + g) * 4096 + (size_t)wave * 512 + lane) * 8;
#pragma unroll
                for (int mt = 0; mt < 2; ++mt)
#pragma unroll
                    for (int q = 0; q < 4; ++q) { const f32x4 a0 = acc[mt][2 * q], a1 = acc[mt][2 * q + 1];
                        u32x4 o; o.x = cvt_pk_bf16(a0[0], a0[1]); o.y = cvt_pk_bf16(a0[2], a0[3]); o.z = cvt_pk_bf16(a1[0], a1[1]); o.w = cvt_pk_bf16(a1[2], a1[3]);
                        *(u32x4*)(sp + (size_t)((mt * 4 + q) * 64) * 8) = o; }
            }
            __syncthreads();
            LAS unsigned char* sw = lds + 34816 + wave * (16 * CB_STRIDE);
            bf16_t* ydp = YD + ((size_t)(jj * 8 + wave) * 8 * 64 + lane) * 8;
#pragma unroll
            for (int k = 0; k < 4; ++k) {
                const int h = g * 4 + k; const float al = ac[k * 128 + l], dsk = A.d_skip[h];
#pragma unroll
                for (int nt = 0; nt < 8; ++nt) {
                    float sv[4];
#pragma unroll
                    for (int r = 0; r < 4; ++r) { const int s = 16 * nt + 4 * fq + r;
                        float v = (s <= l) ? cb[nt][r] * __expf(al - ac[k * 128 + s]) * dtl[k * 128 + s] : 0.f;
                        if (s == l) v += dsk; sv[r] = v; }
                    u32x2 o; o.x = cvt_pk_bf16(sv[0], sv[1]); o.y = cvt_pk_bf16(sv[2], sv[3]);
                    *(LAS u32x2*)(sw + fr * CB_STRIDE + (16 * nt + 4 * fq) * 2) = o;
                    if (nt & 1) asm volatile("" ::: "memory");
                }
                asm volatile("s_waitcnt lgkmcnt(0)" ::: "memory");
                f32x4 ay[4];
#pragma unroll
                for (int pt = 0; pt < 4; ++pt) ay[pt] = (f32x4){0.f, 0.f, 0.f, 0.f};
                const unsigned xa = lds_u32 + 69632 + (8 * fq + (fr >> 2)) * XS_STRIDE + (k * 64 + 4 * (lane & 3)) * 2;
#pragma unroll
                for (int ks = 0; ks < 4; ++ks) {
                    if (ks <= (wave >> 1)) {
                        const bf16x8 fs = *(const LAS bf16x8*)(sw + fr * CB_STRIDE + (32 * ks + 8 * fq) * 2);
                        bf16x8 fx[4]; tr_frag4<4 * XS_STRIDE, 32>(xa + 32 * ks * XS_STRIDE, fx[0], fx[1], fx[2], fx[3]);
#pragma unroll
                        for (int pt = 0; pt < 4; ++pt) ay[pt] = __builtin_amdgcn_mfma_f32_16x16x32_bf16(fx[pt], fs, ay[pt], 0, 0, 0);
                    }
                }
#pragma unroll
                for (int q = 0; q < 2; ++q) { u32x4 o; o.x = cvt_pk_bf16(ay[2 * q][0], ay[2 * q][1]); o.y = cvt_pk_bf16(ay[2 * q][2], ay[2 * q][3]); o.z = cvt_pk_bf16(ay[2 * q + 1][0], ay[2 * q + 1][1]); o.w = cvt_pk_bf16(ay[2 * q + 1][2], ay[2 * q + 1][3]); *(u32x4*)(ydp + (size_t)(k * 2 + q) * 512) = o; }
                __builtin_amdgcn_sched_barrier(0);
                asm volatile("s_waitcnt lgkmcnt(0)" ::: "memory");
            }
            __syncthreads();
        }
    }
    GRID_SYNC(3);

    if constexpr ((PH_MASK >> 3) & 1)
    for (int blk = bx; blk < 256; blk += G) {
        const int b = blk >> 6; const unsigned o8 = (unsigned)(blk & 63) * 512u + (unsigned)tid; const int h = (int)(o8 >> 10);
        const bf16_t* sbase = STATES + (size_t)(b * 32) * 262144; bf16_t* pbase = PREV + (size_t)(b * 32) * 262144;
        const unsigned voff = o8 * 8u;
        f32x4 h0 = {0.f, 0.f, 0.f, 0.f}, h1 = {0.f, 0.f, 0.f, 0.f};
#pragma unroll 1
        for (int cb0 = 0; cb0 < 32; cb0 += 16) {
            const bf16_t* sb = sbase + (size_t)cb0 * 262144; bf16_t* pb = pbase + (size_t)cb0 * 262144;
            u32x4 sv[16]; float cdv[16];
#pragma unroll
            for (int c = 0; c < 16; ++c) { sv[c] = *(const u32x4*)(sb + (size_t)c * 262144 + voff); cdv[c] = CD[(b * 32 + cb0 + c) * 32 + h]; }
#pragma unroll
            for (int c = 0; c < 16; ++c) {
                u32x4 o; o.x = cvt_pk_bf16(h0[0], h0[1]); o.y = cvt_pk_bf16(h0[2], h0[3]); o.z = cvt_pk_bf16(h1[0], h1[1]); o.w = cvt_pk_bf16(h1[2], h1[3]);
                *(u32x4*)(pb + (size_t)c * 262144 + voff) = o;
                const f32x4 s0 = {bflo(sv[c].x), bfhi(sv[c].x), bflo(sv[c].y), bfhi(sv[c].y)}, s1 = {bflo(sv[c].z), bfhi(sv[c].z), bflo(sv[c].w), bfhi(sv[c].w)};
                h0 = h0 * cdv[c] + s0; h1 = h1 * cdv[c] + s1;
            }
        }
    }
    GRID_SYNC(4);

    if constexpr ((PH_MASK >> 4) & 1)
    for (int j = bx; j < 1024; j += G) {
        const int g = j & 7, bc = j >> 3, tok0 = bc * 128;
        int tid = threadIdx.x; asm volatile("" : "+v"(tid));
        const int lane = tid & 63, fr = lane & 15, fq = lane >> 4;
        LAS float* ac = (LAS float*)lds; LAS float* adt = ac + 512;
        const int l = 16 * wave + fr;
        bf16x8 fc[4];
#pragma unroll
        for (int ks = 0; ks < 4; ++ks) fc[ks] = *(const bf16x8*)(CC + (size_t)(tok0 + l) * 1024 + g * 128 + 32 * ks + 8 * fq);
        {
            const bf16_t* pg = PREV + (size_t)(bc * 8 + g) * 4096 * 8;
            u32x4 pv[8];
#pragma unroll
            for (int i = 0; i < 8; ++i) pv[i] = *(const u32x4*)(pg + ((size_t)i * 512 + tid) * 8);
            const int mt_ = (tid >> 8) & 1, q_ = (tid >> 6) & 3, fr_ = tid & 15, fq_ = (tid >> 4) & 3;
#pragma unroll
            for (int i = 0; i < 8; ++i) { const int row = (i >> 1) * 64 + 32 * (i & 1) + 8 * (fr_ >> 2) + 4 * mt_ + (fr_ & 3);
                *(LAS u32x4*)(lds + 4096 + row * CB_STRIDE + (32 * q_ + 8 * fq_) * 2) = pv[i]; }
        }
        (void)chunk_prefix(adt, ac, DT, A.a_log, tok0, g, tid);
        f32x4 y[4][4];
        float ss = 0.f;
        bf16_t* zp = YAB + (size_t)(tok0 + l) * 4096 + 2048 + g * 256 + 8 * fq;
        const bf16_t* ydp = YD + ((size_t)(j * 8 + wave) * 8 * 64 + lane) * 8;
        const int prow0 = pg8::perm32(fr), prow1 = pg8::perm32(16 + fr);
#pragma unroll
        for (int k = 0; k < 4; ++k) {
            const int h = g * 4 + k; const float ea = __expf(ac[k * 128 + l]);
            const LAS unsigned char* pp = lds + 4096 + (k * 64) * CB_STRIDE + 16 * fq;
            f32x4 ao[4];
#pragma unroll
            for (int pt = 0; pt < 4; ++pt) ao[pt] = (f32x4){0.f, 0.f, 0.f, 0.f};
            u32x4 zv4[2], yv4[2];
#pragma unroll
            for (int q = 0; q < 2; ++q) { zv4[q] = *(const u32x4*)(zp + k * 64 + q * 32); yv4[q] = *(const u32x4*)(ydp + (size_t)(k * 2 + q) * 512); }
#pragma unroll
            for (int ks = 0; ks < 4; ++ks) {
                bf16x8 fpw[4];
#pragma unroll
                for (int pt = 0; pt < 4; ++pt) fpw[pt] = *(const LAS bf16x8*)(pp + (32 * (pt >> 1) + ((pt & 1) ? prow1 : prow0)) * CB_STRIDE + 64 * ks);
#pragma unroll
                for (int pt = 0; pt < 4; ++pt) ao[pt] = __builtin_amdgcn_mfma_f32_16x16x32_bf16(fpw[pt], fc[ks], ao[pt], 0, 0, 0);
            }
#pragma unroll
            for (int pt = 0; pt < 4; ++pt) { const u32x4 z4 = zv4[pt >> 1], y4 = yv4[pt >> 1];
                const unsigned zlo = (pt & 1) ? z4.z : z4.x, zhi = (pt & 1) ? z4.w : z4.y, ylo = (pt & 1) ? y4.z : y4.x, yhi = (pt & 1) ? y4.w : y4.y;
                f32x4 v = ao[pt] * ea; v[0] = (v[0] + bflo(ylo)) * bflo(zlo); v[1] = (v[1] + bfhi(ylo)) * bfhi(zlo); v[2] = (v[2] + bflo(yhi)) * bflo(zhi); v[3] = (v[3] + bfhi(yhi)) * bfhi(zhi);
                ss += (v[0] * v[0] + v[1] * v[1]) + (v[2] * v[2] + v[3] * v[3]); y[k][pt] = v; }
            __builtin_amdgcn_sched_barrier(0);
        }
        ss += __shfl_xor(ss, 16); ss += __shfl_xor(ss, 32);
        const float rstd = 1.0f / sqrtf(ss * (1.0f / 256.0f) + EPS);
        const float* nw = A.ssm_nw + g * 256 + 8 * fq;
        u32x4 ov[4][2];
#pragma unroll
        for (int k = 0; k < 4; ++k)
#pragma unroll
            for (int q = 0; q < 2; ++q) { const f32x4 w0 = *(const f32x4*)(nw + k * 64 + q * 32), w1 = *(const f32x4*)(nw + k * 64 + q * 32 + 4); const f32x4 v0 = y[k][2 * q], v1 = y[k][2 * q + 1];
                ov[k][q].x = cvt_pk_bf16(v0[0] * rstd * w0[0], v0[1] * rstd * w0[1]); ov[k][q].y = cvt_pk_bf16(v0[2] * rstd * w0[2], v0[3] * rstd * w0[3]);
                ov[k][q].z = cvt_pk_bf16(v1[0] * rstd * w1[0], v1[1] * rstd * w1[1]); ov[k][q].w = cvt_pk_bf16(v1[2] * rstd * w1[2], v1[3] * rstd * w1[3]); }
#pragma unroll
        for (int k = 0; k < 4; ++k)
#pragma unroll
            for (int q = 0; q < 2; ++q) *(u32x4*)(zp + k * 64 + q * 32) = ov[k][q];
        __syncthreads();
    }
    GRID_SYNC(5);

    if constexpr ((PH_MASK >> 5) & 1)
    {
        pg8::Gemm g{YAB, WbT, M_TOK, DM, DM, 2 * DM}; SplitKOrder S; S.init(M_TOK, DM, G, bx, WGM_P5);
        EpiMerge E{RG, GB, MERGED};
        pg8::gemm_phase<EpiMerge, SplitKOrder, true, true>(lds, g, S, E);
    }
    GRID_SYNC(6);

    if constexpr ((PH_MASK >> 6) & 1)
    {
        pg8::Gemm g{MERGED, WoT, M_TOK, DM, DM, DM}; pg8::StaticOrder S; S.init(M_TOK, DM, G, bx, WGM_P6);
        EpiAcc E{YAB};
        pg8::gemm_phase<EpiAcc, pg8::StaticOrder, true, true>(lds, g, S, E);
    }
    GRID_SYNC(7);

    if constexpr ((PH_MASK >> 7) & 1)
    for (int m = gw; m < M_TOK; m += 2 * NGW) {
        const int m2 = m + NGW;
        int tid_ = threadIdx.x; asm volatile("" : "+v"(tid_)); const int lane = tid_ & 63;
        const f32x4* xr = (const f32x4*)(A.x + (size_t)m * DM) + lane; const f32x4* xr2 = (const f32x4*)(A.x + (size_t)m2 * DM) + lane;
        const u32x2* ar = (const u32x2*)(YAB + (size_t)m * DM) + lane; const u32x2* ar2 = (const u32x2*)(YAB + (size_t)m2 * DM) + lane;
        const f32x4* wr4 = (const f32x4*)A.fnw + lane;
        f32x4 v[8], v2[8]; u32x2 a[8], a2[8]; float s = 0.f, s2 = 0.f;
#pragma unroll
        for (int j = 0; j < 8; ++j) { v[j] = __builtin_nontemporal_load(xr + 64 * j); v2[j] = __builtin_nontemporal_load(xr2 + 64 * j); a[j] = __builtin_nontemporal_load(ar + 64 * j); a2[j] = __builtin_nontemporal_load(ar2 + 64 * j); }
#pragma unroll
        for (int j = 0; j < 8; ++j) {
            v[j][0] += bflo(a[j].x); v[j][1] += bfhi(a[j].x); v[j][2] += bflo(a[j].y); v[j][3] += bfhi(a[j].y);
            v2[j][0] += bflo(a2[j].x); v2[j][1] += bfhi(a2[j].x); v2[j][2] += bflo(a2[j].y); v2[j][3] += bfhi(a2[j].y);
            s += (v[j][0] * v[j][0] + v[j][1] * v[j][1]) + (v[j][2] * v[j][2] + v[j][3] * v[j][3]); s2 += (v2[j][0] * v2[j][0] + v2[j][1] * v2[j][1]) + (v2[j][2] * v2[j][2] + v2[j][3] * v2[j][3]); }
        const float rstd = 1.0f / sqrtf(wave_sum(s) * (1.0f / DM) + EPS), rstd2 = 1.0f / sqrtf(wave_sum(s2) * (1.0f / DM) + EPS);
        f32x4* orow = (f32x4*)(A.out + (size_t)m * DM) + lane; f32x4* orow2 = (f32x4*)(A.out + (size_t)m2 * DM) + lane;
#pragma unroll
        for (int j = 0; j < 8; ++j) { const f32x4 w4 = wr4[64 * j]; __builtin_nontemporal_store(v[j] * rstd * w4, orow + 64 * j); __builtin_nontemporal_store(v2[j] * rstd2 * w4, orow2 + 64 * j); }
    }
#ifdef SPIN_SUB
    if (bx == 0 && tid == 0) {
        const unsigned long long* st = (const unsigned long long*)(BAR + 16) + 16;
        const unsigned long long d = (st[SPIN_SUB + 1] - st[SPIN_SUB]) * SPIN_MULT, t0 = __builtin_amdgcn_s_memrealtime();
        while (__builtin_amdgcn_s_memrealtime() - t0 < d) __builtin_amdgcn_s_sleep(10);
    }
#endif
#ifdef SPIN_PHASE
    STAMP(8);
    if (bx == 0 && tid == 0) {
        const unsigned long long* st = (const unsigned long long*)(BAR + 16);
        const unsigned long long d = (st[SPIN_PHASE + 1] - st[SPIN_PHASE]) * SPIN_MULT, t0 = __builtin_amdgcn_s_memrealtime();
        while (__builtin_amdgcn_s_memrealtime() - t0 < d) __builtin_amdgcn_s_sleep(10);
    }
#endif
}

extern "C" void kernel_launch(void* const* d_in, const int* in_sizes, int n_in, void* d_out, int out_size, void* d_ws, size_t ws_size, hipStream_t stream) {
    static int grid = 0;
    if (grid == 0) {
        if (n_in != 17 || out_size != M_TOK * DM || ws_size < WS_END) { fprintf(stderr, "kernel_launch: unexpected shapes (n_in %d out %d ws %zu)\n", n_in, out_size, ws_size); grid = -1; return; }
        int dev = 0, cus = 0, per_cu = 0;
        hipGetDevice(&dev); hipDeviceGetAttribute(&cus, hipDeviceAttributeMultiprocessorCount, dev);
        if (hipFuncSetAttribute((const void*)fwd_megakernel, hipFuncAttributeMaxDynamicSharedMemorySize, LDS_BYTES) != hipSuccess) { fprintf(stderr, "kernel_launch: hipFuncSetAttribute failed\n"); grid = -1; return; }
        if (hipOccupancyMaxActiveBlocksPerMultiprocessor(&per_cu, (const void*)fwd_megakernel, NT, LDS_BYTES) != hipSuccess || per_cu < 1) { fprintf(stderr, "kernel_launch: occupancy query says %d\n", per_cu); per_cu = 1; }
        (void)hipGetLastError();
        grid = cus * 1;
    }
    if (grid < 0) return;
    Args a{};
    a.x = (const float*)d_in[0]; a.norm_w = (const float*)d_in[1]; a.w_in = (const float*)d_in[2]; a.b_gate = (const float*)d_in[3]; a.ln_w = (const float*)d_in[4]; a.ln_b = (const float*)d_in[5];
    a.w_sp = (const float*)d_in[6]; a.b_sp = (const float*)d_in[7]; a.conv_w = (const float*)d_in[8]; a.conv_b = (const float*)d_in[9]; a.dt_bias = (const float*)d_in[10]; a.a_log = (const float*)d_in[11];
    a.d_skip = (const float*)d_in[12]; a.ssm_nw = (const float*)d_in[13]; a.w_branch = (const float*)d_in[14]; a.w_out = (const float*)d_in[15]; a.fnw = (const float*)d_in[16];
    a.out = (float*)d_out; a.ws = (unsigned char*)d_ws;
    if (hipMemsetAsync((char*)d_ws + WS_BAR, 0, 256, stream) != hipSuccess) { fprintf(stderr, "kernel_launch: memset failed\n"); return; }
    void* args[] = {&a};
    hipError_t e = hipLaunchCooperativeKernel((const void*)fwd_megakernel, dim3(grid), dim3(NT), args, LDS_BYTES, stream);
    if (e != hipSuccess) fprintf(stderr, "cooperative launch failed: %s (grid %d)\n", hipGetErrorString(e), grid);
}
```

```cpp
#include <hip/hip_runtime.h>
#include <hip/hip_cooperative_groups.h>
#include <cstdio>
#include <cstdint>
namespace cg = cooperative_groups;
namespace pg8 {
#define PG8_LAS __attribute__((address_space(3)))
typedef unsigned short bf16_t;
typedef short bf16x8 __attribute__((ext_vector_type(8)));
typedef float f32x4 __attribute__((ext_vector_type(4)));
typedef unsigned u32x4 __attribute__((ext_vector_type(4)));
constexpr int BM = 256, BK = 64, HALF = 128, HTB = HALF * BK * 2  , STAGE_BYTES = 8 * HTB, NXCD = 8, WGM = 8;

__host__ __device__ __forceinline__ int lds_byte(int r, int c) { const int st = (r >> 4) * 2 + (c >> 5), rr = r & 15, cc = c & 31, ob = rr * 64 + cc * 2; return st * 1024 + (ob ^ (((ob >> 9) & 1) << 5)); }
__host__ __device__ __forceinline__ void stage_rc(int b, int& R, int& C) { const int st = b / 1024, sb = b % 1024, swz = sb ^ (((sb >> 9) & 1) << 5); R = (st >> 1) * 16 + swz / 64; C = (st & 1) * 32 + (swz % 64) / 2; }
__host__ __device__ __forceinline__ int perm32(int rho) { const int n = rho >> 4, i = rho & 15; return 8 * (i >> 2) + 4 * n + (i & 3); }

struct Unit { int pm, pn, kh; };
struct Gemm { const bf16_t* A; const bf16_t* Bt; int M, N, K, ld; };

struct StaticOrder {
    int nM, nN, nwg, G, c, wgm;
    __host__ __device__ void init(int M, int N, int G_, int c_, int wgm_ = WGM) { nM = M / BM; nN = N / BM; nwg = nM * nN; G = G_; c = c_; wgm = wgm_; }
    __host__ __device__ bool next(int i, Unit& u) const {
        const long L = (long)i * G + c; if (L >= nwg) return false;
        int wgid = (int)L; { const int q = nwg / NXCD, r = nwg % NXCD, xcd = wgid % NXCD, off = wgid / NXCD; wgid = (xcd < r ? xcd * (q + 1) : r * (q + 1) + (xcd - r) * q) + off; }
        const int nig = wgm * nN, gid = wgid / nig, fm = gid * wgm, gsz = (nM - fm) < wgm ? (nM - fm) : wgm;
        u.pm = fm + ((wgid % nig) % gsz); u.pn = (wgid % nig) / gsz; u.kh = 0; return true;
    }
    __device__ __forceinline__ void a_ready(const Unit&) const {}
    __device__ __forceinline__ void done(const Unit&) const {}
};
typedef float f32x2_t_ __attribute__((ext_vector_type(2)));
typedef __bf16 bf16x2_t_ __attribute__((ext_vector_type(2)));
__device__ __forceinline__ unsigned cvt_pk_bf16(float lo, float hi) { const f32x2_t_ v = {lo, hi}; const bf16x2_t_ b = __builtin_convertvector(v, bf16x2_t_); return __builtin_bit_cast(unsigned, b); }
template <class Epi, class Sched, bool ALIGN_EPI = false, bool SP2 = false>
__device__ __forceinline__ void gemm_phase(PG8_LAS unsigned char* lds, const Gemm g, const Sched& S, const Epi& E) {
    int tid_ = threadIdx.x; asm volatile("" : "+v"(tid_));
    const int tid = tid_, wid = __builtin_amdgcn_readfirstlane(tid >> 6), lane = tid & 63, wr = wid >> 2, wc = wid & 3, fr = lane & 15, fq = lane >> 4;
    const int K = g.K, nt = K / BK, ld = g.ld;
    unsigned voffA[2], voffB[2];
#pragma unroll
    for (int i = 0; i < 2; ++i) { int R, C; stage_rc(tid * 16 + i * 8192, R, C); const int Rb = Epi::PERM ? ((R & ~31) + perm32(R & 31)) : R;
        voffA[i] = (unsigned)(R * ld + C) * 2u; voffB[i] = (unsigned)(Rb * ld + C) * 2u; }
    const size_t kstep = (size_t)(BK * 2);
    const size_t hstep = (size_t)HALF * ld * 2;
    const size_t tstep = 2 * hstep;
    const unsigned ldsw = (unsigned)wid * 1024u;
    const int aoff = lds_byte(wr * 64 + fr, fq * 8), boff = lds_byte(wc * 32 + fr, fq * 8);
#define PG8_SA(b, h) (((b) * 2 + (h)) * HTB)
#define PG8_SB(b, h) ((4 + (b) * 2 + (h)) * HTB)
#define PG8_STAGE(bufoff, gbase, voff) do { _Pragma("unroll") for (int _i = 0; _i < 2; ++_i) \
        __builtin_amdgcn_global_load_lds((const unsigned*)((const char*)(gbase) + (voff)[_i]), (PG8_LAS unsigned*)(lds + (bufoff) + ldsw + _i * 8192), 16, 0, 0); } while (0)
#define PG8_LDA(dst, b, h) do { _Pragma("unroll") for (int m = 0; m < 4; ++m) _Pragma("unroll") for (int k = 0; k < 2; ++k) dst[m][k] = *(const PG8_LAS bf16x8*)(lds + PG8_SA(b, h) + aoff + m * 2048 + k * 1024); } while (0)
#define PG8_LDB(dst, b, h) do { _Pragma("unroll") for (int n = 0; n < 2; ++n) _Pragma("unroll") for (int k = 0; k < 2; ++k) dst[n][k] = *(const PG8_LAS bf16x8*)(lds + PG8_SB(b, h) + boff + n * 2048 + k * 1024); } while (0)
#define PG8_MMA(ai, bj, At, Bt) do { __builtin_amdgcn_s_setprio(1); _Pragma("unroll") for (int m = 0; m < 4; ++m) _Pragma("unroll") for (int n = 0; n < 2; ++n) _Pragma("unroll") for (int k = 0; k < 2; ++k) \
        acc[ai][bj][m][n] = __builtin_amdgcn_mfma_f32_16x16x32_bf16(Bt[n][k], At[m][k], acc[ai][bj][m][n], 0, 0, 0); __builtin_amdgcn_s_setprio(0); } while (0)
#define PG8_WAIT_V(n) asm volatile("s_waitcnt vmcnt(" #n ")" ::: "memory")
#define PG8_WAIT_L(n) asm volatile("s_waitcnt lgkmcnt(" #n ")" ::: "memory")
#define PG8_BAR __builtin_amdgcn_s_barrier()
#define PG8_SCHED __builtin_amdgcn_sched_barrier(0)
    Unit cur, nxt; int ui = 0;
    if (!S.next(0, cur)) return;
    f32x4 acc[2][2][4][2];
#pragma unroll
    for (int a = 0; a < 2; ++a)
#pragma unroll
        for (int b = 0; b < 2; ++b)
#pragma unroll
            for (int m = 0; m < 4; ++m)
#pragma unroll
                for (int n = 0; n < 2; ++n) acc[a][b][m][n] = (f32x4){0.f, 0.f, 0.f, 0.f};
    bf16x8 At[4][2], B0[2][2], B1[2][2];
    const char* cA = (const char*)g.A + (size_t)cur.pm * tstep + (size_t)cur.kh * K * 2; const char* cB = (const char*)g.Bt + (size_t)cur.pn * tstep + (size_t)cur.kh * K * 2;
    S.a_ready(cur);
    if constexpr (SP2) {
        PG8_STAGE(PG8_SB(0, 0), cB, voffB); PG8_STAGE(PG8_SB(0, 1), cB + hstep, voffB); PG8_STAGE(PG8_SA(0, 0), cA, voffA); PG8_STAGE(PG8_SA(0, 1), cA + hstep, voffA);
        if (wr == 1) PG8_BAR;
        PG8_WAIT_V(2); PG8_BAR;
        PG8_STAGE(PG8_SB(1, 0), cB + kstep, voffB); PG8_STAGE(PG8_SA(1, 0), cA + kstep, voffA); PG8_STAGE(PG8_SB(1, 1), cB + hstep + kstep, voffB);
        PG8_WAIT_V(6); PG8_BAR;
    } else {
        PG8_STAGE(PG8_SB(0, 0), cB, voffB); PG8_STAGE(PG8_SA(0, 0), cA, voffA); PG8_STAGE(PG8_SB(0, 1), cB + hstep, voffB); PG8_STAGE(PG8_SA(0, 1), cA + hstep, voffA);
        if (wr == 1) PG8_BAR;
        PG8_WAIT_V(4); PG8_BAR;
        PG8_STAGE(PG8_SB(1, 0), cB + kstep, voffB); PG8_STAGE(PG8_SA(1, 0), cA + kstep, voffA); PG8_STAGE(PG8_SB(1, 1), cB + hstep + kstep, voffB);
        PG8_WAIT_V(6); PG8_BAR;
    }
    for (;;) {
        const bool has_next = S.next(ui + 1, nxt);
        const char* nA = has_next ? (const char*)g.A + (size_t)nxt.pm * tstep + (size_t)nxt.kh * K * 2 : cA; const char* nB = has_next ? (const char*)g.Bt + (size_t)nxt.pn * tstep + (size_t)nxt.kh * K * 2 : cB;
        for (int t = 0; t < nt; t += 2) {
            const bool last = (t == nt - 2);
            const char* a1 = cA + (size_t)(t + 1) * kstep;
            const char* a2 = last ? nA : cA + (size_t)(t + 2) * kstep; const char* b2 = last ? nB : cB + (size_t)(t + 2) * kstep;
            const char* a3 = a2 + kstep; const char* b3 = b2 + kstep;
            if (last && has_next) S.a_ready(nxt);
            if constexpr (SP2) {
            PG8_LDB(B0, 0, 0); PG8_LDB(B1, 0, 1); PG8_SCHED; PG8_LDA(At, 0, 0); PG8_STAGE(PG8_SA(1, 1), a1 + hstep, voffA);
            PG8_WAIT_V(8); PG8_WAIT_L(0); PG8_BAR; PG8_MMA(0, 0, At, B0); PG8_MMA(0, 1, At, B1); PG8_BAR; PG8_SCHED;
            PG8_LDA(At, 0, 1); PG8_STAGE(PG8_SB(0, 0), b2, voffB); PG8_STAGE(PG8_SB(0, 1), b2 + hstep, voffB); PG8_STAGE(PG8_SA(0, 0), a2, voffA);
            PG8_WAIT_V(8); PG8_WAIT_L(0); PG8_BAR; PG8_MMA(1, 0, At, B0); PG8_MMA(1, 1, At, B1); PG8_BAR; PG8_SCHED;
            PG8_LDB(B0, 1, 0); PG8_LDB(B1, 1, 1); PG8_SCHED; PG8_LDA(At, 1, 0); PG8_STAGE(PG8_SA(0, 1), a2 + hstep, voffA);
            PG8_WAIT_V(8); PG8_WAIT_L(0); PG8_BAR; PG8_MMA(0, 0, At, B0); PG8_MMA(0, 1, At, B1); PG8_BAR; PG8_SCHED;
            PG8_LDA(At, 1, 1); PG8_STAGE(PG8_SB(1, 0), b3, voffB); PG8_STAGE(PG8_SB(1, 1), b3 + hstep, voffB); PG8_STAGE(PG8_SA(1, 0), a3, voffA);
            PG8_WAIT_V(8); PG8_WAIT_L(0); PG8_BAR; PG8_MMA(1, 0, At, B0); PG8_MMA(1, 1, At, B1); PG8_BAR; PG8_SCHED;
            } else {
            PG8_LDB(B0, 0, 0); PG8_SCHED; PG8_LDA(At, 0, 0); PG8_STAGE(PG8_SA(1, 1), a1 + hstep, voffA);
            PG8_WAIT_L(8); PG8_BAR; PG8_WAIT_L(0); PG8_MMA(0, 0, At, B0); PG8_BAR; PG8_SCHED;
            PG8_LDB(B1, 0, 1); PG8_STAGE(PG8_SB(0, 0), b2, voffB);
            PG8_BAR; PG8_WAIT_L(0); PG8_MMA(0, 1, At, B1); PG8_BAR;
            PG8_LDA(At, 0, 1); PG8_STAGE(PG8_SA(0, 0), a2, voffA);
            PG8_BAR; PG8_WAIT_L(0); PG8_MMA(1, 0, At, B0); PG8_BAR; PG8_SCHED;
            PG8_STAGE(PG8_SB(0, 1), b2 + hstep, voffB);
            PG8_WAIT_V(6); PG8_BAR; PG8_MMA(1, 1, At, B1); PG8_BAR;
            PG8_LDB(B0, 1, 0); PG8_SCHED; PG8_LDA(At, 1, 0); PG8_STAGE(PG8_SA(0, 1), a2 + hstep, voffA);
            PG8_WAIT_L(8); PG8_BAR; PG8_WAIT_L(0); PG8_MMA(0, 0, At, B0); PG8_BAR; PG8_SCHED;
            PG8_LDB(B1, 1, 1); PG8_STAGE(PG8_SB(1, 0), b3, voffB);
            PG8_BAR; PG8_WAIT_L(0); PG8_MMA(0, 1, At, B1); PG8_BAR;
            PG8_LDA(At, 1, 1); PG8_STAGE(PG8_SA(1, 0), a3, voffA);
            PG8_BAR; PG8_WAIT_L(0); PG8_MMA(1, 0, At, B0); PG8_BAR; PG8_SCHED;
            PG8_STAGE(PG8_SB(1, 1), b3 + hstep, voffB);
            PG8_WAIT_V(6); PG8_BAR; PG8_MMA(1, 1, At, B1); PG8_BAR;
            }
        }
        if constexpr (ALIGN_EPI) { if (wr == 0) PG8_BAR; }
        if constexpr (!Epi::AFTER_DRAIN) { E(acc, cur, wr, wc, fr, fq); S.done(cur); }
        if (!has_next) break;
        if (!E.keep(cur))
#pragma unroll
        for (int a = 0; a < 2; ++a)
#pragma unroll
            for (int b = 0; b < 2; ++b)
#pragma unroll
                for (int m = 0; m < 4; ++m)
#pragma unroll
                    for (int n = 0; n < 2; ++n) acc[a][b][m][n] = (f32x4){0.f, 0.f, 0.f, 0.f};
        cur = nxt; cA = nA; cB = nB; ++ui;
        if constexpr (ALIGN_EPI) { if (wr == 1) PG8_BAR; }
    }
    PG8_WAIT_V(0);
    if constexpr (!ALIGN_EPI) { if (wr == 0) PG8_BAR; }
    PG8_BAR;
    if constexpr (Epi::AFTER_DRAIN) { E.fused(acc, cur, wr, wc, fr, fq, lds, wid, lane); S.done(cur); }
#undef PG8_SA
#undef PG8_SB
#undef PG8_STAGE
#undef PG8_LDA
#undef PG8_LDB
#undef PG8_MMA
#undef PG8_WAIT_V
#undef PG8_WAIT_L
#undef PG8_BAR
#undef PG8_SCHED
}
}

#define LAS __attribute__((address_space(3)))
using pg8::bf16_t; using pg8::bf16x8; using pg8::f32x4; using pg8::u32x4; using pg8::cvt_pk_bf16;
typedef unsigned u32x2 __attribute__((ext_vector_type(2)));
typedef short s16x4 __attribute__((ext_vector_type(4)));

constexpr int NT = 512, NWAVES = 8;
constexpr int M_TOK = 16384, DM = 2048, SEQ = 4096, NCH = 32, CL_ = 128;
constexpr int NIN = 16416;
constexpr int NPROJ = 16384;
constexpr float EPS = 1e-5f;
constexpr int LDS_BYTES = 147456;
#ifndef WGM_P1
#define WGM_P1 4
#endif
#ifndef WGM_P5
#define WGM_P5 4
#endif
#ifndef WGM_P6
#define WGM_P6 4
#endif
#ifndef PH_MASK
#define PH_MASK 0xFF
#endif

constexpr size_t MiB = 1048576;
constexpr size_t WS_BAR = 3 * MiB + 65536;
constexpr size_t WS_WDT = 0, WS_WSB = 131072, WS_STATS = 393216, WS_SSQ = 524288, WS_CD = 589824, WS_DT = 1 * MiB;
constexpr size_t WS_WB = 4 * MiB, WS_WO = 20 * MiB, WS_YAB = 28 * MiB, WS_V = 156 * MiB, WS_XBC = 220 * MiB, WS_R = 348 * MiB, WS_GB = 412 * MiB, WS_CC = 476 * MiB, WS_END = 508 * MiB;

__device__ __forceinline__ float bf2f(unsigned short u) { return __uint_as_float(((unsigned)u) << 16); }
__device__ __forceinline__ float bflo(unsigned w) { return __uint_as_float(w << 16); }
__device__ __forceinline__ float bfhi(unsigned w) { return __uint_as_float(w & 0xffff0000u); }
__device__ __forceinline__ float silu_f(float v) { return v * __builtin_amdgcn_rcpf(1.0f + __expf(-v)); }
__device__ __forceinline__ float sigmoid_f(float v) { return __builtin_amdgcn_rcpf(1.0f + __expf(-v)); }
__device__ __forceinline__ float wave_sum(float v) {
#pragma unroll
    for (int o = 1; o < 64; o <<= 1) v += __shfl_xor(v, o);
    return v;
}
__device__ __forceinline__ void atomic_addf(float* p, float v) { __hip_atomic_fetch_add(p, v, __ATOMIC_RELAXED, __HIP_MEMORY_SCOPE_AGENT); }

template <int OFF> __device__ __forceinline__ bf16x8 tr_frag(unsigned a) {
    s16x4 lo, hi;
    asm volatile("ds_read_b64_tr_b16 %0, %2\n\tds_read_b64_tr_b16 %1, %2 offset:%3\n\ts_waitcnt lgkmcnt(0)" : "=&v"(lo), "=&v"(hi) : "v"(a), "n"(OFF) : "memory");
    return (bf16x8){lo[0], lo[1], lo[2], lo[3], hi[0], hi[1], hi[2], hi[3]};
}

template <int OFF, int STEP> __device__ __forceinline__ void tr_frag2(unsigned a, bf16x8& f0, bf16x8& f1) {
    s16x4 l0, h0, l1, h1;
    asm volatile("ds_read_b64_tr_b16 %0, %4\n\tds_read_b64_tr_b16 %1, %4 offset:%5\n\tds_read_b64_tr_b16 %2, %4 offset:%6\n\tds_read_b64_tr_b16 %3, %4 offset:%7\n\ts_waitcnt lgkmcnt(0)"
                 : "=&v"(l0), "=&v"(h0), "=&v"(l1), "=&v"(h1) : "v"(a), "n"(OFF), "n"(STEP), "n"(STEP + OFF) : "memory");
    f0 = (bf16x8){l0[0], l0[1], l0[2], l0[3], h0[0], h0[1], h0[2], h0[3]}; f1 = (bf16x8){l1[0], l1[1], l1[2], l1[3], h1[0], h1[1], h1[2], h1[3]};
}
template <int OFF, int STEP> __device__ __forceinline__ void tr_frag4(unsigned a, bf16x8& f0, bf16x8& f1, bf16x8& f2, bf16x8& f3) {
    s16x4 l0, h0, l1, h1, l2, h2, l3, h3;
    asm volatile("ds_read_b64_tr_b16 %0, %8\n\tds_read_b64_tr_b16 %1, %8 offset:%9\n\tds_read_b64_tr_b16 %2, %8 offset:%10\n\tds_read_b64_tr_b16 %3, %8 offset:%11\n\t"
                 "ds_read_b64_tr_b16 %4, %8 offset:%12\n\tds_read_b64_tr_b16 %5, %8 offset:%13\n\tds_read_b64_tr_b16 %6, %8 offset:%14\n\tds_read_b64_tr_b16 %7, %8 offset:%15\n\ts_waitcnt lgkmcnt(0)"
                 : "=&v"(l0), "=&v"(h0), "=&v"(l1), "=&v"(h1), "=&v"(l2), "=&v"(h2), "=&v"(l3), "=&v"(h3)
                 : "v"(a), "n"(OFF), "n"(STEP), "n"(STEP + OFF), "n"(2 * STEP), "n"(2 * STEP + OFF), "n"(3 * STEP), "n"(3 * STEP + OFF) : "memory");
    f0 = (bf16x8){l0[0], l0[1], l0[2], l0[3], h0[0], h0[1], h0[2], h0[3]}; f1 = (bf16x8){l1[0], l1[1], l1[2], l1[3], h1[0], h1[1], h1[2], h1[3]};
    f2 = (bf16x8){l2[0], l2[1], l2[2], l2[3], h2[0], h2[1], h2[2], h2[3]}; f3 = (bf16x8){l3[0], l3[1], l3[2], l3[3], h3[0], h3[1], h3[2], h3[3]};
}

struct Args {
    const float* x; const float* norm_w; const float* w_in; const float* b_gate; const float* ln_w; const float* ln_b; const float* w_sp; const float* b_sp;
    const float* conv_w; const float* conv_b; const float* dt_bias; const float* a_log; const float* d_skip; const float* ssm_nw; const float* w_branch; const float* w_out; const float* fnw;
    float* out; unsigned char* ws;
};

struct EpiProj {
    static constexpr bool PERM = true, AFTER_DRAIN = false;
    __device__ __forceinline__ bool keep(const pg8::Unit&) const { return false; }
    bf16_t* YAB; bf16_t* V; bf16_t* XBC; bf16_t* R; bf16_t* GB; float* stats; const float* b_gate;
    __device__ __forceinline__ void operator()(const f32x4 (&acc)[2][2][4][2], const pg8::Unit& u, int wr, int wc, int fr, int fq) const {
        const int row0 = u.pm * 256 + wr * 64 + fr, pn = u.pn, cl = wc * 32 + 8 * fq;
        if (pn < 16) {
#pragma unroll
            for (int ai = 0; ai < 2; ++ai)
#pragma unroll
                for (int m = 0; m < 4; ++m) {
                    const f32x4 u0 = acc[ai][0][m][0], u1 = acc[ai][0][m][1], z0 = acc[ai][1][m][0], z1 = acc[ai][1][m][1];
                    u32x4 w;
                    w.x = cvt_pk_bf16(silu_f(z0[0]) * u0[0], silu_f(z0[1]) * u0[1]); w.y = cvt_pk_bf16(silu_f(z0[2]) * u0[2], silu_f(z0[3]) * u0[3]);
                    w.z = cvt_pk_bf16(silu_f(z1[0]) * u1[0], silu_f(z1[1]) * u1[1]); w.w = cvt_pk_bf16(silu_f(z1[2]) * u1[2], silu_f(z1[3]) * u1[3]);
                    __builtin_nontemporal_store(w, (u32x4*)(YAB + (size_t)(row0 + ai * 128 + m * 16) * 4096 + pn * 128 + cl));
                }
        } else if (pn < 24) {
            const int c0 = (pn - 16) * 256 + cl;
#pragma unroll
            for (int ai = 0; ai < 2; ++ai)
#pragma unroll
                for (int m = 0; m < 4; ++m) {
                    const int row = row0 + ai * 128 + m * 16; float s = 0.f, q = 0.f;
#pragma unroll
                    for (int bj = 0; bj < 2; ++bj) {
                        const f32x4 v0 = acc[ai][bj][m][0], v1 = acc[ai][bj][m][1];
                        s += (v0[0] + v0[1]) + (v0[2] + v0[3]) + (v1[0] + v1[1]) + (v1[2] + v1[3]);
                        q += (v0[0] * v0[0] + v0[1] * v0[1]) + (v0[2] * v0[2] + v0[3] * v0[3]) + (v1[0] * v1[0] + v1[1] * v1[1]) + (v1[2] * v1[2] + v1[3] * v1[3]);
                        u32x4 w; w.x = cvt_pk_bf16(v0[0], v0[1]); w.y = cvt_pk_bf16(v0[2], v0[3]); w.z = cvt_pk_bf16(v1[0], v1[1]); w.w = cvt_pk_bf16(v1[2], v1[3]);
                        __builtin_nontemporal_store(w, (u32x4*)(V + (size_t)row * 2048 + c0 + bj * 128));
                    }
                    s += __shfl_xor(s, 16); s += __shfl_xor(s, 32); q += __shfl_xor(q, 16); q += __shfl_xor(q, 32);
                    if (fq == 0) { atomic_addf(stats + 2 * row, s); atomic_addf(stats + 2 * row + 1, q); }
                }
        } else if (pn < 32) {
            const int c0 = (pn - 24) * 256 + cl;
#pragma unroll
            for (int ai = 0; ai < 2; ++ai)
#pragma unroll
                for (int m = 0; m < 4; ++m)
#pragma unroll
                    for (int bj = 0; bj < 2; ++bj) {
                        const f32x4 v0 = acc[ai][bj][m][0], v1 = acc[ai][bj][m][1];
                        u32x4 w; w.x = cvt_pk_bf16(silu_f(v0[0]), silu_f(v0[1])); w.y = cvt_pk_bf16(silu_f(v0[2]), silu_f(v0[3])); w.z = cvt_pk_bf16(silu_f(v1[0]), silu_f(v1[1])); w.w = cvt_pk_bf16(silu_f(v1[2]), silu_f(v1[3]));
                        __builtin_nontemporal_store(w, (u32x4*)(YAB + (size_t)(row0 + ai * 128 + m * 16) * 4096 + 2048 + c0 + bj * 128));
                    }
        } else if (pn < 48) {
            const int c0 = (pn - 32) * 256 + cl;
#pragma unroll
            for (int ai = 0; ai < 2; ++ai)
#pragma unroll
                for (int m = 0; m < 4; ++m)
#pragma unroll
                    for (int bj = 0; bj < 2; ++bj) {
                        const f32x4 v0 = acc[ai][bj][m][0], v1 = acc[ai][bj][m][1];
                        u32x4 w; w.x = cvt_pk_bf16(v0[0], v0[1]); w.y = cvt_pk_bf16(v0[2], v0[3]); w.z = cvt_pk_bf16(v1[0], v1[1]); w.w = cvt_pk_bf16(v1[2], v1[3]);
                        __builtin_nontemporal_store(w, (u32x4*)(XBC + (size_t)(row0 + ai * 128 + m * 16) * 4096 + c0 + bj * 128));
                    }
        } else {
            const int c0 = (pn - 48) * 128 + cl;
            const f32x4 ba0 = *(const f32x4*)(b_gate + c0), ba1 = *(const f32x4*)(b_gate + c0 + 4), bb0 = *(const f32x4*)(b_gate + 2048 + c0), bb1 = *(const f32x4*)(b_gate + 2048 + c0 + 4);
#pragma unroll
            for (int ai = 0; ai < 2; ++ai)
#pragma unroll
                for (int m = 0; m < 4; ++m) {
                    f32x4 a0 = acc[ai][0][m][0] + ba0, a1 = acc[ai][0][m][1] + ba1, b0 = acc[ai][1][m][0] + bb0, b1 = acc[ai][1][m][1] + bb1;
#pragma unroll
                    for (int j = 0; j < 4; ++j) { a0[j] = fminf(fmaxf(a0[j], -30.f), 30.f); a1[j] = fminf(fmaxf(a1[j], -30.f), 30.f); b0[j] = fminf(fmaxf(b0[j], -30.f), 30.f); b1[j] = fminf(fmaxf(b1[j], -30.f), 30.f); }
                    float ea[8], eb[8], rr[8], gb[8];
#pragma unroll
                    for (int j = 0; j < 4; ++j) { ea[j] = 1.0f + __expf(-a0[j]); ea[4 + j] = 1.0f + __expf(-a1[j]); eb[j] = 1.0f + __expf(-b0[j]); eb[4 + j] = 1.0f + __expf(-b1[j]); }
#pragma unroll
                    for (int j = 0; j < 8; ++j) { rr[j] = eb[j] * __builtin_amdgcn_rcpf(ea[j]); gb[j] = 1.0f * __builtin_amdgcn_rcpf(eb[j]); }
                    u32x4 wr_, wg_;
                    wr_.x = cvt_pk_bf16(rr[0], rr[1]); wr_.y = cvt_pk_bf16(rr[2], rr[3]); wr_.z = cvt_pk_bf16(rr[4], rr[5]); wr_.w = cvt_pk_bf16(rr[6], rr[7]);
                    wg_.x = cvt_pk_bf16(gb[0], gb[1]); wg_.y = cvt_pk_bf16(gb[2], gb[3]); wg_.z = cvt_pk_bf16(gb[4], gb[5]); wg_.w = cvt_pk_bf16(gb[6], gb[7]);
                    const size_t o = ((((((size_t)u.pm * 8 + ((pn - 48) >> 1)) * 2 + ((pn - 48) & 1)) * 2 + ai) * 4 + m) * 8 + (wr * 4 + wc)) * 512 + (size_t)(fr + 16 * fq) * 8;
                    __builtin_nontemporal_store(wr_, (u32x4*)(R + o)); __builtin_nontemporal_store(wg_, (u32x4*)(GB + o));
                }
        }
    }
};
__device__ __forceinline__ void merge_store(const bf16_t* __restrict__ GB, bf16_t* __restrict__ merged, const f32x4 (&acc)[2][2][4][2], int row0, int col0, size_t gbase, int wl) {
#pragma unroll
    for (int ai = 0; ai < 2; ++ai) {
        u32x4 gv[4][2];
#pragma unroll
        for (int m = 0; m < 4; ++m)
#pragma unroll
            for (int bj = 0; bj < 2; ++bj) gv[m][bj] = __builtin_nontemporal_load((const u32x4*)(GB + ((((gbase * 2 + bj) * 2 + ai) * 4 + m) * 8) * 512 + wl));
#pragma unroll
        for (int m = 0; m < 4; ++m)
#pragma unroll
            for (int bj = 0; bj < 2; ++bj) { const u32x4 g = gv[m][bj]; const f32x4 v0 = acc[ai][bj][m][0], v1 = acc[ai][bj][m][1];
                u32x4 w; w.x = cvt_pk_bf16(v0[0] * bflo(g.x), v0[1] * bfhi(g.x)); w.y = cvt_pk_bf16(v0[2] * bflo(g.y), v0[3] * bfhi(g.y));
                w.z = cvt_pk_bf16(v1[0] * bflo(g.z), v1[1] * bfhi(g.z)); w.w = cvt_pk_bf16(v1[2] * bflo(g.w), v1[3] * bfhi(g.w));
                *(u32x4*)(merged + (size_t)(row0 + ai * 128 + m * 16) * 2048 + col0 + bj * 128) = w; }
    }
}
struct EpiMerge {
    static constexpr bool PERM = true, AFTER_DRAIN = false;
    const bf16_t* R; const bf16_t* GB; bf16_t* merged;
    __device__ __forceinline__ bool keep(const pg8::Unit& u) const { return u.kh == 0; }
    __device__ __forceinline__ void operator()(f32x4 (&acc)[2][2][4][2], const pg8::Unit& u, int wr, int wc, int fr, int fq) const {
        const int row0 = u.pm * 256 + wr * 64 + fr, col0 = u.pn * 256 + wc * 32 + 8 * fq;
        const size_t gbase = (size_t)u.pm * 8 + u.pn; const int wl = (wr * 4 + wc) * 512 + (fr + 16 * fq) * 8;
        if (u.kh == 0) {
#pragma unroll
            for (int ai = 0; ai < 2; ++ai) {
                u32x4 rv[4][2];
#pragma unroll
                for (int m = 0; m < 4; ++m)
#pragma unroll
                    for (int bj = 0; bj < 2; ++bj) rv[m][bj] = __builtin_nontemporal_load((const u32x4*)(R + ((((gbase * 2 + bj) * 2 + ai) * 4 + m) * 8) * 512 + wl));
#pragma unroll
                for (int m = 0; m < 4; ++m)
#pragma unroll
                    for (int bj = 0; bj < 2; ++bj) { const u32x4 g = rv[m][bj];
                        f32x4 v0 = acc[ai][bj][m][0], v1 = acc[ai][bj][m][1];
                        v0[0] *= bflo(g.x); v0[1] *= bfhi(g.x); v0[2] *= bflo(g.y); v0[3] *= bfhi(g.y); v1[0] *= bflo(g.z); v1[1] *= bfhi(g.z); v1[2] *= bflo(g.w); v1[3] *= bfhi(g.w);
                        acc[ai][bj][m][0] = v0; acc[ai][bj][m][1] = v1; }
            }
        } else merge_store(GB, merged, acc, row0, col0, gbase, wl);
    }
};
struct SplitKOrder : pg8::StaticOrder {
    __device__ bool next(int i, pg8::Unit& u) const { const bool ok = pg8::StaticOrder::next(i >> 1, u); u.kh = i & 1; return ok; }
};
__device__ __forceinline__ void out_store(const float* __restrict__ x, float* __restrict__ out, float* __restrict__ ssq, const f32x4 (&acc)[2][2][4][2], int row0, int col0, int fq) {
    f32x4 xv[2][4];
#pragma unroll
    for (int bj = 0; bj < 2; ++bj)
#pragma unroll
        for (int n = 0; n < 2; ++n) xv[0][bj * 2 + n] = *(const f32x4*)(x + (size_t)row0 * 2048 + col0 + bj * 128 + n * 16);
#pragma unroll
    for (int gi = 0; gi < 8; ++gi) {
        const int ai = gi >> 2, m = gi & 3;
        if (gi < 7) { const int ai2 = (gi + 1) >> 2, m2 = (gi + 1) & 3;
#pragma unroll
            for (int bj = 0; bj < 2; ++bj)
#pragma unroll
                for (int n = 0; n < 2; ++n) xv[(gi + 1) & 1][bj * 2 + n] = *(const f32x4*)(x + (size_t)(row0 + ai2 * 128 + m2 * 16) * 2048 + col0 + bj * 128 + n * 16); }
        const size_t row = (size_t)(row0 + ai * 128 + m * 16); float q = 0.f;
#pragma unroll
        for (int bj = 0; bj < 2; ++bj)
#pragma unroll
            for (int n = 0; n < 2; ++n) { const f32x4 r = xv[gi & 1][bj * 2 + n] + acc[ai][bj][m][n];
                q += (r[0] * r[0] + r[1] * r[1]) + (r[2] * r[2] + r[3] * r[3]);
                *(f32x4*)(out + row * 2048 + col0 + bj * 128 + n * 16) = r; }
        q += __shfl_xor(q, 16); q += __shfl_xor(q, 32);
        if (fq == 0) atomic_addf(ssq + row, q);
    }
}
struct EpiOut {
    static constexpr bool PERM = false, AFTER_DRAIN = false;
    __device__ __forceinline__ bool keep(const pg8::Unit&) const { return false; }
    const float* x; float* out; float* ssq;
    __device__ __forceinline__ void operator()(const f32x4 (&acc)[2][2][4][2], const pg8::Unit& u, int wr, int wc, int fr, int fq) const {
        out_store(x, out, ssq, acc, u.pm * 256 + wr * 64 + fr, u.pn * 256 + wc * 32 + 4 * fq, fq);
    }
};

struct EpiAcc {
    static constexpr bool PERM = true, AFTER_DRAIN = false;
    __device__ __forceinline__ bool keep(const pg8::Unit&) const { return false; }
    bf16_t* O;
    __device__ __forceinline__ void operator()(const f32x4 (&acc)[2][2][4][2], const pg8::Unit& u, int wr, int wc, int fr, int fq) const {
        const int row0 = u.pm * 256 + wr * 64 + fr, col0 = u.pn * 256 + wc * 32 + 8 * fq;
#pragma unroll
        for (int ai = 0; ai < 2; ++ai)
#pragma unroll
            for (int m = 0; m < 4; ++m)
#pragma unroll
                for (int bj = 0; bj < 2; ++bj) {
                    const f32x4 v0 = acc[ai][bj][m][0], v1 = acc[ai][bj][m][1];
                    u32x4 w; w.x = cvt_pk_bf16(v0[0], v0[1]); w.y = cvt_pk_bf16(v0[2], v0[3]); w.z = cvt_pk_bf16(v1[0], v1[1]); w.w = cvt_pk_bf16(v1[2], v1[3]);
                    __builtin_nontemporal_store(w, (u32x4*)(O + (size_t)(row0 + ai * 128 + m * 16) * 2048 + col0 + bj * 128));
                }
    }
};

__device__ __forceinline__ void transpose_item(const float* W, int ldw, int K, int k0, int n0, bf16_t* dst, LAS float* scr, int lane, int kd = -1) {
    if (kd < 0) kd = k0;
#pragma unroll 8
    for (int i = 0; i < 32; ++i) { const int kk = 2 * i + (lane >> 5); scr[kk * 33 + (lane & 31)] = W[(size_t)(k0 + kk) * ldw + n0 + (lane & 31)]; }
    asm volatile("s_waitcnt lgkmcnt(0)" ::: "memory");
    const int c = lane & 7;
#pragma unroll
    for (int j = 0; j < 4; ++j) { const int n = (lane >> 3) + 8 * j; const LAS float* s = scr + (8 * c) * 33 + n;
        u32x4 o; o.x = cvt_pk_bf16(s[0 * 33], s[1 * 33]); o.y = cvt_pk_bf16(s[2 * 33], s[3 * 33]); o.z = cvt_pk_bf16(s[4 * 33], s[5 * 33]); o.w = cvt_pk_bf16(s[6 * 33], s[7 * 33]);
        *(u32x4*)(dst + (size_t)n * K + kd + 8 * c) = o; }
    asm volatile("s_waitcnt lgkmcnt(0)" ::: "memory");
}
struct TItem { const float* src; bf16_t* dst; int ldw, ldd; };
__device__ __forceinline__ void titem_load(const TItem& t, f32x4 (&v)[16], int lane) {
    const int r4 = lane >> 4, c4 = lane & 15;
#pragma unroll
    for (int i = 0; i < 16; ++i) v[i] = __builtin_nontemporal_load((const f32x4*)(t.src + (size_t)(4 * i + r4) * t.ldw + 4 * c4));
}
__device__ __forceinline__ void titem_finish(const TItem& t, const f32x4 (&v)[16], LAS float* scr, int lane) {
    const int r4 = lane >> 4, c4 = lane & 15;
#pragma unroll
    for (int i = 0; i < 16; ++i) { LAS float* p = scr + (4 * i + r4) * 65 + 4 * c4; p[0] = v[i][0]; p[1] = v[i][1]; p[2] = v[i][2]; p[3] = v[i][3]; }
    asm volatile("s_waitcnt lgkmcnt(0)" ::: "memory");
    const int c = lane & 7;
#pragma unroll
    for (int i = 0; i < 8; ++i) { const int n = (lane >> 3) + 8 * i; const LAS float* s = scr + (8 * c) * 65 + n;
        u32x4 o; o.x = cvt_pk_bf16(s[0 * 65], s[1 * 65]); o.y = cvt_pk_bf16(s[2 * 65], s[3 * 65]); o.z = cvt_pk_bf16(s[4 * 65], s[5 * 65]); o.w = cvt_pk_bf16(s[6 * 65], s[7 * 65]);
        *(u32x4*)(t.dst + (size_t)n * t.ldd + 8 * c) = o; }
    asm volatile("s_waitcnt lgkmcnt(0)" ::: "memory");
}
__device__ __forceinline__ int proj_row(int n0) {
    if (n0 < 2048) return 256 * (n0 >> 7) + (n0 & 127);
    if (n0 < 4096) return 4096 + (n0 - 2048);
    if (n0 < 6144) { const int ch = n0 - 4096; return 256 * (ch >> 7) + 128 + (ch & 127); }
    if (n0 < 12288) return n0;
    if (n0 < 12320) return -1;
    { const int c = n0 - 12320, n = c >> 11, ch = c & 2047; return 12288 + 256 * (ch >> 7) + 128 * n + (ch & 127); }
}

template <int W> struct ConvRaw { static constexpr int CG = W / 8, RB = NT / CG, RPT = 128 / RB; u32x4 r[RPT + 3]; };
template <int W>
__device__ __forceinline__ void stage_conv_load(ConvRaw<W>& raw, const bf16_t* xbc, int tok0, int cidx, int col0, int tid) {
    constexpr int CG = ConvRaw<W>::CG, RPT = ConvRaw<W>::RPT;
    const int cgi = tid % CG, rb = tid / CG, r0 = rb * RPT;
    const bf16_t* src = xbc + (size_t)tok0 * 4096 + col0 + cgi * 8;
#pragma unroll
    for (int i = 0; i < RPT + 3; ++i) { const int r = r0 - 3 + i;
        if (cidx == 0 && r < 0) raw.r[i] = (u32x4){0u, 0u, 0u, 0u}; else raw.r[i] = *(const u32x4*)(src + (ptrdiff_t)r * 4096); }
}
template <int W>
__device__ __forceinline__ void stage_conv_finish(const ConvRaw<W>& raw, LAS unsigned char* dst, int stride, int col0, const float* conv_w, const float* conv_b, const LAS float* scale, int tid, bf16_t* gdst = nullptr, int gstride = 0) {
    constexpr int CG = ConvRaw<W>::CG, RPT = ConvRaw<W>::RPT;
    const int cgi = tid % CG, rb = tid / CG, r0 = rb * RPT, ch0 = col0 + cgi * 8;
    float w[4][8], bias[8], h0[8], h1[8], h2[8];
#pragma unroll
    for (int k = 0; k < 4; ++k) { const f32x4 a = *(const f32x4*)(conv_w + k * 4096 + ch0), b = *(const f32x4*)(conv_w + k * 4096 + ch0 + 4);
#pragma unroll
        for (int j = 0; j < 4; ++j) { w[k][j] = a[j]; w[k][4 + j] = b[j]; } }
    { const f32x4 a = *(const f32x4*)(conv_b + ch0), b = *(const f32x4*)(conv_b + ch0 + 4);
#pragma unroll
      for (int j = 0; j < 4; ++j) { bias[j] = a[j]; bias[4 + j] = b[j]; } }
#define UNPK(v_, o) do { o[0] = bflo(v_.x); o[1] = bfhi(v_.x); o[2] = bflo(v_.y); o[3] = bfhi(v_.y); o[4] = bflo(v_.z); o[5] = bfhi(v_.z); o[6] = bflo(v_.w); o[7] = bfhi(v_.w); } while (0)
    UNPK(raw.r[0], h0); UNPK(raw.r[1], h1); UNPK(raw.r[2], h2);
#pragma unroll
    for (int i = 0; i < RPT; ++i) {
        float cur[8], o[8]; UNPK(raw.r[3 + i], cur);
        float sc = 1.0f; if (scale) sc = scale[(cgi >> 3) * 128 + r0 + i];
#pragma unroll
        for (int j = 0; j < 8; ++j) { float v = bias[j] + w[0][j] * h0[j] + w[1][j] * h1[j] + w[2][j] * h2[j] + w[3][j] * cur[j]; o[j] = silu_f(v) * sc; h0[j] = h1[j]; h1[j] = h2[j]; h2[j] = cur[j]; }
        u32x4 pk; pk.x = cvt_pk_bf16(o[0], o[1]); pk.y = cvt_pk_bf16(o[2], o[3]); pk.z = cvt_pk_bf16(o[4], o[5]); pk.w = cvt_pk_bf16(o[6], o[7]);
        { LAS unsigned char* q_ = dst + (r0 + i) * stride + (32 * (cgi >> 2) + 4 * (cgi & 3)) * 2;
          *(LAS u32x2*)q_ = (u32x2){pk.x, pk.y}; *(LAS u32x2*)(q_ + 32) = (u32x2){pk.z, pk.w}; }
        if (gdst) *(u32x4*)(gdst + (size_t)(r0 + i) * gstride + cgi * 8) = pk;
    }
#undef UNPK
}
__device__ __forceinline__ float chunk_prefix(LAS float* adt, LAS float* ac, const float* DT, const float* a_log, int tok0, int g, int tid) {
    const int k = tid >> 7, l = tid & 127, h = g * 4 + k, lane = tid & 63;
    const float dtv = DT[(size_t)h * M_TOK + tok0 + l];
    const float a = -expf(a_log[h]);
    float s = dtv * a;
#pragma unroll
    for (int o = 1; o < 64; o <<= 1) { const float t = __shfl_up(s, o); if (lane >= o) s += t; }
    if (lane == 63) adt[tid >> 6] = s;
    __syncthreads();
    if (l >= 64) s += adt[(tid >> 6) - 1];
    ac[k * 128 + l] = s;
    __syncthreads();
    return dtv;
}

constexpr int XS_STRIDE = 528, CB_STRIDE = 272;

__device__ __forceinline__ void own_barrier(unsigned* bar, unsigned target) {
    if (threadIdx.x == 0) {
        __hip_atomic_fetch_add(bar, 1u, __ATOMIC_RELAXED, __HIP_MEMORY_SCOPE_AGENT);
        const unsigned long long t0 = __builtin_amdgcn_s_memrealtime();
        while (__hip_atomic_load(bar, __ATOMIC_RELAXED, __HIP_MEMORY_SCOPE_AGENT) < target) {
            __builtin_amdgcn_s_sleep(2);
            if (__builtin_amdgcn_s_memrealtime() - t0 > 200000000ull) break;
        }
    }
    __syncthreads();
}
#define GRID_SYNC(i) do { asm volatile("s_waitcnt vmcnt(0) lgkmcnt(0)" ::: "memory"); grid.sync(); \
    __builtin_amdgcn_fence(__ATOMIC_ACQUIRE, "agent"); asm volatile("s_waitcnt vmcnt(0)" ::: "memory"); __syncthreads(); STAMP(i); } while (0)
#ifdef SPIN_PHASE
#define STAMP(i) do { if (bx == 0 && tid == 0) { ((unsigned long long*)(BAR + 16))[i] = __builtin_amdgcn_s_memrealtime(); } } while (0)
#else
#define STAMP(i) do { } while (0)
#endif
#ifdef SPIN_SUB
#define SUBSTAMP(i) do { if (bx == 0 && tid == 0 && j == 0) ((unsigned long long*)(BAR + 16))[16 + (i)] = __builtin_amdgcn_s_memrealtime(); } while (0)
#else
#define SUBSTAMP(i) do { } while (0)
#endif
__global__ void __launch_bounds__(NT, 2) fwd_megakernel(Args A) {
    extern __shared__ __attribute__((aligned(16))) unsigned char lds_raw[];
    LAS unsigned char* lds = (LAS unsigned char*)lds_raw;
    const unsigned lds_u32 = (unsigned)(size_t)lds_raw;
    cg::grid_group grid = cg::this_grid();
    const int tid = threadIdx.x, lane = tid & 63, wave = __builtin_amdgcn_readfirstlane(tid >> 6), fr = lane & 15, fq = lane >> 4;
    const int G = gridDim.x, bx = blockIdx.x;
    const int gw = bx * NWAVES + wave, NGW = G * NWAVES;
    unsigned char* ws = A.ws;
    bf16_t* WinT = (bf16_t*)A.out; bf16_t* H = (bf16_t*)((unsigned char*)A.out + 64 * MiB);
    bf16_t* STATES = (bf16_t*)A.out;
    bf16_t* WdtT = (bf16_t*)(ws + WS_WDT); bf16_t* WsB = (bf16_t*)(ws + WS_WSB); float* STATS = (float*)(ws + WS_STATS); float* SSQ = (float*)(ws + WS_SSQ);
    float* CD = (float*)(ws + WS_CD); float* DT = (float*)(ws + WS_DT); unsigned* BAR = (unsigned*)(ws + WS_BAR); unsigned bar_epoch = 0;
    bf16_t* WbT = (bf16_t*)(ws + WS_WB); bf16_t* WoT = (bf16_t*)(ws + WS_WO); bf16_t* YAB = (bf16_t*)(ws + WS_YAB); bf16_t* V = (bf16_t*)(ws + WS_V);
    bf16_t* PREV = (bf16_t*)(ws + WS_V); bf16_t* MERGED = (bf16_t*)(ws + WS_V);
    bf16_t* CC = (bf16_t*)(ws + WS_CC); bf16_t* YD = (bf16_t*)((unsigned char*)A.out + 64 * MiB);
    bf16_t* XBC = (bf16_t*)(ws + WS_XBC); bf16_t* RG = (bf16_t*)(ws + WS_R); bf16_t* GB = (bf16_t*)(ws + WS_GB);

    STAMP(0);
    if constexpr ((PH_MASK >> 0) & 1)
    {
        LAS float* scr = (LAS float*)(lds + wave * 16640);
        constexpr int I_IN = 32 * 256, I_B = 32 * 32, I_O = 32 * 32, NITEMS = I_IN + 2 * I_B + I_O;
        auto item_of = [&](int it) -> TItem {
            TItem t; int r = it;
            if (r < I_IN) { const int kb = r >> 8, nb = r & 255, n0 = nb < 192 ? 64 * nb : 12320 + 64 * (nb - 192);
                t.src = A.w_in + (size_t)(64 * kb) * NIN + n0; t.ldw = NIN; t.dst = WinT + (size_t)proj_row(n0) * 2048 + 64 * kb; t.ldd = 2048; return t; }
            r -= I_IN;
            if (r < 2 * I_B) { const int nbr = r / I_B, rr = r % I_B, kb = rr >> 5, nb = rr & 31;
                t.src = A.w_branch + (size_t)nbr * 2048 * 2048 + (size_t)(64 * kb) * 2048 + 64 * nb; t.ldw = 2048; t.dst = WbT + (size_t)(64 * nb) * 4096 + nbr * 2048 + 64 * kb; t.ldd = 4096; return t; }
            r -= 2 * I_B;
            { const int kb = r >> 5, nb = r & 31; t.src = A.w_out + (size_t)(64 * kb) * 2048 + 64 * nb; t.ldw = 2048; t.dst = WoT + (size_t)(64 * nb) * 2048 + 64 * kb; t.ldd = 2048; return t; }
        };
        {
            f32x4 va[16], vb[16]; int it = gw; TItem ta, tb;
            if (it < NITEMS) { ta = item_of(it); titem_load(ta, va, lane); }
            while (it < NITEMS) {
                const int it2 = it + NGW, it3 = it2 + NGW;
                if (it2 < NITEMS) { tb = item_of(it2); titem_load(tb, vb, lane); }
                titem_finish(ta, va, scr, lane);
                if (it3 < NITEMS) { ta = item_of(it3); titem_load(ta, va, lane); }
                if (it2 < NITEMS) titem_finish(tb, vb, scr, lane);
                it = it3;
            }
        }
        for (int r = gw; r < 32; r += NGW) transpose_item(A.w_in, NIN, 2048, 64 * r, 12288, WdtT, scr, lane);
        for (int i = bx * NT + tid; i < 8 * 128 * 128; i += G * NT) { const int t = (i >> 7) & 127, s = i & 127; const float v = (s <= t) ? A.w_sp[i] : 0.f; WsB[i] = (bf16_t)(cvt_pk_bf16(v, 0.f) & 0xffffu); }
        for (int i = bx * NT + tid; i < 2 * M_TOK; i += G * NT) STATS[i] = 0.f;
        for (int i = bx * NT + tid; i < M_TOK; i += G * NT) SSQ[i] = 0.f;
        for (int m = gw; m < M_TOK; m += 2 * NGW) {
            const int m2 = m + NGW;
            const f32x4* xr = (const f32x4*)(A.x + (size_t)m * DM) + lane; const f32x4* xr2 = (const f32x4*)(A.x + (size_t)m2 * DM) + lane; const f32x4* wr4 = (const f32x4*)A.norm_w + lane;
            f32x4 v[8], v2[8]; float s = 0.f, s2 = 0.f;
#pragma unroll
            for (int j = 0; j < 8; ++j) { v[j] = __builtin_nontemporal_load(xr + 64 * j); v2[j] = __builtin_nontemporal_load(xr2 + 64 * j); }
#pragma unroll
            for (int j = 0; j < 8; ++j) { s += (v[j][0] * v[j][0] + v[j][1] * v[j][1]) + (v[j][2] * v[j][2] + v[j][3] * v[j][3]); s2 += (v2[j][0] * v2[j][0] + v2[j][1] * v2[j][1]) + (v2[j][2] * v2[j][2] + v2[j][3] * v2[j][3]); }
            const float rstd = 1.0f / sqrtf(wave_sum(s) * (1.0f / DM) + EPS), rstd2 = 1.0f / sqrtf(wave_sum(s2) * (1.0f / DM) + EPS);
            u32x2* o8 = (u32x2*)(H + (size_t)m * DM) + lane; u32x2* o82 = (u32x2*)(H + (size_t)m2 * DM) + lane;
#pragma unroll
            for (int j = 0; j < 8; ++j) { const f32x4 w4 = wr4[64 * j];
                u32x2 o; o.x = cvt_pk_bf16(v[j][0] * rstd * w4[0], v[j][1] * rstd * w4[1]); o.y = cvt_pk_bf16(v[j][2] * rstd * w4[2], v[j][3] * rstd * w4[3]); o8[64 * j] = o;
                u32x2 o2; o2.x = cvt_pk_bf16(v2[j][0] * rstd2 * w4[0], v2[j][1] * rstd2 * w4[1]); o2.y = cvt_pk_bf16(v2[j][2] * rstd2 * w4[2], v2[j][3] * rstd2 * w4[3]); o82[64 * j] = o2; }
        }
    }
    GRID_SYNC(1);

    if constexpr ((PH_MASK >> 1) & 1)
    {
        pg8::Gemm g{H, WinT, M_TOK, NPROJ, DM, DM}; pg8::StaticOrder S; S.init(M_TOK, NPROJ, G, bx, WGM_P1);
        EpiProj E{YAB, V, XBC, RG, GB, STATS, A.b_gate};
        pg8::gemm_phase<EpiProj, pg8::StaticOrder, true, true>(lds, g, S, E);
        {
            constexpr int WROW = 4112;
#pragma unroll
            for (int i = 0; i < 16; ++i) { const int row = 2 * i + (tid >> 8), ch = tid & 255;
                *(LAS u32x4*)(lds + row * WROW + ch * 16) = *(const u32x4*)(WdtT + (size_t)row * DM + ch * 8); }
            __syncthreads();
            for (int t0 = bx * 4; t0 < M_TOK / 16; t0 += G * 4) {
                const int t = t0 + (wave >> 1), kh = wave & 1;
                f32x4 acc0 = {0.f, 0.f, 0.f, 0.f}, acc1 = {0.f, 0.f, 0.f, 0.f};
                const bf16_t* ap = H + (size_t)(16 * t + fr) * DM + 8 * fq + kh * 1024;
                const LAS unsigned char* bp = lds + fr * WROW + (8 * fq + kh * 1024) * 2;
#pragma unroll 16
                for (int ks = 0; ks < 32; ++ks) {
                    const bf16x8 fa = *(const bf16x8*)(ap + 32 * ks), fb0 = *(const LAS bf16x8*)(bp + 64 * ks), fb1 = *(const LAS bf16x8*)(bp + 16 * WROW + 64 * ks);
                    acc0 = __builtin_amdgcn_mfma_f32_16x16x32_bf16(fb0, fa, acc0, 0, 0, 0);
                    acc1 = __builtin_amdgcn_mfma_f32_16x16x32_bf16(fb1, fa, acc1, 0, 0, 0);
                }
                LAS f32x4* xch = (LAS f32x4*)(lds + 32 * WROW) + (wave >> 1) * 128 + lane * 2;
                if (kh) { xch[0] = acc0; xch[1] = acc1; }
                __syncthreads();
                if (!kh) {
                    acc0 += xch[0]; acc1 += xch[1];
                    const f32x4 bb0 = *(const f32x4*)(A.dt_bias + 4 * fq), bb1 = *(const f32x4*)(A.dt_bias + 16 + 4 * fq);
                    f32x4 o0, o1;
#pragma unroll
                    for (int j = 0; j < 4; ++j) { const float v0 = acc0[j] + bb0[j], v1 = acc1[j] + bb1[j];
                        o0[j] = fmaxf(v0, 0.f) + log1pf(expf(-fabsf(v0))); o1[j] = fmaxf(v1, 0.f) + log1pf(expf(-fabsf(v1))); }
                    float* dp = DT + (size_t)(4 * fq) * M_TOK + 16 * t + fr;
#pragma unroll
                    for (int j = 0; j < 4; ++j) { dp[(size_t)j * M_TOK] = o0[j]; dp[(size_t)(16 + j) * M_TOK] = o1[j]; }
                }
                __syncthreads();
            }
        }
    }
    GRID_SYNC(2);

    if constexpr ((PH_MASK >> 2) & 1)
    for (int j = bx; j < 2048; j += G) {
        const int jj = j & 1023, g = jj & 7, bc = jj >> 3, tok0 = bc * 128, cidx = bc & 31;
        int tid = threadIdx.x; asm volatile("" : "+v"(tid));
        const int lane = tid & 63, fr = lane & 15, fq = lane >> 4;
        if (j < 1024) {
            {
                const bf16_t* wsrc = WsB + (size_t)g * 16384;
                u32x4 wv[4];
#pragma unroll
                for (int i = 0; i < 4; ++i) wv[i] = *(const u32x4*)(wsrc + (size_t)(i * 32 + (tid >> 4)) * 128 + (tid & 15) * 8);
#pragma unroll
                for (int i = 0; i < 4; ++i) *(LAS u32x4*)(lds + 67584 + (i * 32 + (tid >> 4)) * CB_STRIDE + (tid & 15) * 16) = wv[i];
            }
            bf16_t* p0 = YAB + (size_t)(tok0 + fr) * 4096 + g * 256 + 32 * wave + 8 * fq;
            u32x4 sv[8]; float bs[8];
#pragma unroll
            for (int mt = 0; mt < 8; ++mt) { bs[mt] = A.b_sp[g * 128 + 16 * mt + fr]; sv[mt] = *(const u32x4*)(p0 + (size_t)(16 * mt) * 4096); }
            {
                const int cgi = tid & 31, rb = tid >> 5, d0 = g * 256 + cgi * 8;
                const f32x4 lw0 = *(const f32x4*)(A.ln_w + d0), lw1 = *(const f32x4*)(A.ln_w + d0 + 4), lb0 = *(const f32x4*)(A.ln_b + d0), lb1 = *(const f32x4*)(A.ln_b + d0 + 4);
#pragma unroll
                for (int i = 0; i < 8; ++i) {
                    const int r = rb * 8 + i, tok = tok0 + r;
                    const float2 st2 = *(const float2*)(STATS + 2 * tok); const float mean = st2.x * (1.0f / 2048.0f), var = st2.y * (1.0f / 2048.0f) - mean * mean, rstd = 1.0f / sqrtf(fmaxf(var, 0.f) + EPS);
                    const u32x4 v = *(const u32x4*)(V + (size_t)tok * 2048 + d0);
                    u32x4 pk;
                    pk.x = cvt_pk_bf16((bflo(v.x) - mean) * rstd * lw0[0] + lb0[0], (bfhi(v.x) - mean) * rstd * lw0[1] + lb0[1]);
                    pk.y = cvt_pk_bf16((bflo(v.y) - mean) * rstd * lw0[2] + lb0[2], (bfhi(v.y) - mean) * rstd * lw0[3] + lb0[3]);
                    pk.z = cvt_pk_bf16((bflo(v.z) - mean) * rstd * lw1[0] + lb1[0], (bfhi(v.z) - mean) * rstd * lw1[1] + lb1[1]);
                    pk.w = cvt_pk_bf16((bflo(v.w) - mean) * rstd * lw1[2] + lb1[2], (bfhi(v.w) - mean) * rstd * lw1[3] + lb1[3]);
                    { LAS unsigned char* q_ = lds + r * XS_STRIDE + (32 * (cgi >> 2) + 4 * (cgi & 3)) * 2; *(LAS u32x2*)q_ = (u32x2){pk.x, pk.y}; *(LAS u32x2*)(q_ + 32) = (u32x2){pk.z, pk.w}; }
                }
            }
            __syncthreads();
            f32x4 acc[8][2];
#pragma unroll
            for (int mt = 0; mt < 8; ++mt) { acc[mt][0] = (f32x4){0.f, 0.f, 0.f, 0.f}; acc[mt][1] = (f32x4){0.f, 0.f, 0.f, 0.f}; }
            const unsigned tra = lds_u32 + (8 * fq + (fr >> 2)) * XS_STRIDE + (32 * wave + 4 * (lane & 3)) * 2;
#pragma unroll
            for (int ks = 0; ks < 4; ++ks) {
                bf16x8 fn0, fn1; tr_frag2<4 * XS_STRIDE, 32>(tra + 32 * ks * XS_STRIDE, fn0, fn1);
#pragma unroll
                for (int mt = 2 * ks; mt < 8; ++mt) {
                    const bf16x8 fm = *(const LAS bf16x8*)(lds + 67584 + (16 * mt + fr) * CB_STRIDE + (32 * ks + 8 * fq) * 2);
                    acc[mt][0] = __builtin_amdgcn_mfma_f32_16x16x32_bf16(fn0, fm, acc[mt][0], 0, 0, 0);
                    acc[mt][1] = __builtin_amdgcn_mfma_f32_16x16x32_bf16(fn1, fm, acc[mt][1], 0, 0, 0);
                }
            }
            {
#pragma unroll
                for (int mt = 0; mt < 8; ++mt) { const f32x4 a0 = acc[mt][0], a1 = acc[mt][1]; const u32x4 s4 = sv[mt]; const float b = bs[mt];
                    u32x4 o; o.x = cvt_pk_bf16(bflo(s4.x) * (a0[0] + b), bfhi(s4.x) * (a0[1] + b)); o.y = cvt_pk_bf16(bflo(s4.y) * (a0[2] + b), bfhi(s4.y) * (a0[3] + b));
                    o.z = cvt_pk_bf16(bflo(s4.z) * (a1[0] + b), bfhi(s4.z) * (a1[1] + b)); o.w = cvt_pk_bf16(bflo(s4.w) * (a1[2] + b), bfhi(s4.w) * (a1[3] + b));
                    *(u32x4*)(p0 + (size_t)(16 * mt) * 4096) = o; }
            }
            __syncthreads();
        } else {
            LAS float* ac = (LAS float*)(lds + 137216); LAS float* dtl = ac + 512; LAS float* adt = dtl + 512; LAS float* wg = adt + 512;
            ConvRaw<128> rc, rbb; ConvRaw<256> rx;
            stage_conv_load<128>(rc, XBC, tok0, cidx, 3072 + g * 128, tid); stage_conv_load<128>(rbb, XBC, tok0, cidx, 2048 + g * 128, tid); stage_conv_load<256>(rx, XBC, tok0, cidx, g * 256, tid);
            { const float dtv = chunk_prefix(adt, ac, DT, A.a_log, tok0, g, tid); dtl[tid] = dtv;
              const int k = tid >> 7, l_ = tid & 127; const float aend = ac[k * 128 + 127]; wg[tid] = expf(aend - ac[tid]) * dtv; if (l_ == 127) CD[bc * 32 + g * 4 + k] = expf(aend); }
            stage_conv_finish<128>(rc, lds, CB_STRIDE, 3072 + g * 128, A.conv_w, A.conv_b, nullptr, tid, CC + (size_t)tok0 * 1024 + g * 128, 1024);
            stage_conv_finish<128>(rbb, lds + 34816, CB_STRIDE, 2048 + g * 128, A.conv_w, A.conv_b, nullptr, tid);
            stage_conv_finish<256>(rx, lds + 69632, XS_STRIDE, g * 256, A.conv_w, A.conv_b, nullptr, tid);
            __syncthreads();
            const int l = 16 * wave + fr;
            f32x4 cb[8];
            {
                bf16x8 fc[4];
#pragma unroll
                for (int ks = 0; ks < 4; ++ks) fc[ks] = *(const LAS bf16x8*)(lds + l * CB_STRIDE + (32 * ks + 8 * fq) * 2);
#pragma unroll
                for (int nt = 0; nt < 8; ++nt) {
                    cb[nt] = (f32x4){0.f, 0.f, 0.f, 0.f};
                    if (nt <= wave) {
#pragma unroll
                        for (int ks = 0; ks < 4; ++ks) { const bf16x8 fb = *(const LAS bf16x8*)(lds + 34816 + (16 * nt + fr) * CB_STRIDE + (32 * ks + 8 * fq) * 2);
                            cb[nt] = __builtin_amdgcn_mfma_f32_16x16x32_bf16(fb, fc[ks], cb[nt], 0, 0, 0); }
                    }
                }
            }
            {
                const int k = wave >> 1, ph = wave & 1;
                f32x4 acc[2][8];
#pragma unroll
                for (int mt = 0; mt < 2; ++mt)
#pragma unroll
                    for (int nt = 0; nt < 8; ++nt) acc[mt][nt] = (f32x4){0.f, 0.f, 0.f, 0.f};
                const unsigned xa = lds_u32 + 69632 + (8 * fq + (fr >> 2)) * XS_STRIDE + (k * 64 + 32 * ph + 4 * (lane & 3)) * 2;
                const unsigned ba = lds_u32 + 34816 + (8 * fq + (fr >> 2)) * CB_STRIDE + (4 * (lane & 3)) * 2;
#pragma unroll
                for (int ks = 0; ks < 4; ++ks) {
                    bf16x8 fm0, fm1; tr_frag2<4 * XS_STRIDE, 32>(xa + 32 * ks * XS_STRIDE, fm0, fm1);
                    const f32x4 w0 = *(const LAS f32x4*)(wg + k * 128 + 32 * ks + 8 * fq), w1 = *(const LAS f32x4*)(wg + k * 128 + 32 * ks + 8 * fq + 4);
                    const float wv[8] = {w0[0], w0[1], w0[2], w0[3], w1[0], w1[1], w1[2], w1[3]};
                    bf16x8 sm0, sm1;
#pragma unroll
                    for (int e = 0; e < 8; e += 2) {
                        const unsigned a0 = cvt_pk_bf16(bf2f((unsigned short)fm0[e]) * wv[e], bf2f((unsigned short)fm0[e + 1]) * wv[e + 1]);
                        const unsigned a1 = cvt_pk_bf16(bf2f((unsigned short)fm1[e]) * wv[e], bf2f((unsigned short)fm1[e + 1]) * wv[e + 1]);
                        sm0[e] = (short)(a0 & 0xffffu); sm0[e + 1] = (short)(a0 >> 16); sm1[e] = (short)(a1 & 0xffffu); sm1[e + 1] = (short)(a1 >> 16);
                    }
#pragma unroll
                    for (int nq = 0; nq < 2; ++nq) {
                        bf16x8 fn[4]; tr_frag4<4 * CB_STRIDE, 32>(ba + 32 * ks * CB_STRIDE + 128 * nq, fn[0], fn[1], fn[2], fn[3]);
#pragma unroll
                        for (int i = 0; i < 4; ++i) {
                            acc[0][4 * nq + i] = __builtin_amdgcn_mfma_f32_16x16x32_bf16(fn[i], sm0, acc[0][4 * nq + i], 0, 0, 0);
                            acc[1][4 * nq + i] = __builtin_amdgcn_mfma_f32_16x16x32_bf16(fn[i], sm1, acc[1][4 * nq + i], 0, 0, 0);
                        }
                    }
                }
                bf16_t* sp = STATES + ((size_t)(bc * 8 + g) * 4096 + (size_t)wave * 512 + lane) * 8;
#pragma unroll
                for (int mt = 0; mt < 2; ++mt)
#pragma unroll
                    for (int q = 0; q < 4; ++q) { const f32x4 a0 = acc[mt][2 * q], a1 = acc[mt][2 * q + 1];
                        u32x4 o; o.x = cvt_pk_bf16(a0[0], a0[1]); o.y = cvt_pk_bf16(a0[2], a0[3]); o.z = cvt_pk_bf16(a1[0], a1[1]); o.w = cvt_pk_bf16(a1[2], a1[3]);
                        *(u32x4*)(sp + (size_t)((mt * 4 + q) * 64) * 8) = o; }
            }
            __syncthreads();
            LAS unsigned char* sw = lds + 34816 + wave * (16 * CB_STRIDE);
            bf16_t* ydp = YD + ((size_t)(jj * 8 + wave) * 8 * 64 + lane) * 8;
#pragma unroll
            for (int k = 0; k < 4; ++k) {
                const int h = g * 4 + k; const float al = ac[k * 128 + l], dsk = A.d_skip[h];
#pragma unroll
                for (int nt = 0; nt < 8; ++nt) {
                    float sv[4];
#pragma unroll
                    for (int r = 0; r < 4; ++r) { const int s = 16 * nt + 4 * fq + r;
                        float v = (s <= l) ? cb[nt][r] * __expf(al - ac[k * 128 + s]) * dtl[k * 128 + s] : 0.f;
                        if (s == l) v += dsk; sv[r] = v; }
                    u32x2 o; o.x = cvt_pk_bf16(sv[0], sv[1]); o.y = cvt_pk_bf16(sv[2], sv[3]);
                    *(LAS u32x2*)(sw + fr * CB_STRIDE + (16 * nt + 4 * fq) * 2) = o;
                    if (nt & 1) asm volatile("" ::: "memory");
                }
                asm volatile("s_waitcnt lgkmcnt(0)" ::: "memory");
                f32x4 ay[4];
#pragma unroll
                for (int pt = 0; pt < 4; ++pt) ay[pt] = (f32x4){0.f, 0.f, 0.f, 0.f};
                const unsigned xa = lds_u32 + 69632 + (8 * fq + (fr >> 2)) * XS_STRIDE + (k * 64 + 4 * (lane & 3)) * 2;
#pragma unroll
                for (int ks = 0; ks < 4; ++ks) {
                    if (ks <= (wave >> 1)) {
                        const bf16x8 fs = *(const LAS bf16x8*)(sw + fr * CB_STRIDE + (32 * ks + 8 * fq) * 2);
                        bf16x8 fx[4]; tr_frag4<4 * XS_STRIDE, 32>(xa + 32 * ks * XS_STRIDE, fx[0], fx[1], fx[2], fx[3]);
#pragma unroll
                        for (int pt = 0; pt < 4; ++pt) ay[pt] = __builtin_amdgcn_mfma_f32_16x16x32_bf16(fx[pt], fs, ay[pt], 0, 0, 0);
                    }
                }
#pragma unroll
                for (int q = 0; q < 2; ++q) { u32x4 o; o.x = cvt_pk_bf16(ay[2 * q][0], ay[2 * q][1]); o.y = cvt_pk_bf16(ay[2 * q][2], ay[2 * q][3]); o.z = cvt_pk_bf16(ay[2 * q + 1][0], ay[2 * q + 1][1]); o.w = cvt_pk_bf16(ay[2 * q + 1][2], ay[2 * q + 1][3]); *(u32x4*)(ydp + (size_t)(k * 2 + q) * 512) = o; }
                __builtin_amdgcn_sched_barrier(0);
                asm volatile("s_waitcnt lgkmcnt(0)" ::: "memory");
            }
            __syncthreads();
        }
    }
    GRID_SYNC(3);

    if constexpr ((PH_MASK >> 3) & 1)
    for (int blk = bx; blk < 256; blk += G) {
        const int b = blk >> 6; const unsigned o8 = (unsigned)(blk & 63) * 512u + (unsigned)tid; const int h = (int)(o8 >> 10);
        const bf16_t* sbase = STATES + (size_t)(b * 32) * 262144; bf16_t* pbase = PREV + (size_t)(b * 32) * 262144;
        const unsigned voff = o8 * 8u;
        f32x4 h0 = {0.f, 0.f, 0.f, 0.f}, h1 = {0.f, 0.f, 0.f, 0.f};
#pragma unroll 1
        for (int cb0 = 0; cb0 < 32; cb0 += 16) {
            const bf16_t* sb = sbase + (size_t)cb0 * 262144; bf16_t* pb = pbase + (size_t)cb0 * 262144;
            u32x4 sv[16]; float cdv[16];
#pragma unroll
            for (int c = 0; c < 16; ++c) { sv[c] = *(const u32x4*)(sb + (size_t)c * 262144 + voff); cdv[c] = CD[(b * 32 + cb0 + c) * 32 + h]; }
#pragma unroll
            for (int c = 0; c < 16; ++c) {
                u32x4 o; o.x = cvt_pk_bf16(h0[0], h0[1]); o.y = cvt_pk_bf16(h0[2], h0[3]); o.z = cvt_pk_bf16(h1[0], h1[1]); o.w = cvt_pk_bf16(h1[2], h1[3]);
                *(u32x4*)(pb + (size_t)c * 262144 + voff) = o;
                const f32x4 s0 = {bflo(sv[c].x), bfhi(sv[c].x), bflo(sv[c].y), bfhi(sv[c].y)}, s1 = {bflo(sv[c].z), bfhi(sv[c].z), bflo(sv[c].w), bfhi(sv[c].w)};
                h0 = h0 * cdv[c] + s0; h1 = h1 * cdv[c] + s1;
            }
        }
    }
    GRID_SYNC(4);

    if constexpr ((PH_MASK >> 4) & 1)
    for (int j = bx; j < 1024; j += G) {
        const int g = j & 7, bc = j >> 3, tok0 = bc * 128;
        int tid = threadIdx.x; asm volatile("" : "+v"(tid));
        const int lane = tid & 63, fr = lane & 15, fq = lane >> 4;
        LAS float* ac = (LAS float*)lds; LAS float* adt = ac + 512;
        const int l = 16 * wave + fr;
        bf16x8 fc[4];
#pragma unroll
        for (int ks = 0; ks < 4; ++ks) fc[ks] = *(const bf16x8*)(CC + (size_t)(tok0 + l) * 1024 + g * 128 + 32 * ks + 8 * fq);
        {
            const bf16_t* pg = PREV + (size_t)(bc * 8 + g) * 4096 * 8;
            u32x4 pv[8];
#pragma unroll
            for (int i = 0; i < 8; ++i) pv[i] = *(const u32x4*)(pg + ((size_t)i * 512 + tid) * 8);
            const int mt_ = (tid >> 8) & 1, q_ = (tid >> 6) & 3, fr_ = tid & 15, fq_ = (tid >> 4) & 3;
#pragma unroll
            for (int i = 0; i < 8; ++i) { const int row = (i >> 1) * 64 + 32 * (i & 1) + 8 * (fr_ >> 2) + 4 * mt_ + (fr_ & 3);
                *(LAS u32x4*)(lds + 4096 + row * CB_STRIDE + (32 * q_ + 8 * fq_) * 2) = pv[i]; }
        }
        (void)chunk_prefix(adt, ac, DT, A.a_log, tok0, g, tid);
        f32x4 y[4][4];
        float ss = 0.f;
        bf16_t* zp = YAB + (size_t)(tok0 + l) * 4096 + 2048 + g * 256 + 8 * fq;
        const bf16_t* ydp = YD + ((size_t)(j * 8 + wave) * 8 * 64 + lane) * 8;
        const int prow0 = pg8::perm32(fr), prow1 = pg8::perm32(16 + fr);
#pragma unroll
        for (int k = 0; k < 4; ++k) {
            const int h = g * 4 + k; const float ea = __expf(ac[k * 128 + l]);
            const LAS unsigned char* pp = lds + 4096 + (k * 64) * CB_STRIDE + 16 * fq;
            f32x4 ao[4];
#pragma unroll
            for (int pt = 0; pt < 4; ++pt) ao[pt] = (f32x4){0.f, 0.f, 0.f, 0.f};
            u32x4 zv4[2], yv4[2];
#pragma unroll
            for (int q = 0; q < 2; ++q) { zv4[q] = *(const u32x4*)(zp + k * 64 + q * 32); yv4[q] = *(const u32x4*)(ydp + (size_t)(k * 2 + q) * 512); }
#pragma unroll
            for (int ks = 0; ks < 4; ++ks) {
                bf16x8 fpw[4];
#pragma unroll
                for (int pt = 0; pt < 4; ++pt) fpw[pt] = *(const LAS bf16x8*)(pp + (32 * (pt >> 1) + ((pt & 1) ? prow1 : prow0)) * CB_STRIDE + 64 * ks);
#pragma unroll
                for (int pt = 0; pt < 4; ++pt) ao[pt] = __builtin_amdgcn_mfma_f32_16x16x32_bf16(fpw[pt], fc[ks], ao[pt], 0, 0, 0);
            }
#pragma unroll
            for (int pt = 0; pt < 4; ++pt) { const u32x4 z4 = zv4[pt >> 1], y4 = yv4[pt >> 1];
                const unsigned zlo = (pt & 1) ? z4.z : z4.x, zhi = (pt & 1) ? z4.w : z4.y, ylo = (pt & 1) ? y4.z : y4.x, yhi = (pt & 1) ? y4.w : y4.y;
                f32x4 v = ao[pt] * ea; v[0] = (v[0] + bflo(ylo)) * bflo(zlo); v[1] = (v[1] + bfhi(ylo)) * bfhi(zlo); v[2] = (v[2] + bflo(yhi)) * bflo(zhi); v[3] = (v[3] + bfhi(yhi)) * bfhi(zhi);
                ss += (v[0] * v[0] + v[1] * v[1]) + (v[2] * v[2] + v[3] * v[3]); y[k][pt] = v; }
            __builtin_amdgcn_sched_barrier(0);
        }
        ss += __shfl_xor(ss, 16); ss += __shfl_xor(ss, 32);
        const float rstd = 1.0f / sqrtf(ss * (1.0f / 256.0f) + EPS);
        const float* nw = A.ssm_nw + g * 256 + 8 * fq;
        u32x4 ov[4][2];
#pragma unroll
        for (int k = 0; k < 4; ++k)
#pragma unroll
            for (int q = 0; q < 2; ++q) { const f32x4 w0 = *(const f32x4*)(nw + k * 64 + q * 32), w1 = *(const f32x4*)(nw + k * 64 + q * 32 + 4); const f32x4 v0 = y[k][2 * q], v1 = y[k][2 * q + 1];
                ov[k][q].x = cvt_pk_bf16(v0[0] * rstd * w0[0], v0[1] * rstd * w0[1]); ov[k][q].y = cvt_pk_bf16(v0[2] * rstd * w0[2], v0[3] * rstd * w0[3]);
                ov[k][q].z = cvt_pk_bf16(v1[0] * rstd * w1[0], v1[1] * rstd * w1[1]); ov[k][q].w = cvt_pk_bf16(v1[2] * rstd * w1[2], v1[3] * rstd * w1[3]); }
#pragma unroll
        for (int k = 0; k < 4; ++k)
#pragma unroll
            for (int q = 0; q < 2; ++q) *(u32x4*)(zp + k * 64 + q * 32) = ov[k][q];
        __syncthreads();
    }
    GRID_SYNC(5);

    if constexpr ((PH_MASK >> 5) & 1)
    {
        pg8::Gemm g{YAB, WbT, M_TOK, DM, DM, 2 * DM}; SplitKOrder S; S.init(M_TOK, DM, G, bx, WGM_P5);
        EpiMerge E{RG, GB, MERGED};
        pg8::gemm_phase<EpiMerge, SplitKOrder, true, true>(lds, g, S, E);
    }
    GRID_SYNC(6);

    if constexpr ((PH_MASK >> 6) & 1)
    {
        pg8::Gemm g{MERGED, WoT, M_TOK, DM, DM, DM}; pg8::StaticOrder S; S.init(M_TOK, DM, G, bx, WGM_P6);
        EpiAcc E{YAB};
        pg8::gemm_phase<EpiAcc, pg8::StaticOrder, true, true>(lds, g, S, E);
    }
    GRID_SYNC(7);

    if constexpr ((PH_MASK >> 7) & 1)
    for (int m = gw; m < M_TOK; m += 2 * NGW) {
        const int m2 = m + NGW;
        int tid_ = threadIdx.x; asm volatile("" : "+v"(tid_)); const int lane = tid_ & 63;
        const f32x4* xr = (const f32x4*)(A.x + (size_t)m * DM) + lane; const f32x4* xr2 = (const f32x4*)(A.x + (size_t)m2 * DM) + lane;
        const u32x2* ar = (const u32x2*)(YAB + (size_t)m * DM) + lane; const u32x2* ar2 = (const u32x2*)(YAB + (size_t)m2 * DM) + lane;
        const f32x4* wr4 = (const f32x4*)A.fnw + lane;
        f32x4 v[8], v2[8]; u32x2 a[8], a2[8]; float s = 0.f, s2 = 0.f;
#pragma unroll
        for (int j = 0; j < 8; ++j) { v[j] = __builtin_nontemporal_load(xr + 64 * j); v2[j] = __builtin_nontemporal_load(xr2 + 64 * j); a[j] = __builtin_nontemporal_load(ar + 64 * j); a2[j] = __builtin_nontemporal_load(ar2 + 64 * j); }
#pragma unroll
        for (int j = 0; j < 8; ++j) {
            v[j][0] += bflo(a[j].x); v[j][1] += bfhi(a[j].x); v[j][2] += bflo(a[j].y); v[j][3] += bfhi(a[j].y);
            v2[j][0] += bflo(a2[j].x); v2[j][1] += bfhi(a2[j].x); v2[j][2] += bflo(a2[j].y); v2[j][3] += bfhi(a2[j].y);
            s += (v[j][0] * v[j][0] + v[j][1] * v[j][1]) + (v[j][2] * v[j][2] + v[j][3] * v[j][3]); s2 += (v2[j][0] * v2[j][0] + v2[j][1] * v2[j][1]) + (v2[j][2] * v2[j][2] + v2[j][3] * v2[j][3]); }
        const float rstd = 1.0f / sqrtf(wave_sum(s) * (1.0f / DM) + EPS), rstd2 = 1.0f / sqrtf(wave_sum(s2) * (1.0f / DM) + EPS);
        f32x4* orow = (f32x4*)(A.out + (size_t)m * DM) + lane; f32x4* orow2 = (f32x4*)(A.out + (size_t)m2 * DM) + lane;
#pragma unroll
        for (int j = 0; j < 8; ++j) { const f32x4 w4 = wr4[64 * j]; __builtin_nontemporal_store(v[j] * rstd * w4, orow + 64 * j); __builtin_nontemporal_store(v2[j] * rstd2 * w4, orow2 + 64 * j); }
    }
#ifdef SPIN_SUB
    if (bx == 0 && tid == 0) {
        const unsigned long long* st = (const unsigned long long*)(BAR + 16) + 16;
        const unsigned long long d = (st[SPIN_SUB + 1] - st[SPIN_SUB]) * SPIN_MULT, t0 = __builtin_amdgcn_s_memrealtime();
        while (__builtin_amdgcn_s_memrealtime() - t0 < d) __builtin_amdgcn_s_sleep(10);
    }
#endif
#ifdef SPIN_PHASE
    STAMP(8);
    if (bx == 0 && tid == 0) {
        const unsigned long long* st = (const unsigned long long*)(BAR + 16);
        const unsigned long long d = (st[SPIN_PHASE + 1] - st[SPIN_PHASE]) * SPIN_MULT, t0 = __builtin_amdgcn_s_memrealtime();
        while (__builtin_amdgcn_s_memrealtime() - t0 < d) __builtin_amdgcn_s_sleep(10);
    }
#endif
}

extern "C" void kernel_launch(void* const* d_in, const int* in_sizes, int n_in, void* d_out, int out_size, void* d_ws, size_t ws_size, hipStream_t stream) {
    static int grid = 0;
    if (grid == 0) {
        if (n_in != 17 || out_size != M_TOK * DM || ws_size < WS_END) { fprintf(stderr, "kernel_launch: unexpected shapes (n_in %d out %d ws %zu)\n", n_in, out_size, ws_size); grid = -1; return; }
        int dev = 0, cus = 0, per_cu = 0;
        hipGetDevice(&dev); hipDeviceGetAttribute(&cus, hipDeviceAttributeMultiprocessorCount, dev);
        if (hipFuncSetAttribute((const void*)fwd_megakernel, hipFuncAttributeMaxDynamicSharedMemorySize, LDS_BYTES) != hipSuccess) { fprintf(stderr, "kernel_launch: hipFuncSetAttribute failed\n"); grid = -1; return; }
        if (hipOccupancyMaxActiveBlocksPerMultiprocessor(&per_cu, (const void*)fwd_megakernel, NT, LDS_BYTES) != hipSuccess || per_cu < 1) { fprintf(stderr, "kernel_launch: occupancy query says %d\n", per_cu); per_cu = 1; }
        (void)hipGetLastError();
        grid = cus * 1;
    }
    if (grid < 0) return;
    Args a{};
    a.x = (const float*)d_in[0]; a.norm_w = (const float*)d_in[1]; a.w_in = (const float*)d_in[2]; a.b_gate = (const float*)d_in[3]; a.ln_w = (const float*)d_in[4]; a.ln_b = (const float*)d_in[5];
    a.w_sp = (const float*)d_in[6]; a.b_sp = (const float*)d_in[7]; a.conv_w = (const float*)d_in[8]; a.conv_b = (const float*)d_in[9]; a.dt_bias = (const float*)d_in[10]; a.a_log = (const float*)d_in[11];
    a.d_skip = (const float*)d_in[12]; a.ssm_nw = (const float*)d_in[13]; a.w_branch = (const float*)d_in[14]; a.w_out = (const float*)d_in[15]; a.fnw = (const float*)d_in[16];
    a.out = (float*)d_out; a.ws = (unsigned char*)d_ws;
    if (hipMemsetAsync((char*)d_ws + WS_BAR, 0, 256, stream) != hipSuccess) { fprintf(stderr, "kernel_launch: memset failed\n"); return; }
    void* args[] = {&a};
    hipError_t e = hipLaunchCooperativeKernel((const void*)fwd_megakernel, dim3(grid), dim3(NT), args, LDS_BYTES, stream);
    if (e != hipSuccess) fprintf(stderr, "cooperative launch failed: %s (grid %d)\n", hipGetErrorString(e), grid);
}
```

```cpp
#include <hip/hip_runtime.h>
#include <hip/hip_cooperative_groups.h>
#include <cstdio>
#include <cstdint>
namespace cg = cooperative_groups;
namespace pg8 {
#define PG8_LAS __attribute__((address_space(3)))
typedef unsigned short bf16_t;
typedef short bf16x8 __attribute__((ext_vector_type(8)));
typedef float f32x4 __attribute__((ext_vector_type(4)));
typedef unsigned u32x4 __attribute__((ext_vector_type(4)));
constexpr int BM = 256, BK = 64, HALF = 128, HTB = HALF * BK * 2  , STAGE_BYTES = 8 * HTB, NXCD = 8, WGM = 8;

__host__ __device__ __forceinline__ int lds_byte(int r, int c) { const int st = (r >> 4) * 2 + (c >> 5), rr = r & 15, cc = c & 31, ob = rr * 64 + cc * 2; return st * 1024 + (ob ^ (((ob >> 9) & 1) << 5)); }
__host__ __device__ __forceinline__ void stage_rc(int b, int& R, int& C) { const int st = b / 1024, sb = b % 1024, swz = sb ^ (((sb >> 9) & 1) << 5); R = (st >> 1) * 16 + swz / 64; C = (st & 1) * 32 + (swz % 64) / 2; }
__host__ __device__ __forceinline__ int perm32(int rho) { const int n = rho >> 4, i = rho & 15; return 8 * (i >> 2) + 4 * n + (i & 3); }

struct Unit { int pm, pn, kh; };
struct Gemm { const bf16_t* A; const bf16_t* Bt; int M, N, K, ld; };

struct StaticOrder {
    int nM, nN, nwg, G, c, wgm;
    __host__ __device__ void init(int M, int N, int G_, int c_, int wgm_ = WGM) { nM = M / BM; nN = N / BM; nwg = nM * nN; G = G_; c = c_; wgm = wgm_; }
    __host__ __device__ bool next(int i, Unit& u) const {
        const long L = (long)i * G + c; if (L >= nwg) return false;
        int wgid = (int)L; { const int q = nwg / NXCD, r = nwg % NXCD, xcd = wgid % NXCD, off = wgid / NXCD; wgid = (xcd < r ? xcd * (q + 1) : r * (q + 1) + (xcd - r) * q) + off; }
        const int nig = wgm * nN, gid = wgid / nig, fm = gid * wgm, gsz = (nM - fm) < wgm ? (nM - fm) : wgm;
        u.pm = fm + ((wgid % nig) % gsz); u.pn = (wgid % nig) / gsz; u.kh = 0; return true;
    }
    __device__ __forceinline__ void a_ready(const Unit&) const {}
    __device__ __forceinline__ void done(const Unit&) const {}
};
typedef float f32x2_t_ __attribute__((ext_vector_type(2)));
typedef __bf16 bf16x2_t_ __attribute__((ext_vector_type(2)));
__device__ __forceinline__ unsigned cvt_pk_bf16(float lo, float hi) { const f32x2_t_ v = {lo, hi}; const bf16x2_t_ b = __builtin_convertvector(v, bf16x2_t_); return __builtin_bit_cast(unsigned, b); }
template <class Epi, class Sched, bool ALIGN_EPI = false, bool SP2 = false>
__device__ __forceinline__ void gemm_phase(PG8_LAS unsigned char* lds, const Gemm g, const Sched& S, const Epi& E) {
    int tid_ = threadIdx.x; asm volatile("" : "+v"(tid_));
    const int tid = tid_, wid = __builtin_amdgcn_readfirstlane(tid >> 6), lane = tid & 63, wr = wid >> 2, wc = wid & 3, fr = lane & 15, fq = lane >> 4;
    const int K = g.K, nt = K / BK, ld = g.ld;
    unsigned voffA[2], voffB[2];
#pragma unroll
    for (int i = 0; i < 2; ++i) { int R, C; stage_rc(tid * 16 + i * 8192, R, C); const int Rb = Epi::PERM ? ((R & ~31) + perm32(R & 31)) : R;
        voffA[i] = (unsigned)(R * ld + C) * 2u; voffB[i] = (unsigned)(Rb * ld + C) * 2u; }
    const size_t kstep = (size_t)(BK * 2);
    const size_t hstep = (size_t)HALF * ld * 2;
    const size_t tstep = 2 * hstep;
    const unsigned ldsw = (unsigned)wid * 1024u;
    const int aoff = lds_byte(wr * 64 + fr, fq * 8), boff = lds_byte(wc * 32 + fr, fq * 8);
#define PG8_SA(b, h) (((b) * 2 + (h)) * HTB)
#define PG8_SB(b, h) ((4 + (b) * 2 + (h)) * HTB)
#define PG8_STAGE(bufoff, gbase, voff) do { _Pragma("unroll") for (int _i = 0; _i < 2; ++_i) \
        __builtin_amdgcn_global_load_lds((const unsigned*)((const char*)(gbase) + (voff)[_i]), (PG8_LAS unsigned*)(lds + (bufoff) + ldsw + _i * 8192), 16, 0, 0); } while (0)
#define PG8_LDA(dst, b, h) do { _Pragma("unroll") for (int m = 0; m < 4; ++m) _Pragma("unroll") for (int k = 0; k < 2; ++k) dst[m][k] = *(const PG8_LAS bf16x8*)(lds + PG8_SA(b, h) + aoff + m * 2048 + k * 1024); } while (0)
#define PG8_LDB(dst, b, h) do { _Pragma("unroll") for (int n = 0; n < 2; ++n) _Pragma("unroll") for (int k = 0; k < 2; ++k) dst[n][k] = *(const PG8_LAS bf16x8*)(lds + PG8_SB(b, h) + boff + n * 2048 + k * 1024); } while (0)
#define PG8_MMA(ai, bj, At, Bt) do { __builtin_amdgcn_s_setprio(1); _Pragma("unroll") for (int m = 0; m < 4; ++m) _Pragma("unroll") for (int n = 0; n < 2; ++n) _Pragma("unroll") for (int k = 0; k < 2; ++k) \
        acc[ai][bj][m][n] = __builtin_amdgcn_mfma_f32_16x16x32_bf16(Bt[n][k], At[m][k], acc[ai][bj][m][n], 0, 0, 0); __builtin_amdgcn_s_setprio(0); } while (0)
#define PG8_WAIT_V(n) asm volatile("s_waitcnt vmcnt(" #n ")" ::: "memory")
#define PG8_WAIT_L(n) asm volatile("s_waitcnt lgkmcnt(" #n ")" ::: "memory")
#define PG8_BAR __builtin_amdgcn_s_barrier()
#define PG8_SCHED __builtin_amdgcn_sched_barrier(0)
    Unit cur, nxt; int ui = 0;
    if (!S.next(0, cur)) return;
    f32x4 acc[2][2][4][2];
#pragma unroll
    for (int a = 0; a < 2; ++a)
#pragma unroll
        for (int b = 0; b < 2; ++b)
#pragma unroll
            for (int m = 0; m < 4; ++m)
#pragma unroll
                for (int n = 0; n < 2; ++n) acc[a][b][m][n] = (f32x4){0.f, 0.f, 0.f, 0.f};
    bf16x8 At[4][2], B0[2][2], B1[2][2];
    const char* cA = (const char*)g.A + (size_t)cur.pm * tstep + (size_t)cur.kh * K * 2; const char* cB = (const char*)g.Bt + (size_t)cur.pn * tstep + (size_t)cur.kh * K * 2;
    S.a_ready(cur);
    if constexpr (SP2) {
        PG8_STAGE(PG8_SB(0, 0), cB, voffB); PG8_STAGE(PG8_SB(0, 1), cB + hstep, voffB); PG8_STAGE(PG8_SA(0, 0), cA, voffA); PG8_STAGE(PG8_SA(0, 1), cA + hstep, voffA);
        if (wr == 1) PG8_BAR;
        PG8_WAIT_V(2); PG8_BAR;
        PG8_STAGE(PG8_SB(1, 0), cB + kstep, voffB); PG8_STAGE(PG8_SA(1, 0), cA + kstep, voffA); PG8_STAGE(PG8_SB(1, 1), cB + hstep + kstep, voffB);
        PG8_WAIT_V(6); PG8_BAR;
    } else {
        PG8_STAGE(PG8_SB(0, 0), cB, voffB); PG8_STAGE(PG8_SA(0, 0), cA, voffA); PG8_STAGE(PG8_SB(0, 1), cB + hstep, voffB); PG8_STAGE(PG8_SA(0, 1), cA + hstep, voffA);
        if (wr == 1) PG8_BAR;
        PG8_WAIT_V(4); PG8_BAR;
        PG8_STAGE(PG8_SB(1, 0), cB + kstep, voffB); PG8_STAGE(PG8_SA(1, 0), cA + kstep, voffA); PG8_STAGE(PG8_SB(1, 1), cB + hstep + kstep, voffB);
        PG8_WAIT_V(6); PG8_BAR;
    }
    for (;;) {
        const bool has_next = S.next(ui + 1, nxt);
        const char* nA = has_next ? (const char*)g.A + (size_t)nxt.pm * tstep + (size_t)nxt.kh * K * 2 : cA; const char* nB = has_next ? (const char*)g.Bt + (size_t)nxt.pn * tstep + (size_t)nxt.kh * K * 2 : cB;
        for (int t = 0; t < nt; t += 2) {
            const bool last = (t == nt - 2);
            const char* a1 = cA + (size_t)(t + 1) * kstep;
            const char* a2 = last ? nA : cA + (size_t)(t + 2) * kstep; const char* b2 = last ? nB : cB + (size_t)(t + 2) * kstep;
            const char* a3 = a2 + kstep; const char* b3 = b2 + kstep;
            if (last && has_next) S.a_ready(nxt);
            if constexpr (SP2) {
            PG8_LDB(B0, 0, 0); PG8_LDB(B1, 0, 1); PG8_SCHED; PG8_LDA(At, 0, 0); PG8_STAGE(PG8_SA(1, 1), a1 + hstep, voffA);
            PG8_WAIT_V(8); PG8_WAIT_L(0); PG8_BAR; PG8_MMA(0, 0, At, B0); PG8_MMA(0, 1, At, B1); PG8_BAR; PG8_SCHED;
            PG8_LDA(At, 0, 1); PG8_STAGE(PG8_SB(0, 0), b2, voffB); PG8_STAGE(PG8_SB(0, 1), b2 + hstep, voffB); PG8_STAGE(PG8_SA(0, 0), a2, voffA);
            PG8_WAIT_V(8); PG8_WAIT_L(0); PG8_BAR; PG8_MMA(1, 0, At, B0); PG8_MMA(1, 1, At, B1); PG8_BAR; PG8_SCHED;
            PG8_LDB(B0, 1, 0); PG8_LDB(B1, 1, 1); PG8_SCHED; PG8_LDA(At, 1, 0); PG8_STAGE(PG8_SA(0, 1), a2 + hstep, voffA);
            PG8_WAIT_V(8); PG8_WAIT_L(0); PG8_BAR; PG8_MMA(0, 0, At, B0); PG8_MMA(0, 1, At, B1); PG8_BAR; PG8_SCHED;
            PG8_LDA(At, 1, 1); PG8_STAGE(PG8_SB(1, 0), b3, voffB); PG8_STAGE(PG8_SB(1, 1), b3 + hstep, voffB); PG8_STAGE(PG8_SA(1, 0), a3, voffA);
            PG8_WAIT_V(8); PG8_WAIT_L(0); PG8_BAR; PG8_MMA(1, 0, At, B0); PG8_MMA(1, 1, At, B1); PG8_BAR; PG8_SCHED;
            } else {
            PG8_LDB(B0, 0, 0); PG8_SCHED; PG8_LDA(At, 0, 0); PG8_STAGE(PG8_SA(1, 1), a1 + hstep, voffA);
            PG8_WAIT_L(8); PG8_BAR; PG8_WAIT_L(0); PG8_MMA(0, 0, At, B0); PG8_BAR; PG8_SCHED;
            PG8_LDB(B1, 0, 1); PG8_STAGE(PG8_SB(0, 0), b2, voffB);
            PG8_BAR; PG8_WAIT_L(0); PG8_MMA(0, 1, At, B1); PG8_BAR;
            PG8_LDA(At, 0, 1); PG8_STAGE(PG8_SA(0, 0), a2, voffA);
            PG8_BAR; PG8_WAIT_L(0); PG8_MMA(1, 0, At, B0); PG8_BAR; PG8_SCHED;
            PG8_STAGE(PG8_SB(0, 1), b2 + hstep, voffB);
            PG8_WAIT_V(6); PG8_BAR; PG8_MMA(1, 1, At, B1); PG8_BAR;
            PG8_LDB(B0, 1, 0); PG8_SCHED; PG8_LDA(At, 1, 0); PG8_STAGE(PG8_SA(0, 1), a2 + hstep, voffA);
            PG8_WAIT_L(8); PG8_BAR; PG8_WAIT_L(0); PG8_MMA(0, 0, At, B0); PG8_BAR; PG8_SCHED;
            PG8_LDB(B1, 1, 1); PG8_STAGE(PG8_SB(1, 0), b3, voffB);
            PG8_BAR; PG8_WAIT_L(0); PG8_MMA(0, 1, At, B1); PG8_BAR;
            PG8_LDA(At, 1, 1); PG8_STAGE(PG8_SA(1, 0), a3, voffA);
            PG8_BAR; PG8_WAIT_L(0); PG8_MMA(1, 0, At, B0); PG8_BAR; PG8_SCHED;
            PG8_STAGE(PG8_SB(1, 1), b3 + hstep, voffB);
            PG8_WAIT_V(6); PG8_BAR; PG8_MMA(1, 1, At, B1); PG8_BAR;
            }
        }
        if constexpr (ALIGN_EPI) { if (wr == 0) PG8_BAR; }
        if constexpr (!Epi::AFTER_DRAIN) { E(acc, cur, wr, wc, fr, fq); S.done(cur); }
        if (!has_next) break;
        if (!E.keep(cur))
#pragma unroll
        for (int a = 0; a < 2; ++a)
#pragma unroll
            for (int b = 0; b < 2; ++b)
#pragma unroll
                for (int m = 0; m < 4; ++m)
#pragma unroll
                    for (int n = 0; n < 2; ++n) acc[a][b][m][n] = (f32x4){0.f, 0.f, 0.f, 0.f};
        cur = nxt; cA = nA; cB = nB; ++ui;
        if constexpr (ALIGN_EPI) { if (wr == 1) PG8_BAR; }
    }
    PG8_WAIT_V(0);
    if constexpr (!ALIGN_EPI) { if (wr == 0) PG8_BAR; }
    PG8_BAR;
    if constexpr (Epi::AFTER_DRAIN) { E.fused(acc, cur, wr, wc, fr, fq, lds, wid, lane); S.done(cur); }
#undef PG8_SA
#undef PG8_SB
#undef PG8_STAGE
#undef PG8_LDA
#undef PG8_LDB
#undef PG8_MMA
#undef PG8_WAIT_V
#undef PG8_WAIT_L
#undef PG8_BAR
#undef PG8_SCHED
}
}

#define LAS __attribute__((address_space(3)))
using pg8::bf16_t; using pg8::bf16x8; using pg8::f32x4; using pg8::u32x4; using pg8::cvt_pk_bf16;
typedef unsigned u32x2 __attribute__((ext_vector_type(2)));
typedef short s16x4 __attribute__((ext_vector_type(4)));

constexpr int NT = 512, NWAVES = 8;
constexpr int M_TOK = 16384, DM = 2048, SEQ = 4096, NCH = 32, CL_ = 128;
constexpr int NIN = 16416;
constexpr int NPROJ = 16384;
constexpr float EPS = 1e-5f;
constexpr int LDS_BYTES = 147456;
#ifndef WGM_P1
#define WGM_P1 4
#endif
#ifndef WGM_P5
#define WGM_P5 4
#endif
#ifndef WGM_P6
#define WGM_P6 4
#endif
#ifndef PH_MASK
#define PH_MASK 0xFF
#endif

constexpr size_t MiB = 1048576;
constexpr size_t WS_BAR = 3 * MiB + 65536;
constexpr size_t WS_WDT = 0, WS_WSB = 131072, WS_STATS = 393216, WS_SSQ = 524288, WS_CD = 589824, WS_DT = 1 * MiB;
constexpr size_t WS_WB = 4 * MiB, WS_WO = 20 * MiB, WS_YAB = 28 * MiB, WS_V = 156 * MiB, WS_XBC = 220 * MiB, WS_R = 348 * MiB, WS_GB = 412 * MiB, WS_CC = 476 * MiB, WS_END = 508 * MiB;

__device__ __forceinline__ float bf2f(unsigned short u) { return __uint_as_float(((unsigned)u) << 16); }
__device__ __forceinline__ float bflo(unsigned w) { return __uint_as_float(w << 16); }
__device__ __forceinline__ float bfhi(unsigned w) { return __uint_as_float(w & 0xffff0000u); }
__device__ __forceinline__ float silu_f(float v) { return v * __builtin_amdgcn_rcpf(1.0f + __expf(-v)); }
__device__ __forceinline__ float sigmoid_f(float v) { return __builtin_amdgcn_rcpf(1.0f + __expf(-v)); }
__device__ __forceinline__ float wave_sum(float v) {
#pragma unroll
    for (int o = 1; o < 64; o <<= 1) v += __shfl_xor(v, o);
    return v;
}
__device__ __forceinline__ void atomic_addf(float* p, float v) { __hip_atomic_fetch_add(p, v, __ATOMIC_RELAXED, __HIP_MEMORY_SCOPE_AGENT); }

template <int OFF> __device__ __forceinline__ bf16x8 tr_frag(unsigned a) {
    s16x4 lo, hi;
    asm volatile("ds_read_b64_tr_b16 %0, %2\n\tds_read_b64_tr_b16 %1, %2 offset:%3\n\ts_waitcnt lgkmcnt(0)" : "=&v"(lo), "=&v"(hi) : "v"(a), "n"(OFF) : "memory");
    return (bf16x8){lo[0], lo[1], lo[2], lo[3], hi[0], hi[1], hi[2], hi[3]};
}

template <int OFF, int STEP> __device__ __forceinline__ void tr_frag2(unsigned a, bf16x8& f0, bf16x8& f1) {
    s16x4 l0, h0, l1, h1;
    asm volatile("ds_read_b64_tr_b16 %0, %4\n\tds_read_b64_tr_b16 %1, %4 offset:%5\n\tds_read_b64_tr_b16 %2, %4 offset:%6\n\tds_read_b64_tr_b16 %3, %4 offset:%7\n\ts_waitcnt lgkmcnt(0)"
                 : "=&v"(l0), "=&v"(h0), "=&v"(l1), "=&v"(h1) : "v"(a), "n"(OFF), "n"(STEP), "n"(STEP + OFF) : "memory");
    f0 = (bf16x8){l0[0], l0[1], l0[2], l0[3], h0[0], h0[1], h0[2], h0[3]}; f1 = (bf16x8){l1[0], l1[1], l1[2], l1[3], h1[0], h1[1], h1[2], h1[3]};
}
template <int OFF, int STEP> __device__ __forceinline__ void tr_frag4(unsigned a, bf16x8& f0, bf16x8& f1, bf16x8& f2, bf16x8& f3) {
    s16x4 l0, h0, l1, h1, l2, h2, l3, h3;
    asm volatile("ds_read_b64_tr_b16 %0, %8\n\tds_read_b64_tr_b16 %1, %8 offset:%9\n\tds_read_b64_tr_b16 %2, %8 offset:%10\n\tds_read_b64_tr_b16 %3, %8 offset:%11\n\t"
                 "ds_read_b64_tr_b16 %4, %8 offset:%12\n\tds_read_b64_tr_b16 %5, %8 offset:%13\n\tds_read_b64_tr_b16 %6, %8 offset:%14\n\tds_read_b64_tr_b16 %7, %8 offset:%15\n\ts_waitcnt lgkmcnt(0)"
                 : "=&v"(l0), "=&v"(h0), "=&v"(l1), "=&v"(h1), "=&v"(l2), "=&v"(h2), "=&v"(l3), "=&v"(h3)
                 : "v"(a), "n"(OFF), "n"(STEP), "n"(STEP + OFF), "n"(2 * STEP), "n"(2 * STEP + OFF), "n"(3 * STEP), "n"(3 * STEP + OFF) : "memory");
    f0 = (bf16x8){l0[0], l0[1], l0[2], l0[3], h0[0], h0[1], h0[2], h0[3]}; f1 = (bf16x8){l1[0], l1[1], l1[2], l1[3], h1[0], h1[1], h1[2], h1[3]};
    f2 = (bf16x8){l2[0], l2[1], l2[2], l2[3], h2[0], h2[1], h2[2], h2[3]}; f3 = (bf16x8){l3[0], l3[1], l3[2], l3[3], h3[0], h3[1], h3[2], h3[3]};
}

struct Args {
    const float* x; const float* norm_w; const float* w_in; const float* b_gate; const float* ln_w; const float* ln_b; const float* w_sp; const float* b_sp;
    const float* conv_w; const float* conv_b; const float* dt_bias; const float* a_log; const float* d_skip; const float* ssm_nw; const float* w_branch; const float* w_out; const float* fnw;
    float* out; unsigned char* ws;
};

struct EpiProj {
    static constexpr bool PERM = true, AFTER_DRAIN = false;
    __device__ __forceinline__ bool keep(const pg8::Unit&) const { return false; }
    bf16_t* YAB; bf16_t* V; bf16_t* XBC; bf16_t* R; bf16_t* GB; float* stats; const float* b_gate;
    __device__ __forceinline__ void operator()(const f32x4 (&acc)[2][2][4][2], const pg8::Unit& u, int wr, int wc, int fr, int fq) const {
        const int row0 = u.pm * 256 + wr * 64 + fr, pn = u.pn, cl = wc * 32 + 8 * fq;
        if (pn < 16) {
#pragma unroll
            for (int ai = 0; ai < 2; ++ai)
#pragma unroll
                for (int m = 0; m < 4; ++m) {
                    const f32x4 u0 = acc[ai][0][m][0], u1 = acc[ai][0][m][1], z0 = acc[ai][1][m][0], z1 = acc[ai][1][m][1];
                    u32x4 w;
                    w.x = cvt_pk_bf16(silu_f(z0[0]) * u0[0], silu_f(z0[1]) * u0[1]); w.y = cvt_pk_bf16(silu_f(z0[2]) * u0[2], silu_f(z0[3]) * u0[3]);
                    w.z = cvt_pk_bf16(silu_f(z1[0]) * u1[0], silu_f(z1[1]) * u1[1]); w.w = cvt_pk_bf16(silu_f(z1[2]) * u1[2], silu_f(z1[3]) * u1[3]);
                    __builtin_nontemporal_store(w, (u32x4*)(YAB + (size_t)(row0 + ai * 128 + m * 16) * 4096 + pn * 128 + cl));
                }
        } else if (pn < 24) {
            const int c0 = (pn - 16) * 256 + cl;
#pragma unroll
            for (int ai = 0; ai < 2; ++ai)
#pragma unroll
                for (int m = 0; m < 4; ++m) {
                    const int row = row0 + ai * 128 + m * 16; float s = 0.f, q = 0.f;
#pragma unroll
                    for (int bj = 0; bj < 2; ++bj) {
                        const f32x4 v0 = acc[ai][bj][m][0], v1 = acc[ai][bj][m][1];
                        s += (v0[0] + v0[1]) + (v0[2] + v0[3]) + (v1[0] + v1[1]) + (v1[2] + v1[3]);
                        q += (v0[0] * v0[0] + v0[1] * v0[1]) + (v0[2] * v0[2] + v0[3] * v0[3]) + (v1[0] * v1[0] + v1[1] * v1[1]) + (v1[2] * v1[2] + v1[3] * v1[3]);
                        u32x4 w; w.x = cvt_pk_bf16(v0[0], v0[1]); w.y = cvt_pk_bf16(v0[2], v0[3]); w.z = cvt_pk_bf16(v1[0], v1[1]); w.w = cvt_pk_bf16(v1[2], v1[3]);
                        __builtin_nontemporal_store(w, (u32x4*)(V + (size_t)row * 2048 + c0 + bj * 128));
                    }
                    s += __shfl_xor(s, 16); s += __shfl_xor(s, 32); q += __shfl_xor(q, 16); q += __shfl_xor(q, 32);
                    if (fq == 0) { atomic_addf(stats + 2 * row, s); atomic_addf(stats + 2 * row + 1, q); }
                }
        } else if (pn < 32) {
            const int c0 = (pn - 24) * 256 + cl;
#pragma unroll
            for (int ai = 0; ai < 2; ++ai)
#pragma unroll
                for (int m = 0; m < 4; ++m)
#pragma unroll
                    for (int bj = 0; bj < 2; ++bj) {
                        const f32x4 v0 = acc[ai][bj][m][0], v1 = acc[ai][bj][m][1];
                        u32x4 w; w.x = cvt_pk_bf16(silu_f(v0[0]), silu_f(v0[1])); w.y = cvt_pk_bf16(silu_f(v0[2]), silu_f(v0[3])); w.z = cvt_pk_bf16(silu_f(v1[0]), silu_f(v1[1])); w.w = cvt_pk_bf16(silu_f(v1[2]), silu_f(v1[3]));
                        __builtin_nontemporal_store(w, (u32x4*)(YAB + (size_t)(row0 + ai * 128 + m * 16) * 4096 + 2048 + c0 + bj * 128));
                    }
        } else if (pn < 48) {
            const int c0 = (pn - 32) * 256 + cl;
#pragma unroll
            for (int ai = 0; ai < 2; ++ai)
#pragma unroll
                for (int m = 0; m < 4; ++m)
#pragma unroll
                    for (int bj = 0; bj < 2; ++bj) {
                        const f32x4 v0 = acc[ai][bj][m][0], v1 = acc[ai][bj][m][1];
                        u32x4 w; w.x = cvt_pk_bf16(v0[0], v0[1]); w.y = cvt_pk_bf16(v0[2], v0[3]); w.z = cvt_pk_bf16(v1[0], v1[1]); w.w = cvt_pk_bf16(v1[2], v1[3]);
                        __builtin_nontemporal_store(w, (u32x4*)(XBC + (size_t)(row0 + ai * 128 + m * 16) * 4096 + c0 + bj * 128));
                    }
        } else {
            const int c0 = (pn - 48) * 128 + cl;
            const f32x4 ba0 = *(const f32x4*)(b_gate + c0), ba1 = *(const f32x4*)(b_gate + c0 + 4), bb0 = *(const f32x4*)(b_gate + 2048 + c0), bb1 = *(const f32x4*)(b_gate + 2048 + c0 + 4);
#pragma unroll
            for (int ai = 0; ai < 2; ++ai)
#pragma unroll
                for (int m = 0; m < 4; ++m) {
                    f32x4 a0 = acc[ai][0][m][0] + ba0, a1 = acc[ai][0][m][1] + ba1, b0 = acc[ai][1][m][0] + bb0, b1 = acc[ai][1][m][1] + bb1;
#pragma unroll
                    for (int j = 0; j < 4; ++j) { a0[j] = fminf(fmaxf(a0[j], -30.f), 30.f); a1[j] = fminf(fmaxf(a1[j], -30.f), 30.f); b0[j] = fminf(fmaxf(b0[j], -30.f), 30.f); b1[j] = fminf(fmaxf(b1[j], -30.f), 30.f); }
                    float ea[8], eb[8], rr[8], gb[8];
#pragma unroll
                    for (int j = 0; j < 4; ++j) { ea[j] = 1.0f + __expf(-a0[j]); ea[4 + j] = 1.0f + __expf(-a1[j]); eb[j] = 1.0f + __expf(-b0[j]); eb[4 + j] = 1.0f + __expf(-b1[j]); }
#pragma unroll
                    for (int j = 0; j < 8; ++j) { rr[j] = eb[j] * __builtin_amdgcn_rcpf(ea[j]); gb[j] = 1.0f * __builtin_amdgcn_rcpf(eb[j]); }
                    u32x4 wr_, wg_;
                    wr_.x = cvt_pk_bf16(rr[0], rr[1]); wr_.y = cvt_pk_bf16(rr[2], rr[3]); wr_.z = cvt_pk_bf16(rr[4], rr[5]); wr_.w = cvt_pk_bf16(rr[6], rr[7]);
                    wg_.x = cvt_pk_bf16(gb[0], gb[1]); wg_.y = cvt_pk_bf16(gb[2], gb[3]); wg_.z = cvt_pk_bf16(gb[4], gb[5]); wg_.w = cvt_pk_bf16(gb[6], gb[7]);
                    const size_t o = ((((((size_t)u.pm * 8 + ((pn - 48) >> 1)) * 2 + ((pn - 48) & 1)) * 2 + ai) * 4 + m) * 8 + (wr * 4 + wc)) * 512 + (size_t)(fr + 16 * fq) * 8;
                    __builtin_nontemporal_store(wr_, (u32x4*)(R + o)); __builtin_nontemporal_store(wg_, (u32x4*)(GB + o));
                }
        }
    }
};
__device__ __forceinline__ void merge_store(const bf16_t* __restrict__ GB, bf16_t* __restrict__ merged, const f32x4 (&acc)[2][2][4][2], int row0, int col0, size_t gbase, int wl) {
#pragma unroll
    for (int ai = 0; ai < 2; ++ai) {
        u32x4 gv[4][2];
#pragma unroll
        for (int m = 0; m < 4; ++m)
#pragma unroll
            for (int bj = 0; bj < 2; ++bj) gv[m][bj] = __builtin_nontemporal_load((const u32x4*)(GB + ((((gbase * 2 + bj) * 2 + ai) * 4 + m) * 8) * 512 + wl));
#pragma unroll
        for (int m = 0; m < 4; ++m)
#pragma unroll
            for (int bj = 0; bj < 2; ++bj) { const u32x4 g = gv[m][bj]; const f32x4 v0 = acc[ai][bj][m][0], v1 = acc[ai][bj][m][1];
                u32x4 w; w.x = cvt_pk_bf16(v0[0] * bflo(g.x), v0[1] * bfhi(g.x)); w.y = cvt_pk_bf16(v0[2] * bflo(g.y), v0[3] * bfhi(g.y));
                w.z = cvt_pk_bf16(v1[0] * bflo(g.z), v1[1] * bfhi(g.z)); w.w = cvt_pk_bf16(v1[2] * bflo(g.w), v1[3] * bfhi(g.w));
                *(u32x4*)(merged + (size_t)(row0 + ai * 128 + m * 16) * 2048 + col0 + bj * 128) = w; }
    }
}
struct EpiMerge {
    static constexpr bool PERM = true, AFTER_DRAIN = false;
    const bf16_t* R; const bf16_t* GB; bf16_t* merged;
    __device__ __forceinline__ bool keep(const pg8::Unit& u) const { return u.kh == 0; }
    __device__ __forceinline__ void operator()(f32x4 (&acc)[2][2][4][2], const pg8::Unit& u, int wr, int wc, int fr, int fq) const {
        const int row0 = u.pm * 256 + wr * 64 + fr, col0 = u.pn * 256 + wc * 32 + 8 * fq;
        const size_t gbase = (size_t)u.pm * 8 + u.pn; const int wl = (wr * 4 + wc) * 512 + (fr + 16 * fq) * 8;
        if (u.kh == 0) {
#pragma unroll
            for (int ai = 0; ai < 2; ++ai) {
                u32x4 rv[4][2];
#pragma unroll
                for (int m = 0; m < 4; ++m)
#pragma unroll
                    for (int bj = 0; bj < 2; ++bj) rv[m][bj] = __builtin_nontemporal_load((const u32x4*)(R + ((((gbase * 2 + bj) * 2 + ai) * 4 + m) * 8) * 512 + wl));
#pragma unroll
                for (int m = 0; m < 4; ++m)
#pragma unroll
                    for (int bj = 0; bj < 2; ++bj) { const u32x4 g = rv[m][bj];
                        f32x4 v0 = acc[ai][bj][m][0], v1 = acc[ai][bj][m][1];
                        v0[0] *= bflo(g.x); v0[1] *= bfhi(g.x); v0[2] *= bflo(g.y); v0[3] *= bfhi(g.y); v1[0] *= bflo(g.z); v1[1] *= bfhi(g.z); v1[2] *= bflo(g.w); v1[3] *= bfhi(g.w);
                        acc[ai][bj][m][0] = v0; acc[ai][bj][m][1] = v1; }
            }
        } else merge_store(GB, merged, acc, row0, col0, gbase, wl);
    }
};
struct SplitKOrder : pg8::StaticOrder {
    __device__ bool next(int i, pg8::Unit& u) const { const bool ok = pg8::StaticOrder::next(i >> 1, u); u.kh = i & 1; return ok; }
};
__device__ __forceinline__ void out_store(const float* __restrict__ x, float* __restrict__ out, float* __restrict__ ssq, const f32x4 (&acc)[2][2][4][2], int row0, int col0, int fq) {
    f32x4 xv[2][4];
#pragma unroll
    for (int bj = 0; bj < 2; ++bj)
#pragma unroll
        for (int n = 0; n < 2; ++n) xv[0][bj * 2 + n] = *(const f32x4*)(x + (size_t)row0 * 2048 + col0 + bj * 128 + n * 16);
#pragma unroll
    for (int gi = 0; gi < 8; ++gi) {
        const int ai = gi >> 2, m = gi & 3;
        if (gi < 7) { const int ai2 = (gi + 1) >> 2, m2 = (gi + 1) & 3;
#pragma unroll
            for (int bj = 0; bj < 2; ++bj)
#pragma unroll
                for (int n = 0; n < 2; ++n) xv[(gi + 1) & 1][bj * 2 + n] = *(const f32x4*)(x + (size_t)(row0 + ai2 * 128 + m2 * 16) * 2048 + col0 + bj * 128 + n * 16); }
        const size_t row = (size_t)(row0 + ai * 128 + m * 16); float q = 0.f;
#pragma unroll
        for (int bj = 0; bj < 2; ++bj)
#pragma unroll
            for (int n = 0; n < 2; ++n) { const f32x4 r = xv[gi & 1][bj * 2 + n] + acc[ai][bj][m][n];
                q += (r[0] * r[0] + r[1] * r[1]) + (r[2] * r[2] + r[3] * r[3]);
                *(f32x4*)(out + row * 2048 + col0 + bj * 128 + n * 16) = r; }
        q += __shfl_xor(q, 16); q += __shfl_xor(q, 32);
        if (fq == 0) atomic_addf(ssq + row, q);
    }
}
struct EpiOut {
    static constexpr bool PERM = false, AFTER_DRAIN = false;
    __device__ __forceinline__ bool keep(const pg8::Unit&) const { return false; }
    const float* x; float* out; float* ssq;
    __device__ __forceinline__ void operator()(const f32x4 (&acc)[2][2][4][2], const pg8::Unit& u, int wr, int wc, int fr, int fq) const {
        out_store(x, out, ssq, acc, u.pm * 256 + wr * 64 + fr, u.pn * 256 + wc * 32 + 4 * fq, fq);
    }
};

struct EpiAcc {
    static constexpr bool PERM = true, AFTER_DRAIN = false;
    __device__ __forceinline__ bool keep(const pg8::Unit&) const { return false; }
    bf16_t* O;
    __device__ __forceinline__ void operator()(const f32x4 (&acc)[2][2][4][2], const pg8::Unit& u, int wr, int wc, int fr, int fq) const {
        const int row0 = u.pm * 256 + wr * 64 + fr, col0 = u.pn * 256 + wc * 32 + 8 * fq;
#pragma unroll
        for (int ai = 0; ai < 2; ++ai)
#pragma unroll
            for (int m = 0; m < 4; ++m)
#pragma unroll
                for (int bj = 0; bj < 2; ++bj) {
                    const f32x4 v0 = acc[ai][bj][m][0], v1 = acc[ai][bj][m][1];
                    u32x4 w; w.x = cvt_pk_bf16(v0[0], v0[1]); w.y = cvt_pk_bf16(v0[2], v0[3]); w.z = cvt_pk_bf16(v1[0], v1[1]); w.w = cvt_pk_bf16(v1[2], v1[3]);
                    __builtin_nontemporal_store(w, (u32x4*)(O + (size_t)(row0 + ai * 128 + m * 16) * 2048 + col0 + bj * 128));
                }
    }
};

__device__ __forceinline__ void transpose_item(const float* W, int ldw, int K, int k0, int n0, bf16_t* dst, LAS float* scr, int lane, int kd = -1) {
    if (kd < 0) kd = k0;
#pragma unroll 8
    for (int i = 0; i < 32; ++i) { const int kk = 2 * i + (lane >> 5); scr[kk * 33 + (lane & 31)] = W[(size_t)(k0 + kk) * ldw + n0 + (lane & 31)]; }
    asm volatile("s_waitcnt lgkmcnt(0)" ::: "memory");
    const int c = lane & 7;
#pragma unroll
    for (int j = 0; j < 4; ++j) { const int n = (lane >> 3) + 8 * j; const LAS float* s = scr + (8 * c) * 33 + n;
        u32x4 o; o.x = cvt_pk_bf16(s[0 * 33], s[1 * 33]); o.y = cvt_pk_bf16(s[2 * 33], s[3 * 33]); o.z = cvt_pk_bf16(s[4 * 33], s[5 * 33]); o.w = cvt_pk_bf16(s[6 * 33], s[7 * 33]);
        *(u32x4*)(dst + (size_t)n * K + kd + 8 * c) = o; }
    asm volatile("s_waitcnt lgkmcnt(0)" ::: "memory");
}
struct TItem { const float* src; bf16_t* dst; int ldw, ldd; };
__device__ __forceinline__ void titem_load(const TItem& t, f32x4 (&v)[16], int lane) {
    const int r4 = lane >> 4, c4 = lane & 15;
#pragma unroll
    for (int i = 0; i < 16; ++i) v[i] = __builtin_nontemporal_load((const f32x4*)(t.src + (size_t)(4 * i + r4) * t.ldw + 4 * c4));
}
__device__ __forceinline__ void titem_finish(const TItem& t, const f32x4 (&v)[16], LAS float* scr, int lane) {
    const int r4 = lane >> 4, c4 = lane & 15;
#pragma unroll
    for (int i = 0; i < 16; ++i) { LAS float* p = scr + (4 * i + r4) * 65 + 4 * c4; p[0] = v[i][0]; p[1] = v[i][1]; p[2] = v[i][2]; p[3] = v[i][3]; }
    asm volatile("s_waitcnt lgkmcnt(0)" ::: "memory");
    const int c = lane & 7;
#pragma unroll
    for (int i = 0; i < 8; ++i) { const int n = (lane >> 3) + 8 * i; const LAS float* s = scr + (8 * c) * 65 + n;
        u32x4 o; o.x = cvt_pk_bf16(s[0 * 65], s[1 * 65]); o.y = cvt_pk_bf16(s[2 * 65], s[3 * 65]); o.z = cvt_pk_bf16(s[4 * 65], s[5 * 65]); o.w = cvt_pk_bf16(s[6 * 65], s[7 * 65]);
        *(u32x4*)(t.dst + (size_t)n * t.ldd + 8 * c) = o; }
    asm volatile("s_waitcnt lgkmcnt(0)" ::: "memory");
}
__device__ __forceinline__ int proj_row(int n0) {
    if (n0 < 2048) return 256 * (n0 >> 7) + (n0 & 127);
    if (n0 < 4096) return 4096 + (n0 - 2048);
    if (n0 < 6144) { const int ch = n0 - 4096; return 256 * (ch >> 7) + 128 + (ch & 127); }
    if (n0 < 12288) return n0;
    if (n0 < 12320) return -1;
    { const int c = n0 - 12320, n = c >> 11, ch = c & 2047; return 12288 + 256 * (ch >> 7) + 128 * n + (ch & 127); }
}

template <int W> struct ConvRaw { static constexpr int CG = W / 8, RB = NT / CG, RPT = 128 / RB; u32x4 r[RPT + 3]; };
template <int W>
__device__ __forceinline__ void stage_conv_load(ConvRaw<W>& raw, const bf16_t* xbc, int tok0, int cidx, int col0, int tid) {
    constexpr int CG = ConvRaw<W>::CG, RPT = ConvRaw<W>::RPT;
    const int cgi = tid % CG, rb = tid / CG, r0 = rb * RPT;
    const bf16_t* src = xbc + (size_t)tok0 * 4096 + col0 + cgi * 8;
#pragma unroll
    for (int i = 0; i < RPT + 3; ++i) { const int r = r0 - 3 + i;
        if (cidx == 0 && r < 0) raw.r[i] = (u32x4){0u, 0u, 0u, 0u}; else raw.r[i] = __builtin_nontemporal_load((const u32x4*)(src + (ptrdiff_t)r * 4096)); }
}
template <int W>
__device__ __forceinline__ void stage_conv_finish(const ConvRaw<W>& raw, LAS unsigned char* dst, int stride, int col0, const float* conv_w, const float* conv_b, const LAS float* scale, int tid, bf16_t* gdst = nullptr, int gstride = 0) {
    constexpr int CG = ConvRaw<W>::CG, RPT = ConvRaw<W>::RPT;
    const int cgi = tid % CG, rb = tid / CG, r0 = rb * RPT, ch0 = col0 + cgi * 8;
    float w[4][8], bias[8], h0[8], h1[8], h2[8];
#pragma unroll
    for (int k = 0; k < 4; ++k) { const f32x4 a = *(const f32x4*)(conv_w + k * 4096 + ch0), b = *(const f32x4*)(conv_w + k * 4096 + ch0 + 4);
#pragma unroll
        for (int j = 0; j < 4; ++j) { w[k][j] = a[j]; w[k][4 + j] = b[j]; } }
    { const f32x4 a = *(const f32x4*)(conv_b + ch0), b = *(const f32x4*)(conv_b + ch0 + 4);
#pragma unroll
      for (int j = 0; j < 4; ++j) { bias[j] = a[j]; bias[4 + j] = b[j]; } }
#define UNPK(v_, o) do { o[0] = bflo(v_.x); o[1] = bfhi(v_.x); o[2] = bflo(v_.y); o[3] = bfhi(v_.y); o[4] = bflo(v_.z); o[5] = bfhi(v_.z); o[6] = bflo(v_.w); o[7] = bfhi(v_.w); } while (0)
    UNPK(raw.r[0], h0); UNPK(raw.r[1], h1); UNPK(raw.r[2], h2);
#pragma unroll
    for (int i = 0; i < RPT; ++i) {
        float cur[8], o[8]; UNPK(raw.r[3 + i], cur);
        float sc = 1.0f; if (scale) sc = scale[(cgi >> 3) * 128 + r0 + i];
#pragma unroll
        for (int j = 0; j < 8; ++j) { float v = bias[j] + w[0][j] * h0[j] + w[1][j] * h1[j] + w[2][j] * h2[j] + w[3][j] * cur[j]; o[j] = silu_f(v) * sc; h0[j] = h1[j]; h1[j] = h2[j]; h2[j] = cur[j]; }
        u32x4 pk; pk.x = cvt_pk_bf16(o[0], o[1]); pk.y = cvt_pk_bf16(o[2], o[3]); pk.z = cvt_pk_bf16(o[4], o[5]); pk.w = cvt_pk_bf16(o[6], o[7]);
        { LAS unsigned char* q_ = dst + (r0 + i) * stride + (32 * (cgi >> 2) + 4 * (cgi & 3)) * 2;
          *(LAS u32x2*)q_ = (u32x2){pk.x, pk.y}; *(LAS u32x2*)(q_ + 32) = (u32x2){pk.z, pk.w}; }
        if (gdst) __builtin_nontemporal_store(pk, (u32x4*)(gdst + (size_t)(r0 + i) * gstride + cgi * 8));
    }
#undef UNPK
}
__device__ __forceinline__ float chunk_prefix(LAS float* adt, LAS float* ac, const float* DT, const float* a_log, int tok0, int g, int tid) {
    const int k = tid >> 7, l = tid & 127, h = g * 4 + k, lane = tid & 63;
    const float dtv = DT[(size_t)h * M_TOK + tok0 + l];
    const float a = -expf(a_log[h]);
    float s = dtv * a;
#pragma unroll
    for (int o = 1; o < 64; o <<= 1) { const float t = __shfl_up(s, o); if (lane >= o) s += t; }
    if (lane == 63) adt[tid >> 6] = s;
    __syncthreads();
    if (l >= 64) s += adt[(tid >> 6) - 1];
    ac[k * 128 + l] = s;
    __syncthreads();
    return dtv;
}

constexpr int XS_STRIDE = 528, CB_STRIDE = 272;

__device__ __forceinline__ void own_barrier(unsigned* bar, unsigned target) {
    if (threadIdx.x == 0) {
        __hip_atomic_fetch_add(bar, 1u, __ATOMIC_RELAXED, __HIP_MEMORY_SCOPE_AGENT);
        const unsigned long long t0 = __builtin_amdgcn_s_memrealtime();
        while (__hip_atomic_load(bar, __ATOMIC_RELAXED, __HIP_MEMORY_SCOPE_AGENT) < target) {
            __builtin_amdgcn_s_sleep(2);
            if (__builtin_amdgcn_s_memrealtime() - t0 > 200000000ull) break;
        }
    }
    __syncthreads();
}
#define GRID_SYNC(i) do { asm volatile("s_waitcnt vmcnt(0) lgkmcnt(0)" ::: "memory"); grid.sync(); \
    __builtin_amdgcn_fence(__ATOMIC_ACQUIRE, "agent"); asm volatile("s_waitcnt vmcnt(0)" ::: "memory"); __syncthreads(); STAMP(i); } while (0)
#ifdef SPIN_PHASE
#define STAMP(i) do { if (bx == 0 && tid == 0) { ((unsigned long long*)(BAR + 16))[i] = __builtin_amdgcn_s_memrealtime(); } } while (0)
#else
#define STAMP(i) do { } while (0)
#endif
#ifdef SPIN_SUB
#define SUBSTAMP(i) do { if (bx == 0 && tid == 0 && j == 0) ((unsigned long long*)(BAR + 16))[16 + (i)] = __builtin_amdgcn_s_memrealtime(); } while (0)
#else
#define SUBSTAMP(i) do { } while (0)
#endif
__global__ void __launch_bounds__(NT, 2) fwd_megakernel(Args A) {
    extern __shared__ __attribute__((aligned(16))) unsigned char lds_raw[];
    LAS unsigned char* lds = (LAS unsigned char*)lds_raw;
    const unsigned lds_u32 = (unsigned)(size_t)lds_raw;
    cg::grid_group grid = cg::this_grid();
    const int tid = threadIdx.x, lane = tid & 63, wave = __builtin_amdgcn_readfirstlane(tid >> 6), fr = lane & 15, fq = lane >> 4;
    const int G = gridDim.x, bx = blockIdx.x;
    const int gw = bx * NWAVES + wave, NGW = G * NWAVES;
    unsigned char* ws = A.ws;
    bf16_t* WinT = (bf16_t*)A.out; bf16_t* H = (bf16_t*)((unsigned char*)A.out + 64 * MiB);
    bf16_t* STATES = (bf16_t*)A.out;
    bf16_t* WdtT = (bf16_t*)(ws + WS_WDT); bf16_t* WsB = (bf16_t*)(ws + WS_WSB); float* STATS = (float*)(ws + WS_STATS); float* SSQ = (float*)(ws + WS_SSQ);
    float* CD = (float*)(ws + WS_CD); float* DT = (float*)(ws + WS_DT); unsigned* BAR = (unsigned*)(ws + WS_BAR); unsigned bar_epoch = 0;
    bf16_t* WbT = (bf16_t*)(ws + WS_WB); bf16_t* WoT = (bf16_t*)(ws + WS_WO); bf16_t* YAB = (bf16_t*)(ws + WS_YAB); bf16_t* V = (bf16_t*)(ws + WS_V);
    bf16_t* PREV = (bf16_t*)(ws + WS_V); bf16_t* MERGED = (bf16_t*)(ws + WS_V);
    bf16_t* CC = (bf16_t*)(ws + WS_CC); bf16_t* YD = (bf16_t*)((unsigned char*)A.out + 64 * MiB);
    bf16_t* XBC = (bf16_t*)(ws + WS_XBC); bf16_t* RG = (bf16_t*)(ws + WS_R); bf16_t* GB = (bf16_t*)(ws + WS_GB);

    STAMP(0);
    if constexpr ((PH_MASK >> 0) & 1)
    {
        LAS float* scr = (LAS float*)(lds + wave * 16640);
        constexpr int I_IN = 32 * 256, I_B = 32 * 32, I_O = 32 * 32, NITEMS = I_IN + 2 * I_B + I_O;
        auto item_of = [&](int it) -> TItem {
            TItem t; int r = it;
            if (r < I_IN) { const int kb = r >> 8, nb = r & 255, n0 = nb < 192 ? 64 * nb : 12320 + 64 * (nb - 192);
                t.src = A.w_in + (size_t)(64 * kb) * NIN + n0; t.ldw = NIN; t.dst = WinT + (size_t)proj_row(n0) * 2048 + 64 * kb; t.ldd = 2048; return t; }
            r -= I_IN;
            if (r < 2 * I_B) { const int nbr = r / I_B, rr = r % I_B, kb = rr >> 5, nb = rr & 31;
                t.src = A.w_branch + (size_t)nbr * 2048 * 2048 + (size_t)(64 * kb) * 2048 + 64 * nb; t.ldw = 2048; t.dst = WbT + (size_t)(64 * nb) * 4096 + nbr * 2048 + 64 * kb; t.ldd = 4096; return t; }
            r -= 2 * I_B;
            { const int kb = r >> 5, nb = r & 31; t.src = A.w_out + (size_t)(64 * kb) * 2048 + 64 * nb; t.ldw = 2048; t.dst = WoT + (size_t)(64 * nb) * 2048 + 64 * kb; t.ldd = 2048; return t; }
        };
        {
            f32x4 va[16], vb[16]; int it = gw; TItem ta, tb;
            if (it < NITEMS) { ta = item_of(it); titem_load(ta, va, lane); }
            while (it < NITEMS) {
                const int it2 = it + NGW, it3 = it2 + NGW;
                if (it2 < NITEMS) { tb = item_of(it2); titem_load(tb, vb, lane); }
                titem_finish(ta, va, scr, lane);
                if (it3 < NITEMS) { ta = item_of(it3); titem_load(ta, va, lane); }
                if (it2 < NITEMS) titem_finish(tb, vb, scr, lane);
                it = it3;
            }
        }
        for (int r = gw; r < 32; r += NGW) transpose_item(A.w_in, NIN, 2048, 64 * r, 12288, WdtT, scr, lane);
        for (int i = bx * NT + tid; i < 8 * 128 * 128; i += G * NT) { const int t = (i >> 7) & 127, s = i & 127; const float v = (s <= t) ? A.w_sp[i] : 0.f; WsB[i] = (bf16_t)(cvt_pk_bf16(v, 0.f) & 0xffffu); }
        for (int i = bx * NT + tid; i < 2 * M_TOK; i += G * NT) STATS[i] = 0.f;
        for (int i = bx * NT + tid; i < M_TOK; i += G * NT) SSQ[i] = 0.f;
        for (int m = gw; m < M_TOK; m += 2 * NGW) {
            const int m2 = m + NGW;
            const f32x4* xr = (const f32x4*)(A.x + (size_t)m * DM) + lane; const f32x4* xr2 = (const f32x4*)(A.x + (size_t)m2 * DM) + lane; const f32x4* wr4 = (const f32x4*)A.norm_w + lane;
            f32x4 v[8], v2[8]; float s = 0.f, s2 = 0.f;
#pragma unroll
            for (int j = 0; j < 8; ++j) { v[j] = __builtin_nontemporal_load(xr + 64 * j); v2[j] = __builtin_nontemporal_load(xr2 + 64 * j); }
#pragma unroll
            for (int j = 0; j < 8; ++j) { s += (v[j][0] * v[j][0] + v[j][1] * v[j][1]) + (v[j][2] * v[j][2] + v[j][3] * v[j][3]); s2 += (v2[j][0] * v2[j][0] + v2[j][1] * v2[j][1]) + (v2[j][2] * v2[j][2] + v2[j][3] * v2[j][3]); }
            const float rstd = 1.0f / sqrtf(wave_sum(s) * (1.0f / DM) + EPS), rstd2 = 1.0f / sqrtf(wave_sum(s2) * (1.0f / DM) + EPS);
            u32x2* o8 = (u32x2*)(H + (size_t)m * DM) + lane; u32x2* o82 = (u32x2*)(H + (size_t)m2 * DM) + lane;
#pragma unroll
            for (int j = 0; j < 8; ++j) { const f32x4 w4 = wr4[64 * j];
                u32x2 o; o.x = cvt_pk_bf16(v[j][0] * rstd * w4[0], v[j][1] * rstd * w4[1]); o.y = cvt_pk_bf16(v[j][2] * rstd * w4[2], v[j][3] * rstd * w4[3]); o8[64 * j] = o;
                u32x2 o2; o2.x = cvt_pk_bf16(v2[j][0] * rstd2 * w4[0], v2[j][1] * rstd2 * w4[1]); o2.y = cvt_pk_bf16(v2[j][2] * rstd2 * w4[2], v2[j][3] * rstd2 * w4[3]); o82[64 * j] = o2; }
        }
    }
    GRID_SYNC(1);

    if constexpr ((PH_MASK >> 1) & 1)
    {
        pg8::Gemm g{H, WinT, M_TOK, NPROJ, DM, DM}; pg8::StaticOrder S; S.init(M_TOK, NPROJ, G, bx, WGM_P1);
        EpiProj E{YAB, V, XBC, RG, GB, STATS, A.b_gate};
        pg8::gemm_phase<EpiProj, pg8::StaticOrder, true, true>(lds, g, S, E);
        {
            constexpr int WROW = 4112;
#pragma unroll
            for (int i = 0; i < 16; ++i) { const int row = 2 * i + (tid >> 8), ch = tid & 255;
                *(LAS u32x4*)(lds + row * WROW + ch * 16) = *(const u32x4*)(WdtT + (size_t)row * DM + ch * 8); }
            __syncthreads();
            for (int t0 = bx * 4; t0 < M_TOK / 16; t0 += G * 4) {
                const int t = t0 + (wave >> 1), kh = wave & 1;
                f32x4 acc0 = {0.f, 0.f, 0.f, 0.f}, acc1 = {0.f, 0.f, 0.f, 0.f};
                const bf16_t* ap = H + (size_t)(16 * t + fr) * DM + 8 * fq + kh * 1024;
                const LAS unsigned char* bp = lds + fr * WROW + (8 * fq + kh * 1024) * 2;
#pragma unroll 16
                for (int ks = 0; ks < 32; ++ks) {
                    const bf16x8 fa = *(const bf16x8*)(ap + 32 * ks), fb0 = *(const LAS bf16x8*)(bp + 64 * ks), fb1 = *(const LAS bf16x8*)(bp + 16 * WROW + 64 * ks);
                    acc0 = __builtin_amdgcn_mfma_f32_16x16x32_bf16(fb0, fa, acc0, 0, 0, 0);
                    acc1 = __builtin_amdgcn_mfma_f32_16x16x32_bf16(fb1, fa, acc1, 0, 0, 0);
                }
                LAS f32x4* xch = (LAS f32x4*)(lds + 32 * WROW) + (wave >> 1) * 128 + lane * 2;
                if (kh) { xch[0] = acc0; xch[1] = acc1; }
                __syncthreads();
                if (!kh) {
                    acc0 += xch[0]; acc1 += xch[1];
                    const f32x4 bb0 = *(const f32x4*)(A.dt_bias + 4 * fq), bb1 = *(const f32x4*)(A.dt_bias + 16 + 4 * fq);
                    f32x4 o0, o1;
#pragma unroll
                    for (int j = 0; j < 4; ++j) { const float v0 = acc0[j] + bb0[j], v1 = acc1[j] + bb1[j];
                        o0[j] = fmaxf(v0, 0.f) + log1pf(expf(-fabsf(v0))); o1[j] = fmaxf(v1, 0.f) + log1pf(expf(-fabsf(v1))); }
                    float* dp = DT + (size_t)(4 * fq) * M_TOK + 16 * t + fr;
#pragma unroll
                    for (int j = 0; j < 4; ++j) { dp[(size_t)j * M_TOK] = o0[j]; dp[(size_t)(16 + j) * M_TOK] = o1[j]; }
                }
                __syncthreads();
            }
        }
    }
    GRID_SYNC(2);

    if constexpr ((PH_MASK >> 2) & 1)
    for (int j = bx; j < 2048; j += G) {
        const int jj = j & 1023, g = jj & 7, bc = jj >> 3, tok0 = bc * 128, cidx = bc & 31;
        int tid = threadIdx.x; asm volatile("" : "+v"(tid));
        const int lane = tid & 63, fr = lane & 15, fq = lane >> 4;
        if (j < 1024) {
            {
                const bf16_t* wsrc = WsB + (size_t)g * 16384;
                u32x4 wv[4];
#pragma unroll
                for (int i = 0; i < 4; ++i) wv[i] = *(const u32x4*)(wsrc + (size_t)(i * 32 + (tid >> 4)) * 128 + (tid & 15) * 8);
#pragma unroll
                for (int i = 0; i < 4; ++i) *(LAS u32x4*)(lds + 67584 + (i * 32 + (tid >> 4)) * CB_STRIDE + (tid & 15) * 16) = wv[i];
            }
            bf16_t* p0 = YAB + (size_t)(tok0 + fr) * 4096 + g * 256 + 32 * wave + 8 * fq;
            u32x4 sv[8]; float bs[8];
#pragma unroll
            for (int mt = 0; mt < 8; ++mt) { bs[mt] = A.b_sp[g * 128 + 16 * mt + fr]; sv[mt] = *(const u32x4*)(p0 + (size_t)(16 * mt) * 4096); }
            {
                const int cgi = tid & 31, rb = tid >> 5, d0 = g * 256 + cgi * 8;
                const f32x4 lw0 = *(const f32x4*)(A.ln_w + d0), lw1 = *(const f32x4*)(A.ln_w + d0 + 4), lb0 = *(const f32x4*)(A.ln_b + d0), lb1 = *(const f32x4*)(A.ln_b + d0 + 4);
#pragma unroll
                for (int i = 0; i < 8; ++i) {
                    const int r = rb * 8 + i, tok = tok0 + r;
                    const float2 st2 = *(const float2*)(STATS + 2 * tok); const float mean = st2.x * (1.0f / 2048.0f), var = st2.y * (1.0f / 2048.0f) - mean * mean, rstd = 1.0f / sqrtf(fmaxf(var, 0.f) + EPS);
                    const u32x4 v = __builtin_nontemporal_load((const u32x4*)(V + (size_t)tok * 2048 + d0));
                    u32x4 pk;
                    pk.x = cvt_pk_bf16((bflo(v.x) - mean) * rstd * lw0[0] + lb0[0], (bfhi(v.x) - mean) * rstd * lw0[1] + lb0[1]);
                    pk.y = cvt_pk_bf16((bflo(v.y) - mean) * rstd * lw0[2] + lb0[2], (bfhi(v.y) - mean) * rstd * lw0[3] + lb0[3]);
                    pk.z = cvt_pk_bf16((bflo(v.z) - mean) * rstd * lw1[0] + lb1[0], (bfhi(v.z) - mean) * rstd * lw1[1] + lb1[1]);
                    pk.w = cvt_pk_bf16((bflo(v.w) - mean) * rstd * lw1[2] + lb1[2], (bfhi(v.w) - mean) * rstd * lw1[3] + lb1[3]);
                    { LAS unsigned char* q_ = lds + r * XS_STRIDE + (32 * (cgi >> 2) + 4 * (cgi & 3)) * 2; *(LAS u32x2*)q_ = (u32x2){pk.x, pk.y}; *(LAS u32x2*)(q_ + 32) = (u32x2){pk.z, pk.w}; }
                }
            }
            __syncthreads();
            f32x4 acc[8][2];
#pragma unroll
            for (int mt = 0; mt < 8; ++mt) { acc[mt][0] = (f32x4){0.f, 0.f, 0.f, 0.f}; acc[mt][1] = (f32x4){0.f, 0.f, 0.f, 0.f}; }
            const unsigned tra = lds_u32 + (8 * fq + (fr >> 2)) * XS_STRIDE + (32 * wave + 4 * (lane & 3)) * 2;
#pragma unroll
            for (int ks = 0; ks < 4; ++ks) {
                bf16x8 fn0, fn1; tr_frag2<4 * XS_STRIDE, 32>(tra + 32 * ks * XS_STRIDE, fn0, fn1);
#pragma unroll
                for (int mt = 2 * ks; mt < 8; ++mt) {
                    const bf16x8 fm = *(const LAS bf16x8*)(lds + 67584 + (16 * mt + fr) * CB_STRIDE + (32 * ks + 8 * fq) * 2);
                    acc[mt][0] = __builtin_amdgcn_mfma_f32_16x16x32_bf16(fn0, fm, acc[mt][0], 0, 0, 0);
                    acc[mt][1] = __builtin_amdgcn_mfma_f32_16x16x32_bf16(fn1, fm, acc[mt][1], 0, 0, 0);
                }
            }
            {
#pragma unroll
                for (int mt = 0; mt < 8; ++mt) { const f32x4 a0 = acc[mt][0], a1 = acc[mt][1]; const u32x4 s4 = sv[mt]; const float b = bs[mt];
                    u32x4 o; o.x = cvt_pk_bf16(bflo(s4.x) * (a0[0] + b), bfhi(s4.x) * (a0[1] + b)); o.y = cvt_pk_bf16(bflo(s4.y) * (a0[2] + b), bfhi(s4.y) * (a0[3] + b));
                    o.z = cvt_pk_bf16(bflo(s4.z) * (a1[0] + b), bfhi(s4.z) * (a1[1] + b)); o.w = cvt_pk_bf16(bflo(s4.w) * (a1[2] + b), bfhi(s4.w) * (a1[3] + b));
                    *(u32x4*)(p0 + (size_t)(16 * mt) * 4096) = o; }
            }
            __syncthreads();
        } else {
            LAS float* ac = (LAS float*)(lds + 137216); LAS float* dtl = ac + 512; LAS float* adt = dtl + 512; LAS float* wg = adt + 512;
            ConvRaw<128> rc, rbb; ConvRaw<256> rx;
            stage_conv_load<128>(rc, XBC, tok0, cidx, 3072 + g * 128, tid); stage_conv_load<128>(rbb, XBC, tok0, cidx, 2048 + g * 128, tid); stage_conv_load<256>(rx, XBC, tok0, cidx, g * 256, tid);
            { const float dtv = chunk_prefix(adt, ac, DT, A.a_log, tok0, g, tid); dtl[tid] = dtv;
              const int k = tid >> 7, l_ = tid & 127; const float aend = ac[k * 128 + 127]; wg[tid] = expf(aend - ac[tid]) * dtv; if (l_ == 127) CD[bc * 32 + g * 4 + k] = expf(aend); }
            stage_conv_finish<128>(rc, lds, CB_STRIDE, 3072 + g * 128, A.conv_w, A.conv_b, nullptr, tid, CC + (size_t)tok0 * 1024 + g * 128, 1024);
            stage_conv_finish<128>(rbb, lds + 34816, CB_STRIDE, 2048 + g * 128, A.conv_w, A.conv_b, nullptr, tid);
            stage_conv_finish<256>(rx, lds + 69632, XS_STRIDE, g * 256, A.conv_w, A.conv_b, nullptr, tid);
            __syncthreads();
            const int l = 16 * wave + fr;
            f32x4 cb[8];
            {
                bf16x8 fc[4];
#pragma unroll
                for (int ks = 0; ks < 4; ++ks) fc[ks] = *(const LAS bf16x8*)(lds + l * CB_STRIDE + (32 * ks + 8 * fq) * 2);
#pragma unroll
                for (int nt = 0; nt < 8; ++nt) {
                    cb[nt] = (f32x4){0.f, 0.f, 0.f, 0.f};
                    if (nt <= wave) {
#pragma unroll
                        for (int ks = 0; ks < 4; ++ks) { const bf16x8 fb = *(const LAS bf16x8*)(lds + 34816 + (16 * nt + fr) * CB_STRIDE + (32 * ks + 8 * fq) * 2);
                            cb[nt] = __builtin_amdgcn_mfma_f32_16x16x32_bf16(fb, fc[ks], cb[nt], 0, 0, 0); }
                    }
                }
            }
            {
                const int k = wave >> 1, ph = wave & 1;
                f32x4 acc[2][8];
#pragma unroll
                for (int mt = 0; mt < 2; ++mt)
#pragma unroll
                    for (int nt = 0; nt < 8; ++nt) acc[mt][nt] = (f32x4){0.f, 0.f, 0.f, 0.f};
                const unsigned xa = lds_u32 + 69632 + (8 * fq + (fr >> 2)) * XS_STRIDE + (k * 64 + 32 * ph + 4 * (lane & 3)) * 2;
                const unsigned ba = lds_u32 + 34816 + (8 * fq + (fr >> 2)) * CB_STRIDE + (4 * (lane & 3)) * 2;
#pragma unroll
                for (int ks = 0; ks < 4; ++ks) {
                    bf16x8 fm0, fm1; tr_frag2<4 * XS_STRIDE, 32>(xa + 32 * ks * XS_STRIDE, fm0, fm1);
                    const f32x4 w0 = *(const LAS f32x4*)(wg + k * 128 + 32 * ks + 8 * fq), w1 = *(const LAS f32x4*)(wg + k * 128 + 32 * ks + 8 * fq + 4);
                    const float wv[8] = {w0[0], w0[1], w0[2], w0[3], w1[0], w1[1], w1[2], w1[3]};
                    bf16x8 sm0, sm1;
#pragma unroll
                    for (int e = 0; e < 8; e += 2) {
                        const unsigned a0 = cvt_pk_bf16(bf2f((unsigned short)fm0[e]) * wv[e], bf2f((unsigned short)fm0[e + 1]) * wv[e + 1]);
                        const unsigned a1 = cvt_pk_bf16(bf2f((unsigned short)fm1[e]) * wv[e], bf2f((unsigned short)fm1[e + 1]) * wv[e + 1]);
                        sm0[e] = (short)(a0 & 0xffffu); sm0[e + 1] = (short)(a0 >> 16); sm1[e] = (short)(a1 & 0xffffu); sm1[e + 1] = (short)(a1 >> 16);
                    }
#pragma unroll
                    for (int nq = 0; nq < 2; ++nq) {
                        bf16x8 fn[4]; tr_frag4<4 * CB_STRIDE, 32>(ba + 32 * ks * CB_STRIDE + 128 * nq, fn[0], fn[1], fn[2], fn[3]);
#pragma unroll
                        for (int i = 0; i < 4; ++i) {
                            acc[0][4 * nq + i] = __builtin_amdgcn_mfma_f32_16x16x32_bf16(fn[i], sm0, acc[0][4 * nq + i], 0, 0, 0);
                            acc[1][4 * nq + i] = __builtin_amdgcn_mfma_f32_16x16x32_bf16(fn[i], sm1, acc[1][4 * nq + i], 0, 0, 0);
                        }
                    }
                }
                bf16_t* sp = STATES + ((size_t)(bc * 8 + g) * 4096 + (size_t)wave * 512 + lane) * 8;
#pragma unroll
                for (int mt = 0; mt < 2; ++mt)
#pragma unroll
                    for (int q = 0; q < 4; ++q) { const f32x4 a0 = acc[mt][2 * q], a1 = acc[mt][2 * q + 1];
                        u32x4 o; o.x = cvt_pk_bf16(a0[0], a0[1]); o.y = cvt_pk_bf16(a0[2], a0[3]); o.z = cvt_pk_bf16(a1[0], a1[1]); o.w = cvt_pk_bf16(a1[2], a1[3]);
                        __builtin_nontemporal_store(o, (u32x4*)(sp + (size_t)((mt * 4 + q) * 64) * 8)); }
            }
            __syncthreads();
            LAS unsigned char* sw = lds + 34816 + wave * (16 * CB_STRIDE);
            bf16_t* ydp = YD + ((size_t)(jj * 8 + wave) * 8 * 64 + lane) * 8;
#pragma unroll
            for (int k = 0; k < 4; ++k) {
                const int h = g * 4 + k; const float al = ac[k * 128 + l], dsk = A.d_skip[h];
#pragma unroll
                for (int nt = 0; nt < 8; ++nt) {
                    float sv[4];
#pragma unroll
                    for (int r = 0; r < 4; ++r) { const int s = 16 * nt + 4 * fq + r;
                        float v = (s <= l) ? cb[nt][r] * __expf(al - ac[k * 128 + s]) * dtl[k * 128 + s] : 0.f;
                        if (s == l) v += dsk; sv[r] = v; }
                    u32x2 o; o.x = cvt_pk_bf16(sv[0], sv[1]); o.y = cvt_pk_bf16(sv[2], sv[3]);
                    *(LAS u32x2*)(sw + fr * CB_STRIDE + (16 * nt + 4 * fq) * 2) = o;
                    if (nt & 1) asm volatile("" ::: "memory");
                }
                asm volatile("s_waitcnt lgkmcnt(0)" ::: "memory");
                f32x4 ay[4];
#pragma unroll
                for (int pt = 0; pt < 4; ++pt) ay[pt] = (f32x4){0.f, 0.f, 0.f, 0.f};
                const unsigned xa = lds_u32 + 69632 + (8 * fq + (fr >> 2)) * XS_STRIDE + (k * 64 + 4 * (lane & 3)) * 2;
#pragma unroll
                for (int ks = 0; ks < 4; ++ks) {
                    if (ks <= (wave >> 1)) {
                        const bf16x8 fs = *(const LAS bf16x8*)(sw + fr * CB_STRIDE + (32 * ks + 8 * fq) * 2);
                        bf16x8 fx[4]; tr_frag4<4 * XS_STRIDE, 32>(xa + 32 * ks * XS_STRIDE, fx[0], fx[1], fx[2], fx[3]);
#pragma unroll
                        for (int pt = 0; pt < 4; ++pt) ay[pt] = __builtin_amdgcn_mfma_f32_16x16x32_bf16(fx[pt], fs, ay[pt], 0, 0, 0);
                    }
                }
#pragma unroll
                for (int q = 0; q < 2; ++q) { u32x4 o; o.x = cvt_pk_bf16(ay[2 * q][0], ay[2 * q][1]); o.y = cvt_pk_bf16(ay[2 * q][2], ay[2 * q][3]); o.z = cvt_pk_bf16(ay[2 * q + 1][0], ay[2 * q + 1][1]); o.w = cvt_pk_bf16(ay[2 * q + 1][2], ay[2 * q + 1][3]); __builtin_nontemporal_store(o, (u32x4*)(ydp + (size_t)(k * 2 + q) * 512)); }
                __builtin_amdgcn_sched_barrier(0);
                asm volatile("s_waitcnt lgkmcnt(0)" ::: "memory");
            }
            __syncthreads();
        }
    }
    GRID_SYNC(3);

    if constexpr ((PH_MASK >> 3) & 1)
    for (int blk = bx; blk < 256; blk += G) {
        const int b = blk >> 6; const unsigned o8 = (unsigned)(blk & 63) * 512u + (unsigned)tid; const int h = (int)(o8 >> 10);
        const bf16_t* sbase = STATES + (size_t)(b * 32) * 262144; bf16_t* pbase = PREV + (size_t)(b * 32) * 262144;
        const unsigned voff = o8 * 8u;
        f32x4 h0 = {0.f, 0.f, 0.f, 0.f}, h1 = {0.f, 0.f, 0.f, 0.f};
#pragma unroll 1
        for (int cb0 = 0; cb0 < 32; cb0 += 16) {
            const bf16_t* sb = sbase + (size_t)cb0 * 262144; bf16_t* pb = pbase + (size_t)cb0 * 262144;
            u32x4 sv[16]; float cdv[16];
#pragma unroll
            for (int c = 0; c < 16; ++c) { sv[c] = __builtin_nontemporal_load((const u32x4*)(sb + (size_t)c * 262144 + voff)); cdv[c] = CD[(b * 32 + cb0 + c) * 32 + h]; }
#pragma unroll
            for (int c = 0; c < 16; ++c) {
                u32x4 o; o.x = cvt_pk_bf16(h0[0], h0[1]); o.y = cvt_pk_bf16(h0[2], h0[3]); o.z = cvt_pk_bf16(h1[0], h1[1]); o.w = cvt_pk_bf16(h1[2], h1[3]);
                __builtin_nontemporal_store(o, (u32x4*)(pb + (size_t)c * 262144 + voff));
                const f32x4 s0 = {bflo(sv[c].x), bfhi(sv[c].x), bflo(sv[c].y), bfhi(sv[c].y)}, s1 = {bflo(sv[c].z), bfhi(sv[c].z), bflo(sv[c].w), bfhi(sv[c].w)};
                h0 = h0 * cdv[c] + s0; h1 = h1 * cdv[c] + s1;
            }
        }
    }
    GRID_SYNC(4);

    if constexpr ((PH_MASK >> 4) & 1)
    for (int j = bx; j < 1024; j += G) {
        const int g = j & 7, bc = j >> 3, tok0 = bc * 128;
        int tid = threadIdx.x; asm volatile("" : "+v"(tid));
        const int lane = tid & 63, fr = lane & 15, fq = lane >> 4;
        LAS float* ac = (LAS float*)lds; LAS float* adt = ac + 512;
        const int l = 16 * wave + fr;
        bf16x8 fc[4];
#pragma unroll
        for (int ks = 0; ks < 4; ++ks) fc[ks] = *(const bf16x8*)(CC + (size_t)(tok0 + l) * 1024 + g * 128 + 32 * ks + 8 * fq);
        {
            const bf16_t* pg = PREV + (size_t)(bc * 8 + g) * 4096 * 8;
            u32x4 pv[8];
#pragma unroll
            for (int i = 0; i < 8; ++i) pv[i] = __builtin_nontemporal_load((const u32x4*)(pg + ((size_t)i * 512 + tid) * 8));
            const int mt_ = (tid >> 8) & 1, q_ = (tid >> 6) & 3, fr_ = tid & 15, fq_ = (tid >> 4) & 3;
#pragma unroll
            for (int i = 0; i < 8; ++i) { const int row = (i >> 1) * 64 + 32 * (i & 1) + 8 * (fr_ >> 2) + 4 * mt_ + (fr_ & 3);
                *(LAS u32x4*)(lds + 4096 + row * CB_STRIDE + (32 * q_ + 8 * fq_) * 2) = pv[i]; }
        }
        (void)chunk_prefix(adt, ac, DT, A.a_log, tok0, g, tid);
        f32x4 y[4][4];
        float ss = 0.f;
        bf16_t* zp = YAB + (size_t)(tok0 + l) * 4096 + 2048 + g * 256 + 8 * fq;
        const bf16_t* ydp = YD + ((size_t)(j * 8 + wave) * 8 * 64 + lane) * 8;
        const int prow0 = pg8::perm32(fr), prow1 = pg8::perm32(16 + fr);
#pragma unroll
        for (int k = 0; k < 4; ++k) {
            const int h = g * 4 + k; const float ea = __expf(ac[k * 128 + l]);
            const LAS unsigned char* pp = lds + 4096 + (k * 64) * CB_STRIDE + 16 * fq;
            f32x4 ao[4];
#pragma unroll
            for (int pt = 0; pt < 4; ++pt) ao[pt] = (f32x4){0.f, 0.f, 0.f, 0.f};
            u32x4 zv4[2], yv4[2];
#pragma unroll
            for (int q = 0; q < 2; ++q) { zv4[q] = *(const u32x4*)(zp + k * 64 + q * 32); yv4[q] = __builtin_nontemporal_load((const u32x4*)(ydp + (size_t)(k * 2 + q) * 512)); }
#pragma unroll
            for (int ks = 0; ks < 4; ++ks) {
                bf16x8 fpw[4];
#pragma unroll
                for (int pt = 0; pt < 4; ++pt) fpw[pt] = *(const LAS bf16x8*)(pp + (32 * (pt >> 1) + ((pt & 1) ? prow1 : prow0)) * CB_STRIDE + 64 * ks);
#pragma unroll
                for (int pt = 0; pt < 4; ++pt) ao[pt] = __builtin_amdgcn_mfma_f32_16x16x32_bf16(fpw[pt], fc[ks], ao[pt], 0, 0, 0);
            }
#pragma unroll
            for (int pt = 0; pt < 4; ++pt) { const u32x4 z4 = zv4[pt >> 1], y4 = yv4[pt >> 1];
                const unsigned zlo = (pt & 1) ? z4.z : z4.x, zhi = (pt & 1) ? z4.w : z4.y, ylo = (pt & 1) ? y4.z : y4.x, yhi = (pt & 1) ? y4.w : y4.y;
                f32x4 v = ao[pt] * ea; v[0] = (v[0] + bflo(ylo)) * bflo(zlo); v[1] = (v[1] + bfhi(ylo)) * bfhi(zlo); v[2] = (v[2] + bflo(yhi)) * bflo(zhi); v[3] = (v[3] + bfhi(yhi)) * bfhi(zhi);
                ss += (v[0] * v[0] + v[1] * v[1]) + (v[2] * v[2] + v[3] * v[3]); y[k][pt] = v; }
            __builtin_amdgcn_sched_barrier(0);
        }
        ss += __shfl_xor(ss, 16); ss += __shfl_xor(ss, 32);
        const float rstd = 1.0f / sqrtf(ss * (1.0f / 256.0f) + EPS);
        const float* nw = A.ssm_nw + g * 256 + 8 * fq;
        u32x4 ov[4][2];
#pragma unroll
        for (int k = 0; k < 4; ++k)
#pragma unroll
            for (int q = 0; q < 2; ++q) { const f32x4 w0 = *(const f32x4*)(nw + k * 64 + q * 32), w1 = *(const f32x4*)(nw + k * 64 + q * 32 + 4); const f32x4 v0 = y[k][2 * q], v1 = y[k][2 * q + 1];
                ov[k][q].x = cvt_pk_bf16(v0[0] * rstd * w0[0], v0[1] * rstd * w0[1]); ov[k][q].y = cvt_pk_bf16(v0[2] * rstd * w0[2], v0[3] * rstd * w0[3]);
                ov[k][q].z = cvt_pk_bf16(v1[0] * rstd * w1[0], v1[1] * rstd * w1[1]); ov[k][q].w = cvt_pk_bf16(v1[2] * rstd * w1[2], v1[3] * rstd * w1[3]); }
#pragma unroll
        for (int k = 0; k < 4; ++k)
#pragma unroll
            for (int q = 0; q < 2; ++q) *(u32x4*)(zp + k * 64 + q * 32) = ov[k][q];
        __syncthreads();
    }
    GRID_SYNC(5);

    if constexpr ((PH_MASK >> 5) & 1)
    {
        pg8::Gemm g{YAB, WbT, M_TOK, DM, DM, 2 * DM}; SplitKOrder S; S.init(M_TOK, DM, G, bx, WGM_P5);
        EpiMerge E{RG, GB, MERGED};
        pg8::gemm_phase<EpiMerge, SplitKOrder, true, true>(lds, g, S, E);
    }
    GRID_SYNC(6);

    if constexpr ((PH_MASK >> 6) & 1)
    {
        pg8::Gemm g{MERGED, WoT, M_TOK, DM, DM, DM}; pg8::StaticOrder S; S.init(M_TOK, DM, G, bx, WGM_P6);
        EpiAcc E{YAB};
        pg8::gemm_phase<EpiAcc, pg8::StaticOrder, true, true>(lds, g, S, E);
    }
    GRID_SYNC(7);

    if constexpr ((PH_MASK >> 7) & 1)
    for (int m = gw; m < M_TOK; m += 2 * NGW) {
        const int m2 = m + NGW;
        int tid_ = threadIdx.x; asm volatile("" : "+v"(tid_)); const int lane = tid_ & 63;
        const f32x4* xr = (const f32x4*)(A.x + (size_t)m * DM) + lane; const f32x4* xr2 = (const f32x4*)(A.x + (size_t)m2 * DM) + lane;
        const u32x2* ar = (const u32x2*)(YAB + (size_t)m * DM) + lane; const u32x2* ar2 = (const u32x2*)(YAB + (size_t)m2 * DM) + lane;
        const f32x4* wr4 = (const f32x4*)A.fnw + lane;
        f32x4 v[8], v2[8]; u32x2 a[8], a2[8]; float s = 0.f, s2 = 0.f;
#pragma unroll
        for (int j = 0; j < 8; ++j) { v[j] = __builtin_nontemporal_load(xr + 64 * j); v2[j] = __builtin_nontemporal_load(xr2 + 64 * j); a[j] = __builtin_nontemporal_load(ar + 64 * j); a2[j] = __builtin_nontemporal_load(ar2 + 64 * j); }
#pragma unroll
        for (int j = 0; j < 8; ++j) {
            v[j][0] += bflo(a[j].x); v[j][1] += bfhi(a[j].x); v[j][2] += bflo(a[j].y); v[j][3] += bfhi(a[j].y);
            v2[j][0] += bflo(a2[j].x); v2[j][1] += bfhi(a2[j].x); v2[j][2] += bflo(a2[j].y); v2[j][3] += bfhi(a2[j].y);
            s += (v[j][0] * v[j][0] + v[j][1] * v[j][1]) + (v[j][2] * v[j][2] + v[j][3] * v[j][3]); s2 += (v2[j][0] * v2[j][0] + v2[j][1] * v2[j][1]) + (v2[j][2] * v2[j][2] + v2[j][3] * v2[j][3]); }
        const float rstd = 1.0f / sqrtf(wave_sum(s) * (1.0f / DM) + EPS), rstd2 = 1.0f / sqrtf(wave_sum(s2) * (1.0f / DM) + EPS);
        f32x4* orow = (f32x4*)(A.out + (size_t)m * DM) + lane; f32x4* orow2 = (f32x4*)(A.out + (size_t)m2 * DM) + lane;
#pragma unroll
        for (int j = 0; j < 8; ++j) { const f32x4 w4 = wr4[64 * j]; __builtin_nontemporal_store(v[j] * rstd * w4, orow + 64 * j); __builtin_nontemporal_store(v2[j] * rstd2 * w4, orow2 + 64 * j); }
    }
#ifdef SPIN_SUB
    if (bx == 0 && tid == 0) {
        const unsigned long long* st = (const unsigned long long*)(BAR + 16) + 16;
        const unsigned long long d = (st[SPIN_SUB + 1] - st[SPIN_SUB]) * SPIN_MULT, t0 = __builtin_amdgcn_s_memrealtime();
        while (__builtin_amdgcn_s_memrealtime() - t0 < d) __builtin_amdgcn_s_sleep(10);
    }
#endif
#ifdef SPIN_PHASE
    STAMP(8);
    if (bx == 0 && tid == 0) {
        const unsigned long long* st = (const unsigned long long*)(BAR + 16);
        const unsigned long long d = (st[SPIN_PHASE + 1] - st[SPIN_PHASE]) * SPIN_MULT, t0 = __builtin_amdgcn_s_memrealtime();
        while (__builtin_amdgcn_s_memrealtime() - t0 < d) __builtin_amdgcn_s_sleep(10);
    }
#endif
}

extern "C" void kernel_launch(void* const* d_in, const int* in_sizes, int n_in, void* d_out, int out_size, void* d_ws, size_t ws_size, hipStream_t stream) {
    static int grid = 0;
    if (grid == 0) {
        if (n_in != 17 || out_size != M_TOK * DM || ws_size < WS_END) { fprintf(stderr, "kernel_launch: unexpected shapes (n_in %d out %d ws %zu)\n", n_in, out_size, ws_size); grid = -1; return; }
        int dev = 0, cus = 0, per_cu = 0;
        hipGetDevice(&dev); hipDeviceGetAttribute(&cus, hipDeviceAttributeMultiprocessorCount, dev);
        if (hipFuncSetAttribute((const void*)fwd_megakernel, hipFuncAttributeMaxDynamicSharedMemorySize, LDS_BYTES) != hipSuccess) { fprintf(stderr, "kernel_launch: hipFuncSetAttribute failed\n"); grid = -1; return; }
        if (hipOccupancyMaxActiveBlocksPerMultiprocessor(&per_cu, (const void*)fwd_megakernel, NT, LDS_BYTES) != hipSuccess || per_cu < 1) { fprintf(stderr, "kernel_launch: occupancy query says %d\n", per_cu); per_cu = 1; }
        (void)hipGetLastError();
        grid = cus * 1;
    }
    if (grid < 0) return;
    Args a{};
    a.x = (const float*)d_in[0]; a.norm_w = (const float*)d_in[1]; a.w_in = (const float*)d_in[2]; a.b_gate = (const float*)d_in[3]; a.ln_w = (const float*)d_in[4]; a.ln_b = (const float*)d_in[5];
    a.w_sp = (const float*)d_in[6]; a.b_sp = (const float*)d_in[7]; a.conv_w = (const float*)d_in[8]; a.conv_b = (const float*)d_in[9]; a.dt_bias = (const float*)d_in[10]; a.a_log = (const float*)d_in[11];
    a.d_skip = (const float*)d_in[12]; a.ssm_nw = (const float*)d_in[13]; a.w_branch = (const float*)d_in[14]; a.w_out = (const float*)d_in[15]; a.fnw = (const float*)d_in[16];
    a.out = (float*)d_out; a.ws = (unsigned char*)d_ws;
    if (hipMemsetAsync((char*)d_ws + WS_BAR, 0, 256, stream) != hipSuccess) { fprintf(stderr, "kernel_launch: memset failed\n"); return; }
    void* args[] = {&a};
    hipError_t e = hipLaunchCooperativeKernel((const void*)fwd_megakernel, dim3(grid), dim3(NT), args, LDS_BYTES, stream);
    if (e != hipSuccess) fprintf(stderr, "cooperative launch failed: %s (grid %d)\n", hipGetErrorString(e), grid);
}
```

```cpp
#include <hip/hip_runtime.h>
#include <hip/hip_cooperative_groups.h>
#include <cstdio>
#include <cstdint>
namespace cg = cooperative_groups;
namespace pg8 {
#define PG8_LAS __attribute__((address_space(3)))
typedef unsigned short bf16_t;
typedef short bf16x8 __attribute__((ext_vector_type(8)));
typedef float f32x4 __attribute__((ext_vector_type(4)));
typedef unsigned u32x4 __attribute__((ext_vector_type(4)));
constexpr int BM = 256, BK = 64, HALF = 128, HTB = HALF * BK * 2  , STAGE_BYTES = 8 * HTB, NXCD = 8, WGM = 8;

__host__ __device__ __forceinline__ int lds_byte(int r, int c) { const int st = (r >> 4) * 2 + (c >> 5), rr = r & 15, cc = c & 31, ob = rr * 64 + cc * 2; return st * 1024 + (ob ^ (((ob >> 9) & 1) << 5)); }
__host__ __device__ __forceinline__ void stage_rc(int b, int& R, int& C) { const int st = b / 1024, sb = b % 1024, swz = sb ^ (((sb >> 9) & 1) << 5); R = (st >> 1) * 16 + swz / 64; C = (st & 1) * 32 + (swz % 64) / 2; }
__host__ __device__ __forceinline__ int perm32(int rho) { const int n = rho >> 4, i = rho & 15; return 8 * (i >> 2) + 4 * n + (i & 3); }

struct Unit { int pm, pn, kh; };
struct Gemm { const bf16_t* A; const bf16_t* Bt; int M, N, K, ld; };

struct StaticOrder {
    int nM, nN, nwg, G, c, wgm;
    __host__ __device__ void init(int M, int N, int G_, int c_, int wgm_ = WGM) { nM = M / BM; nN = N / BM; nwg = nM * nN; G = G_; c = c_; wgm = wgm_; }
    __host__ __device__ bool next(int i, Unit& u) const {
        const long L = (long)i * G + c; if (L >= nwg) return false;
        int wgid = (int)L; { const int q = nwg / NXCD, r = nwg % NXCD, xcd = wgid % NXCD, off = wgid / NXCD; wgid = (xcd < r ? xcd * (q + 1) : r * (q + 1) + (xcd - r) * q) + off; }
        const int nig = wgm * nN, gid = wgid / nig, fm = gid * wgm, gsz = (nM - fm) < wgm ? (nM - fm) : wgm;
        u.pm = fm + ((wgid % nig) % gsz); u.pn = (wgid % nig) / gsz; u.kh = 0; return true;
    }
    __device__ __forceinline__ void a_ready(const Unit&) const {}
    __device__ __forceinline__ void done(const Unit&) const {}
};
typedef float f32x2_t_ __attribute__((ext_vector_type(2)));
typedef __bf16 bf16x2_t_ __attribute__((ext_vector_type(2)));
__device__ __forceinline__ unsigned cvt_pk_bf16(float lo, float hi) { const f32x2_t_ v = {lo, hi}; const bf16x2_t_ b = __builtin_convertvector(v, bf16x2_t_); return __builtin_bit_cast(unsigned, b); }
template <class Epi, class Sched, bool ALIGN_EPI = false, bool SP2 = false>
__device__ __forceinline__ void gemm_phase(PG8_LAS unsigned char* lds, const Gemm g, const Sched& S, const Epi& E) {
    int tid_ = threadIdx.x; asm volatile("" : "+v"(tid_));
    const int tid = tid_, wid = __builtin_amdgcn_readfirstlane(tid >> 6), lane = tid & 63, wr = wid >> 2, wc = wid & 3, fr = lane & 15, fq = lane >> 4;
    const int K = g.K, nt = K / BK, ld = g.ld;
    unsigned voffA[2], voffB[2];
#pragma unroll
    for (int i = 0; i < 2; ++i) { int R, C; stage_rc(tid * 16 + i * 8192, R, C); const int Rb = Epi::PERM ? ((R & ~31) + perm32(R & 31)) : R;
        voffA[i] = (unsigned)(R * ld + C) * 2u; voffB[i] = (unsigned)(Rb * ld + C) * 2u; }
    const size_t kstep = (size_t)(BK * 2);
    const size_t hstep = (size_t)HALF * ld * 2;
    const size_t tstep = 2 * hstep;
    const unsigned ldsw = (unsigned)wid * 1024u;
    const int aoff = lds_byte(wr * 64 + fr, fq * 8), boff = lds_byte(wc * 32 + fr, fq * 8);
#define PG8_SA(b, h) (((b) * 2 + (h)) * HTB)
#define PG8_SB(b, h) ((4 + (b) * 2 + (h)) * HTB)
#define PG8_STAGE(bufoff, gbase, voff) do { _Pragma("unroll") for (int _i = 0; _i < 2; ++_i) \
        __builtin_amdgcn_global_load_lds((const unsigned*)((const char*)(gbase) + (voff)[_i]), (PG8_LAS unsigned*)(lds + (bufoff) + ldsw + _i * 8192), 16, 0, 0); } while (0)
#define PG8_LDA(dst, b, h) do { _Pragma("unroll") for (int m = 0; m < 4; ++m) _Pragma("unroll") for (int k = 0; k < 2; ++k) dst[m][k] = *(const PG8_LAS bf16x8*)(lds + PG8_SA(b, h) + aoff + m * 2048 + k * 1024); } while (0)
#define PG8_LDB(dst, b, h) do { _Pragma("unroll") for (int n = 0; n < 2; ++n) _Pragma("unroll") for (int k = 0; k < 2; ++k) dst[n][k] = *(const PG8_LAS bf16x8*)(lds + PG8_SB(b, h) + boff + n * 2048 + k * 1024); } while (0)
#define PG8_MMA(ai, bj, At, Bt) do { __builtin_amdgcn_s_setprio(1); _Pragma("unroll") for (int m = 0; m < 4; ++m) _Pragma("unroll") for (int n = 0; n < 2; ++n) _Pragma("unroll") for (int k = 0; k < 2; ++k) \
        acc[ai][bj][m][n] = __builtin_amdgcn_mfma_f32_16x16x32_bf16(Bt[n][k], At[m][k], acc[ai][bj][m][n], 0, 0, 0); __builtin_amdgcn_s_setprio(0); } while (0)
#define PG8_WAIT_V(n) asm volatile("s_waitcnt vmcnt(" #n ")" ::: "memory")
#define PG8_WAIT_L(n) asm volatile("s_waitcnt lgkmcnt(" #n ")" ::: "memory")
#define PG8_BAR __builtin_amdgcn_s_barrier()
#define PG8_SCHED __builtin_amdgcn_sched_barrier(0)
    Unit cur, nxt; int ui = 0;
    if (!S.next(0, cur)) return;
    f32x4 acc[2][2][4][2];
#pragma unroll
    for (int a = 0; a < 2; ++a)
#pragma unroll
        for (int b = 0; b < 2; ++b)
#pragma unroll
            for (int m = 0; m < 4; ++m)
#pragma unroll
                for (int n = 0; n < 2; ++n) acc[a][b][m][n] = (f32x4){0.f, 0.f, 0.f, 0.f};
    bf16x8 At[4][2], B0[2][2], B1[2][2];
    const char* cA = (const char*)g.A + (size_t)cur.pm * tstep + (size_t)cur.kh * K * 2; const char* cB = (const char*)g.Bt + (size_t)cur.pn * tstep + (size_t)cur.kh * K * 2;
    S.a_ready(cur);
    if constexpr (SP2) {
        PG8_STAGE(PG8_SB(0, 0), cB, voffB); PG8_STAGE(PG8_SB(0, 1), cB + hstep, voffB); PG8_STAGE(PG8_SA(0, 0), cA, voffA); PG8_STAGE(PG8_SA(0, 1), cA + hstep, voffA);
        if (wr == 1) PG8_BAR;
        PG8_WAIT_V(2); PG8_BAR;
        PG8_STAGE(PG8_SB(1, 0), cB + kstep, voffB); PG8_STAGE(PG8_SA(1, 0), cA + kstep, voffA); PG8_STAGE(PG8_SB(1, 1), cB + hstep + kstep, voffB);
        PG8_WAIT_V(6); PG8_BAR;
    } else {
        PG8_STAGE(PG8_SB(0, 0), cB, voffB); PG8_STAGE(PG8_SA(0, 0), cA, voffA); PG8_STAGE(PG8_SB(0, 1), cB + hstep, voffB); PG8_STAGE(PG8_SA(0, 1), cA + hstep, voffA);
        if (wr == 1) PG8_BAR;
        PG8_WAIT_V(4); PG8_BAR;
        PG8_STAGE(PG8_SB(1, 0), cB + kstep, voffB); PG8_STAGE(PG8_SA(1, 0), cA + kstep, voffA); PG8_STAGE(PG8_SB(1, 1), cB + hstep + kstep, voffB);
        PG8_WAIT_V(6); PG8_BAR;
    }
    for (;;) {
        const bool has_next = S.next(ui + 1, nxt);
        const char* nA = has_next ? (const char*)g.A + (size_t)nxt.pm * tstep + (size_t)nxt.kh * K * 2 : cA; const char* nB = has_next ? (const char*)g.Bt + (size_t)nxt.pn * tstep + (size_t)nxt.kh * K * 2 : cB;
        for (int t = 0; t < nt; t += 2) {
            const bool last = (t == nt - 2);
            const char* a1 = cA + (size_t)(t + 1) * kstep;
            const char* a2 = last ? nA : cA + (size_t)(t + 2) * kstep; const char* b2 = last ? nB : cB + (size_t)(t + 2) * kstep;
            const char* a3 = a2 + kstep; const char* b3 = b2 + kstep;
            if (last && has_next) S.a_ready(nxt);
            if constexpr (SP2) {
            PG8_LDB(B0, 0, 0); PG8_LDB(B1, 0, 1); PG8_SCHED; PG8_LDA(At, 0, 0); PG8_STAGE(PG8_SA(1, 1), a1 + hstep, voffA);
            PG8_WAIT_V(8); PG8_WAIT_L(0); PG8_BAR; PG8_MMA(0, 0, At, B0); PG8_MMA(0, 1, At, B1); PG8_BAR; PG8_SCHED;
            PG8_LDA(At, 0, 1); PG8_STAGE(PG8_SB(0, 0), b2, voffB); PG8_STAGE(PG8_SB(0, 1), b2 + hstep, voffB); PG8_STAGE(PG8_SA(0, 0), a2, voffA);
            PG8_WAIT_V(8); PG8_WAIT_L(0); PG8_BAR; PG8_MMA(1, 0, At, B0); PG8_MMA(1, 1, At, B1); PG8_BAR; PG8_SCHED;
            PG8_LDB(B0, 1, 0); PG8_LDB(B1, 1, 1); PG8_SCHED; PG8_LDA(At, 1, 0); PG8_STAGE(PG8_SA(0, 1), a2 + hstep, voffA);
            PG8_WAIT_V(8); PG8_WAIT_L(0); PG8_BAR; PG8_MMA(0, 0, At, B0); PG8_MMA(0, 1, At, B1); PG8_BAR; PG8_SCHED;
            PG8_LDA(At, 1, 1); PG8_STAGE(PG8_SB(1, 0), b3, voffB); PG8_STAGE(PG8_SB(1, 1), b3 + hstep, voffB); PG8_STAGE(PG8_SA(1, 0), a3, voffA);
            PG8_WAIT_V(8); PG8_WAIT_L(0); PG8_BAR; PG8_MMA(1, 0, At, B0); PG8_MMA(1, 1, At, B1); PG8_BAR; PG8_SCHED;
            } else {
            PG8_LDB(B0, 0, 0); PG8_SCHED; PG8_LDA(At, 0, 0); PG8_STAGE(PG8_SA(1, 1), a1 + hstep, voffA);
            PG8_WAIT_L(8); PG8_BAR; PG8_WAIT_L(0); PG8_MMA(0, 0, At, B0); PG8_BAR; PG8_SCHED;
            PG8_LDB(B1, 0, 1); PG8_STAGE(PG8_SB(0, 0), b2, voffB);
            PG8_BAR; PG8_WAIT_L(0); PG8_MMA(0, 1, At, B1); PG8_BAR;
            PG8_LDA(At, 0, 1); PG8_STAGE(PG8_SA(0, 0), a2, voffA);
            PG8_BAR; PG8_WAIT_L(0); PG8_MMA(1, 0, At, B0); PG8_BAR; PG8_SCHED;
            PG8_STAGE(PG8_SB(0, 1), b2 + hstep, voffB);
            PG8_WAIT_V(6); PG8_BAR; PG8_MMA(1, 1, At, B1); PG8_BAR;
            PG8_LDB(B0, 1, 0); PG8_SCHED; PG8_LDA(At, 1, 0); PG8_STAGE(PG8_SA(0, 1), a2 + hstep, voffA);
            PG8_WAIT_L(8); PG8_BAR; PG8_WAIT_L(0); PG8_MMA(0, 0, At, B0); PG8_BAR; PG8_SCHED;
            PG8_LDB(B1, 1, 1); PG8_STAGE(PG8_SB(1, 0), b3, voffB);
            PG8_BAR; PG8_WAIT_L(0); PG8_MMA(0, 1, At, B1); PG8_BAR;
            PG8_LDA(At, 1, 1); PG8_STAGE(PG8_SA(1, 0), a3, voffA);
            PG8_BAR; PG8_WAIT_L(0); PG8_MMA(1, 0, At, B0); PG8_BAR; PG8_SCHED;
            PG8_STAGE(PG8_SB(1, 1), b3 + hstep, voffB);
            PG8_WAIT_V(6); PG8_BAR; PG8_MMA(1, 1, At, B1); PG8_BAR;
            }
        }
        if constexpr (ALIGN_EPI) { if (wr == 0) PG8_BAR; }
        if constexpr (!Epi::AFTER_DRAIN) { E(acc, cur, wr, wc, fr, fq); S.done(cur); }
        if (!has_next) break;
        if (!E.keep(cur))
#pragma unroll
        for (int a = 0; a < 2; ++a)
#pragma unroll
            for (int b = 0; b < 2; ++b)
#pragma unroll
                for (int m = 0; m < 4; ++m)
#pragma unroll
                    for (int n = 0; n < 2; ++n) acc[a][b][m][n] = (f32x4){0.f, 0.f, 0.f, 0.f};
        cur = nxt; cA = nA; cB = nB; ++ui;
        if constexpr (ALIGN_EPI) { if (wr == 1) PG8_BAR; }
    }
    PG8_WAIT_V(0);
    if constexpr (!ALIGN_EPI) { if (wr == 0) PG8_BAR; }
    PG8_BAR;
    if constexpr (Epi::AFTER_DRAIN) { E.fused(acc, cur, wr, wc, fr, fq, lds, wid, lane); S.done(cur); }
#undef PG8_SA
#undef PG8_SB
#undef PG8_STAGE
#undef PG8_LDA
#undef PG8_LDB
#undef PG8_MMA
#undef PG8_WAIT_V
#undef PG8_WAIT_L
#undef PG8_BAR
#undef PG8_SCHED
}
}

#define LAS __attribute__((address_space(3)))
using pg8::bf16_t; using pg8::bf16x8; using pg8::f32x4; using pg8::u32x4; using pg8::cvt_pk_bf16;
typedef unsigned u32x2 __attribute__((ext_vector_type(2)));
typedef short s16x4 __attribute__((ext_vector_type(4)));

constexpr int NT = 512, NWAVES = 8;
constexpr int M_TOK = 16384, DM = 2048, SEQ = 4096, NCH = 32, CL_ = 128;
constexpr int NIN = 16416;
constexpr int NPROJ = 16384;
constexpr float EPS = 1e-5f;
constexpr int LDS_BYTES = 147456;
#ifndef WGM_P1
#define WGM_P1 4
#endif
#ifndef WGM_P5
#define WGM_P5 4
#endif
#ifndef WGM_P6
#define WGM_P6 4
#endif
#ifndef PH_MASK
#define PH_MASK 0xFF
#endif

constexpr size_t MiB = 1048576;
constexpr size_t WS_BAR = 3 * MiB + 65536;
constexpr size_t WS_WDT = 0, WS_WSB = 131072, WS_STATS = 393216, WS_SSQ = 524288, WS_CD = 589824, WS_DT = 1 * MiB;
constexpr size_t WS_WB = 4 * MiB, WS_WO = 20 * MiB, WS_YAB = 28 * MiB, WS_V = 156 * MiB, WS_XBC = 220 * MiB, WS_R = 348 * MiB, WS_GB = 412 * MiB, WS_CC = 476 * MiB, WS_END = 508 * MiB;

__device__ __forceinline__ float bf2f(unsigned short u) { return __uint_as_float(((unsigned)u) << 16); }
__device__ __forceinline__ float bflo(unsigned w) { return __uint_as_float(w << 16); }
__device__ __forceinline__ float bfhi(unsigned w) { return __uint_as_float(w & 0xffff0000u); }
__device__ __forceinline__ float silu_f(float v) { return v * __builtin_amdgcn_rcpf(1.0f + __expf(-v)); }
__device__ __forceinline__ float sigmoid_f(float v) { return __builtin_amdgcn_rcpf(1.0f + __expf(-v)); }
__device__ __forceinline__ float wave_sum(float v) {
#pragma unroll
    for (int o = 1; o < 64; o <<= 1) v += __shfl_xor(v, o);
    return v;
}
__device__ __forceinline__ void atomic_addf(float* p, float v) { __hip_atomic_fetch_add(p, v, __ATOMIC_RELAXED, __HIP_MEMORY_SCOPE_AGENT); }

template <int OFF> __device__ __forceinline__ bf16x8 tr_frag(unsigned a) {
    s16x4 lo, hi;
    asm volatile("ds_read_b64_tr_b16 %0, %2\n\tds_read_b64_tr_b16 %1, %2 offset:%3\n\ts_waitcnt lgkmcnt(0)" : "=&v"(lo), "=&v"(hi) : "v"(a), "n"(OFF) : "memory");
    return (bf16x8){lo[0], lo[1], lo[2], lo[3], hi[0], hi[1], hi[2], hi[3]};
}

template <int OFF, int STEP> __device__ __forceinline__ void tr_frag2(unsigned a, bf16x8& f0, bf16x8& f1) {
    s16x4 l0, h0, l1, h1;
    asm volatile("ds_read_b64_tr_b16 %0, %4\n\tds_read_b64_tr_b16 %1, %4 offset:%5\n\tds_read_b64_tr_b16 %2, %4 offset:%6\n\tds_read_b64_tr_b16 %3, %4 offset:%7\n\ts_waitcnt lgkmcnt(0)"
                 : "=&v"(l0), "=&v"(h0), "=&v"(l1), "=&v"(h1) : "v"(a), "n"(OFF), "n"(STEP), "n"(STEP + OFF) : "memory");
    f0 = (bf16x8){l0[0], l0[1], l0[2], l0[3], h0[0], h0[1], h0[2], h0[3]}; f1 = (bf16x8){l1[0], l1[1], l1[2], l1[3], h1[0], h1[1], h1[2], h1[3]};
}
template <int OFF, int STEP> __device__ __forceinline__ void tr_frag4(unsigned a, bf16x8& f0, bf16x8& f1, bf16x8& f2, bf16x8& f3) {
    s16x4 l0, h0, l1, h1, l2, h2, l3, h3;
    asm volatile("ds_read_b64_tr_b16 %0, %8\n\tds_read_b64_tr_b16 %1, %8 offset:%9\n\tds_read_b64_tr_b16 %2, %8 offset:%10\n\tds_read_b64_tr_b16 %3, %8 offset:%11\n\t"
                 "ds_read_b64_tr_b16 %4, %8 offset:%12\n\tds_read_b64_tr_b16 %5, %8 offset:%13\n\tds_read_b64_tr_b16 %6, %8 offset:%14\n\tds_read_b64_tr_b16 %7, %8 offset:%15\n\ts_waitcnt lgkmcnt(0)"
                 : "=&v"(l0), "=&v"(h0), "=&v"(l1), "=&v"(h1), "=&v"(l2), "=&v"(h2), "=&v"(l3), "=&v"(h3)
                 : "v"(a), "n"(OFF), "n"(STEP), "n"(STEP + OFF), "n"(2 * STEP), "n"(2 * STEP + OFF), "n"(3 * STEP), "n"(3 * STEP + OFF) : "memory");
    f0 = (bf16x8){l0[0], l0[1], l0[2], l0[3], h0[0], h0[1], h0[2], h0[3]}; f1 = (bf16x8){l1[0], l1[1], l1[2], l1[3], h1[0], h1[1], h1[2], h1[3]};
    f2 = (bf16x8){l2[0], l2[1], l2[2], l2[3], h2[0], h2[1], h2[2], h2[3]}; f3 = (bf16x8){l3[0], l3[1], l3[2], l3[3], h3[0], h3[1], h3[2], h3[3]};
}

struct Args {
    const float* x; const float* norm_w; const float* w_in; const float* b_gate; const float* ln_w; const float* ln_b; const float* w_sp; const float* b_sp;
    const float* conv_w; const float* conv_b; const float* dt_bias; const float* a_log; const float* d_skip; const float* ssm_nw; const float* w_branch; const float* w_out; const float* fnw;
    float* out; unsigned char* ws;
};

struct EpiProj {
    static constexpr bool PERM = true, AFTER_DRAIN = false;
    __device__ __forceinline__ bool keep(const pg8::Unit&) const { return false; }
    bf16_t* YAB; bf16_t* V; bf16_t* XBC; bf16_t* R; bf16_t* GB; float* stats; const float* b_gate;
    __device__ __forceinline__ void operator()(const f32x4 (&acc)[2][2][4][2], const pg8::Unit& u, int wr, int wc, int fr, int fq) const {
        const int row0 = u.pm * 256 + wr * 64 + fr, pn = u.pn, cl = wc * 32 + 8 * fq;
        if (pn < 16) {
#pragma unroll
            for (int ai = 0; ai < 2; ++ai)
#pragma unroll
                for (int m = 0; m < 4; ++m) {
                    const f32x4 u0 = acc[ai][0][m][0], u1 = acc[ai][0][m][1], z0 = acc[ai][1][m][0], z1 = acc[ai][1][m][1];
                    u32x4 w;
                    w.x = cvt_pk_bf16(silu_f(z0[0]) * u0[0], silu_f(z0[1]) * u0[1]); w.y = cvt_pk_bf16(silu_f(z0[2]) * u0[2], silu_f(z0[3]) * u0[3]);
                    w.z = cvt_pk_bf16(silu_f(z1[0]) * u1[0], silu_f(z1[1]) * u1[1]); w.w = cvt_pk_bf16(silu_f(z1[2]) * u1[2], silu_f(z1[3]) * u1[3]);
                    __builtin_nontemporal_store(w, (u32x4*)(YAB + (size_t)(row0 + ai * 128 + m * 16) * 4096 + pn * 128 + cl));
                }
        } else if (pn < 24) {
            const int c0 = (pn - 16) * 256 + cl;
#pragma unroll
            for (int ai = 0; ai < 2; ++ai)
#pragma unroll
                for (int m = 0; m < 4; ++m) {
                    const int row = row0 + ai * 128 + m * 16; float s = 0.f, q = 0.f;
#pragma unroll
                    for (int bj = 0; bj < 2; ++bj) {
                        const f32x4 v0 = acc[ai][bj][m][0], v1 = acc[ai][bj][m][1];
                        s += (v0[0] + v0[1]) + (v0[2] + v0[3]) + (v1[0] + v1[1]) + (v1[2] + v1[3]);
                        q += (v0[0] * v0[0] + v0[1] * v0[1]) + (v0[2] * v0[2] + v0[3] * v0[3]) + (v1[0] * v1[0] + v1[1] * v1[1]) + (v1[2] * v1[2] + v1[3] * v1[3]);
                        u32x4 w; w.x = cvt_pk_bf16(v0[0], v0[1]); w.y = cvt_pk_bf16(v0[2], v0[3]); w.z = cvt_pk_bf16(v1[0], v1[1]); w.w = cvt_pk_bf16(v1[2], v1[3]);
                        __builtin_nontemporal_store(w, (u32x4*)(V + (size_t)row * 2048 + c0 + bj * 128));
                    }
                    s += __shfl_xor(s, 16); s += __shfl_xor(s, 32); q += __shfl_xor(q, 16); q += __shfl_xor(q, 32);
                    if (fq == 0) { atomic_addf(stats + 2 * row, s); atomic_addf(stats + 2 * row + 1, q); }
                }
        } else if (pn < 32) {
            const int c0 = (pn - 24) * 256 + cl;
#pragma unroll
            for (int ai = 0; ai < 2; ++ai)
#pragma unroll
                for (int m = 0; m < 4; ++m)
#pragma unroll
                    for (int bj = 0; bj < 2; ++bj) {
                        const f32x4 v0 = acc[ai][bj][m][0], v1 = acc[ai][bj][m][1];
                        u32x4 w; w.x = cvt_pk_bf16(silu_f(v0[0]), silu_f(v0[1])); w.y = cvt_pk_bf16(silu_f(v0[2]), silu_f(v0[3])); w.z = cvt_pk_bf16(silu_f(v1[0]), silu_f(v1[1])); w.w = cvt_pk_bf16(silu_f(v1[2]), silu_f(v1[3]));
                        __builtin_nontemporal_store(w, (u32x4*)(YAB + (size_t)(row0 + ai * 128 + m * 16) * 4096 + 2048 + c0 + bj * 128));
                    }
        } else if (pn < 48) {
            const int c0 = (pn - 32) * 256 + cl;
#pragma unroll
            for (int ai = 0; ai < 2; ++ai)
#pragma unroll
                for (int m = 0; m < 4; ++m)
#pragma unroll
                    for (int bj = 0; bj < 2; ++bj) {
                        const f32x4 v0 = acc[ai][bj][m][0], v1 = acc[ai][bj][m][1];
                        u32x4 w; w.x = cvt_pk_bf16(v0[0], v0[1]); w.y = cvt_pk_bf16(v0[2], v0[3]); w.z = cvt_pk_bf16(v1[0], v1[1]); w.w = cvt_pk_bf16(v1[2], v1[3]);
                        __builtin_nontemporal_store(w, (u32x4*)(XBC + (size_t)(row0 + ai * 128 + m * 16) * 4096 + c0 + bj * 128));
                    }
        } else {
            const int c0 = (pn - 48) * 128 + cl;
            const f32x4 ba0 = *(const f32x4*)(b_gate + c0), ba1 = *(const f32x4*)(b_gate + c0 + 4), bb0 = *(const f32x4*)(b_gate + 2048 + c0), bb1 = *(const f32x4*)(b_gate + 2048 + c0 + 4);
#pragma unroll
            for (int ai = 0; ai < 2; ++ai)
#pragma unroll
                for (int m = 0; m < 4; ++m) {
                    f32x4 a0 = acc[ai][0][m][0] + ba0, a1 = acc[ai][0][m][1] + ba1, b0 = acc[ai][1][m][0] + bb0, b1 = acc[ai][1][m][1] + bb1;
#pragma unroll
                    for (int j = 0; j < 4; ++j) { a0[j] = fminf(fmaxf(a0[j], -30.f), 30.f); a1[j] = fminf(fmaxf(a1[j], -30.f), 30.f); b0[j] = fminf(fmaxf(b0[j], -30.f), 30.f); b1[j] = fminf(fmaxf(b1[j], -30.f), 30.f); }
                    float ea[8], eb[8], rr[8], gb[8];
#pragma unroll
                    for (int j = 0; j < 4; ++j) { ea[j] = 1.0f + __expf(-a0[j]); ea[4 + j] = 1.0f + __expf(-a1[j]); eb[j] = 1.0f + __expf(-b0[j]); eb[4 + j] = 1.0f + __expf(-b1[j]); }
#pragma unroll
                    for (int j = 0; j < 8; ++j) { rr[j] = eb[j] * __builtin_amdgcn_rcpf(ea[j]); gb[j] = 1.0f * __builtin_amdgcn_rcpf(eb[j]); }
                    u32x4 wr_, wg_;
                    wr_.x = cvt_pk_bf16(rr[0], rr[1]); wr_.y = cvt_pk_bf16(rr[2], rr[3]); wr_.z = cvt_pk_bf16(rr[4], rr[5]); wr_.w = cvt_pk_bf16(rr[6], rr[7]);
                    wg_.x = cvt_pk_bf16(gb[0], gb[1]); wg_.y = cvt_pk_bf16(gb[2], gb[3]); wg_.z = cvt_pk_bf16(gb[4], gb[5]); wg_.w = cvt_pk_bf16(gb[6], gb[7]);
                    const size_t o = ((((((size_t)u.pm * 8 + ((pn - 48) >> 1)) * 2 + ((pn - 48) & 1)) * 2 + ai) * 4 + m) * 8 + (wr * 4 + wc)) * 512 + (size_t)(fr + 16 * fq) * 8;
                    __builtin_nontemporal_store(wr_, (u32x4*)(R + o)); __builtin_nontemporal_store(wg_, (u32x4*)(GB + o));
                }
        }
    }
};
__device__ __forceinline__ void merge_store(const bf16_t* __restrict__ GB, bf16_t* __restrict__ merged, const f32x4 (&acc)[2][2][4][2], int row0, int col0, size_t gbase, int wl) {
#pragma unroll
    for (int ai = 0; ai < 2; ++ai) {
        u32x4 gv[4][2];
#pragma unroll
        for (int m = 0; m < 4; ++m)
#pragma unroll
            for (int bj = 0; bj < 2; ++bj) gv[m][bj] = __builtin_nontemporal_load((const u32x4*)(GB + ((((gbase * 2 + bj) * 2 + ai) * 4 + m) * 8) * 512 + wl));
#pragma unroll
        for (int m = 0; m < 4; ++m)
#pragma unroll
            for (int bj = 0; bj < 2; ++bj) { const u32x4 g = gv[m][bj]; const f32x4 v0 = acc[ai][bj][m][0], v1 = acc[ai][bj][m][1];
                u32x4 w; w.x = cvt_pk_bf16(v0[0] * bflo(g.x), v0[1] * bfhi(g.x)); w.y = cvt_pk_bf16(v0[2] * bflo(g.y), v0[3] * bfhi(g.y));
                w.z = cvt_pk_bf16(v1[0] * bflo(g.z), v1[1] * bfhi(g.z)); w.w = cvt_pk_bf16(v1[2] * bflo(g.w), v1[3] * bfhi(g.w));
                *(u32x4*)(merged + (size_t)(row0 + ai * 128 + m * 16) * 2048 + col0 + bj * 128) = w; }
    }
}
struct EpiMerge {
    static constexpr bool PERM = true, AFTER_DRAIN = false;
    const bf16_t* R; const bf16_t* GB; bf16_t* merged;
    __device__ __forceinline__ bool keep(const pg8::Unit& u) const { return u.kh == 0; }
    __device__ __forceinline__ void operator()(f32x4 (&acc)[2][2][4][2], const pg8::Unit& u, int wr, int wc, int fr, int fq) const {
        const int row0 = u.pm * 256 + wr * 64 + fr, col0 = u.pn * 256 + wc * 32 + 8 * fq;
        const size_t gbase = (size_t)u.pm * 8 + u.pn; const int wl = (wr * 4 + wc) * 512 + (fr + 16 * fq) * 8;
        if (u.kh == 0) {
#pragma unroll
            for (int ai = 0; ai < 2; ++ai) {
                u32x4 rv[4][2];
#pragma unroll
                for (int m = 0; m < 4; ++m)
#pragma unroll
                    for (int bj = 0; bj < 2; ++bj) rv[m][bj] = __builtin_nontemporal_load((const u32x4*)(R + ((((gbase * 2 + bj) * 2 + ai) * 4 + m) * 8) * 512 + wl));
#pragma unroll
                for (int m = 0; m < 4; ++m)
#pragma unroll
                    for (int bj = 0; bj < 2; ++bj) { const u32x4 g = rv[m][bj];
                        f32x4 v0 = acc[ai][bj][m][0], v1 = acc[ai][bj][m][1];
                        v0[0] *= bflo(g.x); v0[1] *= bfhi(g.x); v0[2] *= bflo(g.y); v0[3] *= bfhi(g.y); v1[0] *= bflo(g.z); v1[1] *= bfhi(g.z); v1[2] *= bflo(g.w); v1[3] *= bfhi(g.w);
                        acc[ai][bj][m][0] = v0; acc[ai][bj][m][1] = v1; }
            }
        } else merge_store(GB, merged, acc, row0, col0, gbase, wl);
    }
};
struct SplitKOrder : pg8::StaticOrder {
    __device__ bool next(int i, pg8::Unit& u) const { const bool ok = pg8::StaticOrder::next(i >> 1, u); u.kh = i & 1; return ok; }
};
__device__ __forceinline__ void out_store(const float* __restrict__ x, float* __restrict__ out, float* __restrict__ ssq, const f32x4 (&acc)[2][2][4][2], int row0, int col0, int fq) {
    f32x4 xv[2][4];
#pragma unroll
    for (int bj = 0; bj < 2; ++bj)
#pragma unroll
        for (int n = 0; n < 2; ++n) xv[0][bj * 2 + n] = *(const f32x4*)(x + (size_t)row0 * 2048 + col0 + bj * 128 + n * 16);
#pragma unroll
    for (int gi = 0; gi < 8; ++gi) {
        const int ai = gi >> 2, m = gi & 3;
        if (gi < 7) { const int ai2 = (gi + 1) >> 2, m2 = (gi + 1) & 3;
#pragma unroll
            for (int bj = 0; bj < 2; ++bj)
#pragma unroll
                for (int n = 0; n < 2; ++n) xv[(gi + 1) & 1][bj * 2 + n] = *(const f32x4*)(x + (size_t)(row0 + ai2 * 128 + m2 * 16) * 2048 + col0 + bj * 128 + n * 16); }
        const size_t row = (size_t)(row0 + ai * 128 + m * 16); float q = 0.f;
#pragma unroll
        for (int bj = 0; bj < 2; ++bj)
#pragma unroll
            for (int n = 0; n < 2; ++n) { const f32x4 r = xv[gi & 1][bj * 2 + n] + acc[ai][bj][m][n];
                q += (r[0] * r[0] + r[1] * r[1]) + (r[2] * r[2] + r[3] * r[3]);
                *(f32x4*)(out + row * 2048 + col0 + bj * 128 + n * 16) = r; }
        q += __shfl_xor(q, 16); q += __shfl_xor(q, 32);
        if (fq == 0) atomic_addf(ssq + row, q);
    }
}
struct EpiOut {
    static constexpr bool PERM = false, AFTER_DRAIN = false;
    __device__ __forceinline__ bool keep(const pg8::Unit&) const { return false; }
    const float* x; float* out; float* ssq;
    __device__ __forceinline__ void operator()(const f32x4 (&acc)[2][2][4][2], const pg8::Unit& u, int wr, int wc, int fr, int fq) const {
        out_store(x, out, ssq, acc, u.pm * 256 + wr * 64 + fr, u.pn * 256 + wc * 32 + 4 * fq, fq);
    }
};

struct EpiAcc {
    static constexpr bool PERM = true, AFTER_DRAIN = false;
    __device__ __forceinline__ bool keep(const pg8::Unit&) const { return false; }
    bf16_t* O;
    __device__ __forceinline__ void operator()(const f32x4 (&acc)[2][2][4][2], const pg8::Unit& u, int wr, int wc, int fr, int fq) const {
        const int row0 = u.pm * 256 + wr * 64 + fr, col0 = u.pn * 256 + wc * 32 + 8 * fq;
#pragma unroll
        for (int ai = 0; ai < 2; ++ai)
#pragma unroll
            for (int m = 0; m < 4; ++m)
#pragma unroll
                for (int bj = 0; bj < 2; ++bj) {
                    const f32x4 v0 = acc[ai][bj][m][0], v1 = acc[ai][bj][m][1];
                    u32x4 w; w.x = cvt_pk_bf16(v0[0], v0[1]); w.y = cvt_pk_bf16(v0[2], v0[3]); w.z = cvt_pk_bf16(v1[0], v1[1]); w.w = cvt_pk_bf16(v1[2], v1[3]);
                    __builtin_nontemporal_store(w, (u32x4*)(O + (size_t)(row0 + ai * 128 + m * 16) * 2048 + col0 + bj * 128));
                }
    }
};

__device__ __forceinline__ void transpose_item(const float* W, int ldw, int K, int k0, int n0, bf16_t* dst, LAS float* scr, int lane, int kd = -1) {
    if (kd < 0) kd = k0;
#pragma unroll 8
    for (int i = 0; i < 32; ++i) { const int kk = 2 * i + (lane >> 5); scr[kk * 33 + (lane & 31)] = W[(size_t)(k0 + kk) * ldw + n0 + (lane & 31)]; }
    asm volatile("s_waitcnt lgkmcnt(0)" ::: "memory");
    const int c = lane & 7;
#pragma unroll
    for (int j = 0; j < 4; ++j) { const int n = (lane >> 3) + 8 * j; const LAS float* s = scr + (8 * c) * 33 + n;
        u32x4 o; o.x = cvt_pk_bf16(s[0 * 33], s[1 * 33]); o.y = cvt_pk_bf16(s[2 * 33], s[3 * 33]); o.z = cvt_pk_bf16(s[4 * 33], s[5 * 33]); o.w = cvt_pk_bf16(s[6 * 33], s[7 * 33]);
        *(u32x4*)(dst + (size_t)n * K + kd + 8 * c) = o; }
    asm volatile("s_waitcnt lgkmcnt(0)" ::: "memory");
}
struct TItem { const float* src; bf16_t* dst; int ldw, ldd; };
__device__ __forceinline__ void titem_load(const TItem& t, f32x4 (&v)[16], int lane) {
    const int r4 = lane >> 4, c4 = lane & 15;
#pragma unroll
    for (int i = 0; i < 16; ++i) v[i] = __builtin_nontemporal_load((const f32x4*)(t.src + (size_t)(4 * i + r4) * t.ldw + 4 * c4));
}
__device__ __forceinline__ void titem_finish(const TItem& t, const f32x4 (&v)[16], LAS float* scr, int lane) {
    const int r4 = lane >> 4, c4 = lane & 15;
#pragma unroll
    for (int i = 0; i < 16; ++i) { LAS float* p = scr + (4 * i + r4) * 65 + 4 * c4; p[0] = v[i][0]; p[1] = v[i][1]; p[2] = v[i][2]; p[3] = v[i][3]; }
    asm volatile("s_waitcnt lgkmcnt(0)" ::: "memory");
    const int c = lane & 7;
#pragma unroll
    for (int i = 0; i < 8; ++i) { const int n = (lane >> 3) + 8 * i; const LAS float* s = scr + (8 * c) * 65 + n;
        u32x4 o; o.x = cvt_pk_bf16(s[0 * 65], s[1 * 65]); o.y = cvt_pk_bf16(s[2 * 65], s[3 * 65]); o.z = cvt_pk_bf16(s[4 * 65], s[5 * 65]); o.w = cvt_pk_bf16(s[6 * 65], s[7 * 65]);
        *(u32x4*)(t.dst + (size_t)n * t.ldd + 8 * c) = o; }
    asm volatile("s_waitcnt lgkmcnt(0)" ::: "memory");
}
__device__ __forceinline__ int proj_row(int n0) {
    if (n0 < 2048) return 256 * (n0 >> 7) + (n0 & 127);
    if (n0 < 4096) return 4096 + (n0 - 2048);
    if (n0 < 6144) { const int ch = n0 - 4096; return 256 * (ch >> 7) + 128 + (ch & 127); }
    if (n0 < 12288) return n0;
    if (n0 < 12320) return -1;
    { const int c = n0 - 12320, n = c >> 11, ch = c & 2047; return 12288 + 256 * (ch >> 7) + 128 * n + (ch & 127); }
}

template <int W> struct ConvRaw { static constexpr int CG = W / 8, RB = NT / CG, RPT = 128 / RB; u32x4 r[RPT + 3]; };
template <int W>
__device__ __forceinline__ void stage_conv_load(ConvRaw<W>& raw, const bf16_t* xbc, int tok0, int cidx, int col0, int tid) {
    constexpr int CG = ConvRaw<W>::CG, RPT = ConvRaw<W>::RPT;
    const int cgi = tid % CG, rb = tid / CG, r0 = rb * RPT;
    const bf16_t* src = xbc + (size_t)tok0 * 4096 + col0 + cgi * 8;
#pragma unroll
    for (int i = 0; i < RPT + 3; ++i) { const int r = r0 - 3 + i;
        if (cidx == 0 && r < 0) raw.r[i] = (u32x4){0u, 0u, 0u, 0u}; else raw.r[i] = __builtin_nontemporal_load((const u32x4*)(src + (ptrdiff_t)r * 4096)); }
}
template <int W>
__device__ __forceinline__ void stage_conv_finish(const ConvRaw<W>& raw, LAS unsigned char* dst, int stride, int col0, const float* conv_w, const float* conv_b, const LAS float* scale, int tid, bf16_t* gdst = nullptr, int gstride = 0) {
    constexpr int CG = ConvRaw<W>::CG, RPT = ConvRaw<W>::RPT;
    const int cgi = tid % CG, rb = tid / CG, r0 = rb * RPT, ch0 = col0 + cgi * 8;
    float w[4][8], bias[8], h0[8], h1[8], h2[8];
#pragma unroll
    for (int k = 0; k < 4; ++k) { const f32x4 a = *(const f32x4*)(conv_w + k * 4096 + ch0), b = *(const f32x4*)(conv_w + k * 4096 + ch0 + 4);
#pragma unroll
        for (int j = 0; j < 4; ++j) { w[k][j] = a[j]; w[k][4 + j] = b[j]; } }
    { const f32x4 a = *(const f32x4*)(conv_b + ch0), b = *(const f32x4*)(conv_b + ch0 + 4);
#pragma unroll
      for (int j = 0; j < 4; ++j) { bias[j] = a[j]; bias[4 + j] = b[j]; } }
#define UNPK(v_, o) do { o[0] = bflo(v_.x); o[1] = bfhi(v_.x); o[2] = bflo(v_.y); o[3] = bfhi(v_.y); o[4] = bflo(v_.z); o[5] = bfhi(v_.z); o[6] = bflo(v_.w); o[7] = bfhi(v_.w); } while (0)
    UNPK(raw.r[0], h0); UNPK(raw.r[1], h1); UNPK(raw.r[2], h2);
#pragma unroll
    for (int i = 0; i < RPT; ++i) {
        float cur[8], o[8]; UNPK(raw.r[3 + i], cur);
        float sc = 1.0f; if (scale) sc = scale[(cgi >> 3) * 128 + r0 + i];
#pragma unroll
        for (int j = 0; j < 8; ++j) { float v = bias[j] + w[0][j] * h0[j] + w[1][j] * h1[j] + w[2][j] * h2[j] + w[3][j] * cur[j]; o[j] = silu_f(v) * sc; h0[j] = h1[j]; h1[j] = h2[j]; h2[j] = cur[j]; }
        u32x4 pk; pk.x = cvt_pk_bf16(o[0], o[1]); pk.y = cvt_pk_bf16(o[2], o[3]); pk.z = cvt_pk_bf16(o[4], o[5]); pk.w = cvt_pk_bf16(o[6], o[7]);
        { LAS unsigned char* q_ = dst + (r0 + i) * stride + (32 * (cgi >> 2) + 4 * (cgi & 3)) * 2;
          *(LAS u32x2*)q_ = (u32x2){pk.x, pk.y}; *(LAS u32x2*)(q_ + 32) = (u32x2){pk.z, pk.w}; }
        if (gdst) __builtin_nontemporal_store(pk, (u32x4*)(gdst + (size_t)(r0 + i) * gstride + cgi * 8));
    }
#undef UNPK
}
__device__ __forceinline__ float chunk_prefix(LAS float* adt, LAS float* ac, const float* DT, const float* a_log, int tok0, int g, int tid) {
    const int k = tid >> 7, l = tid & 127, h = g * 4 + k, lane = tid & 63;
    const float dtv = DT[(size_t)h * M_TOK + tok0 + l];
    const float a = -expf(a_log[h]);
    float s = dtv * a;
#pragma unroll
    for (int o = 1; o < 64; o <<= 1) { const float t = __shfl_up(s, o); if (lane >= o) s += t; }
    if (lane == 63) adt[tid >> 6] = s;
    __syncthreads();
    if (l >= 64) s += adt[(tid >> 6) - 1];
    ac[k * 128 + l] = s;
    __syncthreads();
    return dtv;
}

constexpr int XS_STRIDE = 528, CB_STRIDE = 272;

__device__ __forceinline__ void own_barrier(unsigned* bar, unsigned target) {
    if (threadIdx.x == 0) {
        __hip_atomic_fetch_add(bar, 1u, __ATOMIC_RELAXED, __HIP_MEMORY_SCOPE_AGENT);
        const unsigned long long t0 = __builtin_amdgcn_s_memrealtime();
        while (__hip_atomic_load(bar, __ATOMIC_RELAXED, __HIP_MEMORY_SCOPE_AGENT) < target) {
            __builtin_amdgcn_s_sleep(2);
            if (__builtin_amdgcn_s_memrealtime() - t0 > 200000000ull) break;
        }
    }
    __syncthreads();
}
#define GRID_SYNC(i) do { asm volatile("s_waitcnt vmcnt(0) lgkmcnt(0)" ::: "memory"); grid.sync(); \
    __builtin_amdgcn_fence(__ATOMIC_ACQUIRE, "agent"); asm volatile("s_waitcnt vmcnt(0)" ::: "memory"); __syncthreads(); STAMP(i); } while (0)
#ifdef SPIN_PHASE
#define STAMP(i) do { if (bx == 0 && tid == 0) { ((unsigned long long*)(BAR + 16))[i] = __builtin_amdgcn_s_memrealtime(); } } while (0)
#else
#define STAMP(i) do { } while (0)
#endif
#ifdef SPIN_SUB
#define SUBSTAMP(i) do { if (bx == 0 && tid == 0 && j == 0) ((unsigned long long*)(BAR + 16))[16 + (i)] = __builtin_amdgcn_s_memrealtime(); } while (0)
#else
#define SUBSTAMP(i) do { } while (0)
#endif
__global__ void __launch_bounds__(NT, 2) fwd_megakernel(Args A) {
    extern __shared__ __attribute__((aligned(16))) unsigned char lds_raw[];
    LAS unsigned char* lds = (LAS unsigned char*)lds_raw;
    const unsigned lds_u32 = (unsigned)(size_t)lds_raw;
    cg::grid_group grid = cg::this_grid();
    const int tid = threadIdx.x, lane = tid & 63, wave = __builtin_amdgcn_readfirstlane(tid >> 6), fr = lane & 15, fq = lane >> 4;
    const int G = gridDim.x, bx = blockIdx.x;
    const int gw = bx * NWAVES + wave, NGW = G * NWAVES;
    unsigned char* ws = A.ws;
    bf16_t* WinT = (bf16_t*)A.out; bf16_t* H = (bf16_t*)((unsigned char*)A.out + 64 * MiB);
    bf16_t* STATES = (bf16_t*)A.out;
    bf16_t* WdtT = (bf16_t*)(ws + WS_WDT); bf16_t* WsB = (bf16_t*)(ws + WS_WSB); float* STATS = (float*)(ws + WS_STATS); float* SSQ = (float*)(ws + WS_SSQ);
    float* CD = (float*)(ws + WS_CD); float* DT = (float*)(ws + WS_DT); unsigned* BAR = (unsigned*)(ws + WS_BAR); unsigned bar_epoch = 0;
    bf16_t* WbT = (bf16_t*)(ws + WS_WB); bf16_t* WoT = (bf16_t*)(ws + WS_WO); bf16_t* YAB = (bf16_t*)(ws + WS_YAB); bf16_t* V = (bf16_t*)(ws + WS_V);
    bf16_t* PREV = (bf16_t*)(ws + WS_V); bf16_t* MERGED = (bf16_t*)(ws + WS_V);
    bf16_t* CC = (bf16_t*)(ws + WS_CC); bf16_t* YD = (bf16_t*)((unsigned char*)A.out + 64 * MiB);
    bf16_t* XBC = (bf16_t*)(ws + WS_XBC); bf16_t* RG = (bf16_t*)(ws + WS_R); bf16_t* GB = (bf16_t*)(ws + WS_GB);

    STAMP(0);
    if constexpr ((PH_MASK >> 0) & 1)
    {
        LAS float* scr = (LAS float*)(lds + wave * 16640);
        constexpr int I_IN = 32 * 256, I_B = 32 * 32, I_O = 32 * 32, NITEMS = I_IN + 2 * I_B + I_O;
        auto item_of = [&](int it) -> TItem {
            TItem t; int r = it;
            if (r < I_IN) { const int kb = r >> 8, nb = r & 255, n0 = nb < 192 ? 64 * nb : 12320 + 64 * (nb - 192);
                t.src = A.w_in + (size_t)(64 * kb) * NIN + n0; t.ldw = NIN; t.dst = WinT + (size_t)proj_row(n0) * 2048 + 64 * kb; t.ldd = 2048; return t; }
            r -= I_IN;
            if (r < 2 * I_B) { const int nbr = r / I_B, rr = r % I_B, kb = rr >> 5, nb = rr & 31;
                t.src = A.w_branch + (size_t)nbr * 2048 * 2048 + (size_t)(64 * kb) * 2048 + 64 * nb; t.ldw = 2048; t.dst = WbT + (size_t)(64 * nb) * 4096 + nbr * 2048 + 64 * kb; t.ldd = 4096; return t; }
            r -= 2 * I_B;
            { const int kb = r >> 5, nb = r & 31; t.src = A.w_out + (size_t)(64 * kb) * 2048 + 64 * nb; t.ldw = 2048; t.dst = WoT + (size_t)(64 * nb) * 2048 + 64 * kb; t.ldd = 2048; return t; }
        };
        {
            f32x4 va[16], vb[16]; int it = gw; TItem ta, tb;
            if (it < NITEMS) { ta = item_of(it); titem_load(ta, va, lane); }
            while (it < NITEMS) {
                const int it2 = it + NGW, it3 = it2 + NGW;
                if (it2 < NITEMS) { tb = item_of(it2); titem_load(tb, vb, lane); }
                titem_finish(ta, va, scr, lane);
                if (it3 < NITEMS) { ta = item_of(it3); titem_load(ta, va, lane); }
                if (it2 < NITEMS) titem_finish(tb, vb, scr, lane);
                it = it3;
            }
        }
        for (int r = gw; r < 32; r += NGW) transpose_item(A.w_in, NIN, 2048, 64 * r, 12288, WdtT, scr, lane);
        for (int i = bx * NT + tid; i < 8 * 128 * 128; i += G * NT) { const int t = (i >> 7) & 127, s = i & 127; const float v = (s <= t) ? A.w_sp[i] : 0.f; WsB[i] = (bf16_t)(cvt_pk_bf16(v, 0.f) & 0xffffu); }
        for (int i = bx * NT + tid; i < 2 * M_TOK; i += G * NT) STATS[i] = 0.f;
        for (int i = bx * NT + tid; i < M_TOK; i += G * NT) SSQ[i] = 0.f;
        for (int m = gw; m < M_TOK; m += 2 * NGW) {
            const int m2 = m + NGW;
            const f32x4* xr = (const f32x4*)(A.x + (size_t)m * DM) + lane; const f32x4* xr2 = (const f32x4*)(A.x + (size_t)m2 * DM) + lane; const f32x4* wr4 = (const f32x4*)A.norm_w + lane;
            f32x4 v[8], v2[8]; float s = 0.f, s2 = 0.f;
#pragma unroll
            for (int j = 0; j < 8; ++j) { v[j] = __builtin_nontemporal_load(xr + 64 * j); v2[j] = __builtin_nontemporal_load(xr2 + 64 * j); }
#pragma unroll
            for (int j = 0; j < 8; ++j) { s += (v[j][0] * v[j][0] + v[j][1] * v[j][1]) + (v[j][2] * v[j][2] + v[j][3] * v[j][3]); s2 += (v2[j][0] * v2[j][0] + v2[j][1] * v2[j][1]) + (v2[j][2] * v2[j][2] + v2[j][3] * v2[j][3]); }
            const float rstd = 1.0f / sqrtf(wave_sum(s) * (1.0f / DM) + EPS), rstd2 = 1.0f / sqrtf(wave_sum(s2) * (1.0f / DM) + EPS);
            u32x2* o8 = (u32x2*)(H + (size_t)m * DM) + lane; u32x2* o82 = (u32x2*)(H + (size_t)m2 * DM) + lane;
#pragma unroll
            for (int j = 0; j < 8; ++j) { const f32x4 w4 = wr4[64 * j];
                u32x2 o; o.x = cvt_pk_bf16(v[j][0] * rstd * w4[0], v[j][1] * rstd * w4[1]); o.y = cvt_pk_bf16(v[j][2] * rstd * w4[2], v[j][3] * rstd * w4[3]); o8[64 * j] = o;
                u32x2 o2; o2.x = cvt_pk_bf16(v2[j][0] * rstd2 * w4[0], v2[j][1] * rstd2 * w4[1]); o2.y = cvt_pk_bf16(v2[j][2] * rstd2 * w4[2], v2[j][3] * rstd2 * w4[3]); o82[64 * j] = o2; }
        }
    }
    GRID_SYNC(1);

    if constexpr ((PH_MASK >> 1) & 1)
    {
        pg8::Gemm g{H, WinT, M_TOK, NPROJ, DM, DM}; pg8::StaticOrder S; S.init(M_TOK, NPROJ, G, bx, WGM_P1);
        EpiProj E{YAB, V, XBC, RG, GB, STATS, A.b_gate};
        pg8::gemm_phase<EpiProj, pg8::StaticOrder, true, true>(lds, g, S, E);
        {
            constexpr int WROW = 4112;
#pragma unroll
            for (int i = 0; i < 16; ++i) { const int row = 2 * i + (tid >> 8), ch = tid & 255;
                *(LAS u32x4*)(lds + row * WROW + ch * 16) = *(const u32x4*)(WdtT + (size_t)row * DM + ch * 8); }
            __syncthreads();
            for (int t0 = bx * 4; t0 < M_TOK / 16; t0 += G * 4) {
                const int t = t0 + (wave >> 1), kh = wave & 1;
                f32x4 acc0 = {0.f, 0.f, 0.f, 0.f}, acc1 = {0.f, 0.f, 0.f, 0.f};
                const bf16_t* ap = H + (size_t)(16 * t + fr) * DM + 8 * fq + kh * 1024;
                const LAS unsigned char* bp = lds + fr * WROW + (8 * fq + kh * 1024) * 2;
#pragma unroll 16
                for (int ks = 0; ks < 32; ++ks) {
                    const bf16x8 fa = *(const bf16x8*)(ap + 32 * ks), fb0 = *(const LAS bf16x8*)(bp + 64 * ks), fb1 = *(const LAS bf16x8*)(bp + 16 * WROW + 64 * ks);
                    acc0 = __builtin_amdgcn_mfma_f32_16x16x32_bf16(fb0, fa, acc0, 0, 0, 0);
                    acc1 = __builtin_amdgcn_mfma_f32_16x16x32_bf16(fb1, fa, acc1, 0, 0, 0);
                }
                LAS f32x4* xch = (LAS f32x4*)(lds + 32 * WROW) + (wave >> 1) * 128 + lane * 2;
                if (kh) { xch[0] = acc0; xch[1] = acc1; }
                __syncthreads();
                if (!kh) {
                    acc0 += xch[0]; acc1 += xch[1];
                    const f32x4 bb0 = *(const f32x4*)(A.dt_bias + 4 * fq), bb1 = *(const f32x4*)(A.dt_bias + 16 + 4 * fq);
                    f32x4 o0, o1;
#pragma unroll
                    for (int j = 0; j < 4; ++j) { const float v0 = acc0[j] + bb0[j], v1 = acc1[j] + bb1[j];
                        o0[j] = fmaxf(v0, 0.f) + log1pf(expf(-fabsf(v0))); o1[j] = fmaxf(v1, 0.f) + log1pf(expf(-fabsf(v1))); }
                    float* dp = DT + (size_t)(4 * fq) * M_TOK + 16 * t + fr;
#pragma unroll
                    for (int j = 0; j < 4; ++j) { dp[(size_t)j * M_TOK] = o0[j]; dp[(size_t)(16 + j) * M_TOK] = o1[j]; }
                }
                __syncthreads();
            }
        }
    }
    GRID_SYNC(2);

    if constexpr ((PH_MASK >> 2) & 1)
    for (int j = bx; j < 2048; j += G) {
        const int jj = j & 1023, g = jj & 7, bc = jj >> 3, tok0 = bc * 128, cidx = bc & 31;
        int tid = threadIdx.x; asm volatile("" : "+v"(tid));
        const int lane = tid & 63, fr = lane & 15, fq = lane >> 4;
        if (j < 1024) {
            {
                const bf16_t* wsrc = WsB + (size_t)g * 16384;
                u32x4 wv[4];
#pragma unroll
                for (int i = 0; i < 4; ++i) wv[i] = *(const u32x4*)(wsrc + (size_t)(i * 32 + (tid >> 4)) * 128 + (tid & 15) * 8);
#pragma unroll
                for (int i = 0; i < 4; ++i) *(LAS u32x4*)(lds + 67584 + (i * 32 + (tid >> 4)) * CB_STRIDE + (tid & 15) * 16) = wv[i];
            }
            bf16_t* p0 = YAB + (size_t)(tok0 + fr) * 4096 + g * 256 + 32 * wave + 8 * fq;
            u32x4 sv[8]; float bs[8];
#pragma unroll
            for (int mt = 0; mt < 8; ++mt) { bs[mt] = A.b_sp[g * 128 + 16 * mt + fr]; sv[mt] = *(const u32x4*)(p0 + (size_t)(16 * mt) * 4096); }
            {
                const int cgi = tid & 31, rb = tid >> 5, d0 = g * 256 + cgi * 8;
                const f32x4 lw0 = *(const f32x4*)(A.ln_w + d0), lw1 = *(const f32x4*)(A.ln_w + d0 + 4), lb0 = *(const f32x4*)(A.ln_b + d0), lb1 = *(const f32x4*)(A.ln_b + d0 + 4);
#pragma unroll
                for (int i = 0; i < 8; ++i) {
                    const int r = rb * 8 + i, tok = tok0 + r;
                    const float2 st2 = *(const float2*)(STATS + 2 * tok); const float mean = st2.x * (1.0f / 2048.0f), var = st2.y * (1.0f / 2048.0f) - mean * mean, rstd = 1.0f / sqrtf(fmaxf(var, 0.f) + EPS);
                    const u32x4 v = __builtin_nontemporal_load((const u32x4*)(V + (size_t)tok * 2048 + d0));
                    u32x4 pk;
                    pk.x = cvt_pk_bf16((bflo(v.x) - mean) * rstd * lw0[0] + lb0[0], (bfhi(v.x) - mean) * rstd * lw0[1] + lb0[1]);
                    pk.y = cvt_pk_bf16((bflo(v.y) - mean) * rstd * lw0[2] + lb0[2], (bfhi(v.y) - mean) * rstd * lw0[3] + lb0[3]);
                    pk.z = cvt_pk_bf16((bflo(v.z) - mean) * rstd * lw1[0] + lb1[0], (bfhi(v.z) - mean) * rstd * lw1[1] + lb1[1]);
                    pk.w = cvt_pk_bf16((bflo(v.w) - mean) * rstd * lw1[2] + lb1[2], (bfhi(v.w) - mean) * rstd * lw1[3] + lb1[3]);
                    { LAS unsigned char* q_ = lds + r * XS_STRIDE + (32 * (cgi >> 2) + 4 * (cgi & 3)) * 2; *(LAS u32x2*)q_ = (u32x2){pk.x, pk.y}; *(LAS u32x2*)(q_ + 32) = (u32x2){pk.z, pk.w}; }
                }
            }
            __syncthreads();
            f32x4 acc[8][2];
#pragma unroll
            for (int mt = 0; mt < 8; ++mt) { acc[mt][0] = (f32x4){0.f, 0.f, 0.f, 0.f}; acc[mt][1] = (f32x4){0.f, 0.f, 0.f, 0.f}; }
            const unsigned tra = lds_u32 + (8 * fq + (fr >> 2)) * XS_STRIDE + (32 * wave + 4 * (lane & 3)) * 2;
#pragma unroll
            for (int ks = 0; ks < 4; ++ks) {
                bf16x8 fn0, fn1; tr_frag2<4 * XS_STRIDE, 32>(tra + 32 * ks * XS_STRIDE, fn0, fn1);
#pragma unroll
                for (int mt = 2 * ks; mt < 8; ++mt) {
                    const bf16x8 fm = *(const LAS bf16x8*)(lds + 67584 + (16 * mt + fr) * CB_STRIDE + (32 * ks + 8 * fq) * 2);
                    acc[mt][0] = __builtin_amdgcn_mfma_f32_16x16x32_bf16(fn0, fm, acc[mt][0], 0, 0, 0);
                    acc[mt][1] = __builtin_amdgcn_mfma_f32_16x16x32_bf16(fn1, fm, acc[mt][1], 0, 0, 0);
                }
            }
            {
#pragma unroll
                for (int mt = 0; mt < 8; ++mt) { const f32x4 a0 = acc[mt][0], a1 = acc[mt][1]; const u32x4 s4 = sv[mt]; const float b = bs[mt];
                    u32x4 o; o.x = cvt_pk_bf16(bflo(s4.x) * (a0[0] + b), bfhi(s4.x) * (a0[1] + b)); o.y = cvt_pk_bf16(bflo(s4.y) * (a0[2] + b), bfhi(s4.y) * (a0[3] + b));
                    o.z = cvt_pk_bf16(bflo(s4.z) * (a1[0] + b), bfhi(s4.z) * (a1[1] + b)); o.w = cvt_pk_bf16(bflo(s4.w) * (a1[2] + b), bfhi(s4.w) * (a1[3] + b));
                    *(u32x4*)(p0 + (size_t)(16 * mt) * 4096) = o; }
            }
            __syncthreads();
        } else {
            LAS float* ac = (LAS float*)(lds + 137216); LAS float* dtl = ac + 512; LAS float* adt = dtl + 512; LAS float* wg = adt + 512;
            ConvRaw<128> rc, rbb; ConvRaw<256> rx;
            stage_conv_load<128>(rc, XBC, tok0, cidx, 3072 + g * 128, tid); stage_conv_load<128>(rbb, XBC, tok0, cidx, 2048 + g * 128, tid); stage_conv_load<256>(rx, XBC, tok0, cidx, g * 256, tid);
            { const float dtv = chunk_prefix(adt, ac, DT, A.a_log, tok0, g, tid); dtl[tid] = dtv;
              const int k = tid >> 7, l_ = tid & 127; const float aend = ac[k * 128 + 127]; wg[tid] = expf(aend - ac[tid]) * dtv; if (l_ == 127) CD[bc * 32 + g * 4 + k] = expf(aend); }
            stage_conv_finish<128>(rc, lds, CB_STRIDE, 3072 + g * 128, A.conv_w, A.conv_b, nullptr, tid, CC + (size_t)tok0 * 1024 + g * 128, 1024);
            stage_conv_finish<128>(rbb, lds + 34816, CB_STRIDE, 2048 + g * 128, A.conv_w, A.conv_b, nullptr, tid);
            stage_conv_finish<256>(rx, lds + 69632, XS_STRIDE, g * 256, A.conv_w, A.conv_b, nullptr, tid);
            __syncthreads();
            const int l = 16 * wave + fr;
            f32x4 cb[8];
            {
                bf16x8 fc[4];
#pragma unroll
                for (int ks = 0; ks < 4; ++ks) fc[ks] = *(const LAS bf16x8*)(lds + l * CB_STRIDE + (32 * ks + 8 * fq) * 2);
#pragma unroll
                for (int nt = 0; nt < 8; ++nt) {
                    cb[nt] = (f32x4){0.f, 0.f, 0.f, 0.f};
                    if (nt <= wave) {
#pragma unroll
                        for (int ks = 0; ks < 4; ++ks) { const bf16x8 fb = *(const LAS bf16x8*)(lds + 34816 + (16 * nt + fr) * CB_STRIDE + (32 * ks + 8 * fq) * 2);
                            cb[nt] = __builtin_amdgcn_mfma_f32_16x16x32_bf16(fb, fc[ks], cb[nt], 0, 0, 0); }
                    }
                }
            }
            {
                const int k = wave >> 1, ph = wave & 1;
                f32x4 acc[2][8];
#pragma unroll
                for (int mt = 0; mt < 2; ++mt)
#pragma unroll
                    for (int nt = 0; nt < 8; ++nt) acc[mt][nt] = (f32x4){0.f, 0.f, 0.f, 0.f};
                const unsigned xa = lds_u32 + 69632 + (8 * fq + (fr >> 2)) * XS_STRIDE + (k * 64 + 32 * ph + 4 * (lane & 3)) * 2;
                const unsigned ba = lds_u32 + 34816 + (8 * fq + (fr >> 2)) * CB_STRIDE + (4 * (lane & 3)) * 2;
#pragma unroll
                for (int ks = 0; ks < 4; ++ks) {
                    bf16x8 fm0, fm1; tr_frag2<4 * XS_STRIDE, 32>(xa + 32 * ks * XS_STRIDE, fm0, fm1);
                    const f32x4 w0 = *(const LAS f32x4*)(wg + k * 128 + 32 * ks + 8 * fq), w1 = *(const LAS f32x4*)(wg + k * 128 + 32 * ks + 8 * fq + 4);
                    const float wv[8] = {w0[0], w0[1], w0[2], w0[3], w1[0], w1[1], w1[2], w1[3]};
                    bf16x8 sm0, sm1;
#pragma unroll
                    for (int e = 0; e < 8; e += 2) {
                        const unsigned a0 = cvt_pk_bf16(bf2f((unsigned short)fm0[e]) * wv[e], bf2f((unsigned short)fm0[e + 1]) * wv[e + 1]);
                        const unsigned a1 = cvt_pk_bf16(bf2f((unsigned short)fm1[e]) * wv[e], bf2f((unsigned short)fm1[e + 1]) * wv[e + 1]);
                        sm0[e] = (short)(a0 & 0xffffu); sm0[e + 1] = (short)(a0 >> 16); sm1[e] = (short)(a1 & 0xffffu); sm1[e + 1] = (short)(a1 >> 16);
                    }
#pragma unroll
                    for (int nq = 0; nq < 2; ++nq) {
                        bf16x8 fn[4]; tr_frag4<4 * CB_STRIDE, 32>(ba + 32 * ks * CB_STRIDE + 128 * nq, fn[0], fn[1], fn[2], fn[3]);
#pragma unroll
                        for (int i = 0; i < 4; ++i) {
                            acc[0][4 * nq + i] = __builtin_amdgcn_mfma_f32_16x16x32_bf16(fn[i], sm0, acc[0][4 * nq + i], 0, 0, 0);
                            acc[1][4 * nq + i] = __builtin_amdgcn_mfma_f32_16x16x32_bf16(fn[i], sm1, acc[1][4 * nq + i], 0, 0, 0);
                        }
                    }
                }
                bf16_t* sp = STATES + ((size_t)(bc * 8 + g) * 4096 + (size_t)wave * 512 + lane) * 8;
#pragma unroll
                for (int mt = 0; mt < 2; ++mt)
#pragma unroll
                    for (int q = 0; q < 4; ++q) { const f32x4 a0 = acc[mt][2 * q], a1 = acc[mt][2 * q + 1];
                        u32x4 o; o.x = cvt_pk_bf16(a0[0], a0[1]); o.y = cvt_pk_bf16(a0[2], a0[3]); o.z = cvt_pk_bf16(a1[0], a1[1]); o.w = cvt_pk_bf16(a1[2], a1[3]);
                        __builtin_nontemporal_store(o, (u32x4*)(sp + (size_t)((mt * 4 + q) * 64) * 8)); }
            }
            __syncthreads();
            LAS unsigned char* sw = lds + 34816 + wave * (16 * CB_STRIDE);
            bf16_t* ydp = YD + ((size_t)(jj * 8 + wave) * 8 * 64 + lane) * 8;
#pragma unroll
            for (int k = 0; k < 4; ++k) {
                const int h = g * 4 + k; const float al = ac[k * 128 + l], dsk = A.d_skip[h];
#pragma unroll
                for (int nt = 0; nt < 8; ++nt) {
                    float sv[4];
#pragma unroll
                    for (int r = 0; r < 4; ++r) { const int s = 16 * nt + 4 * fq + r;
                        float v = (s <= l) ? cb[nt][r] * __expf(al - ac[k * 128 + s]) * dtl[k * 128 + s] : 0.f;
                        if (s == l) v += dsk; sv[r] = v; }
                    u32x2 o; o.x = cvt_pk_bf16(sv[0], sv[1]); o.y = cvt_pk_bf16(sv[2], sv[3]);
                    *(LAS u32x2*)(sw + fr * CB_STRIDE + (16 * nt + 4 * fq) * 2) = o;
                    if (nt & 1) asm volatile("" ::: "memory");
                }
                asm volatile("s_waitcnt lgkmcnt(0)" ::: "memory");
                f32x4 ay[4];
#pragma unroll
                for (int pt = 0; pt < 4; ++pt) ay[pt] = (f32x4){0.f, 0.f, 0.f, 0.f};
                const unsigned xa = lds_u32 + 69632 + (8 * fq + (fr >> 2)) * XS_STRIDE + (k * 64 + 4 * (lane & 3)) * 2;
#pragma unroll
                for (int ks = 0; ks < 4; ++ks) {
                    if (ks <= (wave >> 1)) {
                        const bf16x8 fs = *(const LAS bf16x8*)(sw + fr * CB_STRIDE + (32 * ks + 8 * fq) * 2);
                        bf16x8 fx[4]; tr_frag4<4 * XS_STRIDE, 32>(xa + 32 * ks * XS_STRIDE, fx[0], fx[1], fx[2], fx[3]);
#pragma unroll
                        for (int pt = 0; pt < 4; ++pt) ay[pt] = __builtin_amdgcn_mfma_f32_16x16x32_bf16(fx[pt], fs, ay[pt], 0, 0, 0);
                    }
                }
#pragma unroll
                for (int q = 0; q < 2; ++q) { u32x4 o; o.x = cvt_pk_bf16(ay[2 * q][0], ay[2 * q][1]); o.y = cvt_pk_bf16(ay[2 * q][2], ay[2 * q][3]); o.z = cvt_pk_bf16(ay[2 * q + 1][0], ay[2 * q + 1][1]); o.w = cvt_pk_bf16(ay[2 * q + 1][2], ay[2 * q + 1][3]); __builtin_nontemporal_store(o, (u32x4*)(ydp + (size_t)(k * 2 + q) * 512)); }
                __builtin_amdgcn_sched_barrier(0);
                asm volatile("s_waitcnt lgkmcnt(0)" ::: "memory");
            }
            __syncthreads();
        }
    }
    GRID_SYNC(3);

    if constexpr ((PH_MASK >> 3) & 1)
    for (int blk = bx; blk < 256; blk += G) {
        const int b = blk >> 6; const unsigned o8 = (unsigned)(blk & 63) * 512u + (unsigned)tid; const int h = (int)(o8 >> 10);
        const bf16_t* sbase = STATES + (size_t)(b * 32) * 262144; bf16_t* pbase = PREV + (size_t)(b * 32) * 262144;
        const unsigned voff = o8 * 8u;
        f32x4 h0 = {0.f, 0.f, 0.f, 0.f}, h1 = {0.f, 0.f, 0.f, 0.f};
#pragma unroll 1
        for (int cb0 = 0; cb0 < 32; cb0 += 16) {
            const bf16_t* sb = sbase + (size_t)cb0 * 262144; bf16_t* pb = pbase + (size_t)cb0 * 262144;
            u32x4 sv[16]; float cdv[16];
#pragma unroll
            for (int c = 0; c < 16; ++c) { sv[c] = __builtin_nontemporal_load((const u32x4*)(sb + (size_t)c * 262144 + voff)); cdv[c] = CD[(b * 32 + cb0 + c) * 32 + h]; }
#pragma unroll
            for (int c = 0; c < 16; ++c) {
                u32x4 o; o.x = cvt_pk_bf16(h0[0], h0[1]); o.y = cvt_pk_bf16(h0[2], h0[3]); o.z = cvt_pk_bf16(h1[0], h1[1]); o.w = cvt_pk_bf16(h1[2], h1[3]);
                __builtin_nontemporal_store(o, (u32x4*)(pb + (size_t)c * 262144 + voff));
                const f32x4 s0 = {bflo(sv[c].x), bfhi(sv[c].x), bflo(sv[c].y), bfhi(sv[c].y)}, s1 = {bflo(sv[c].z), bfhi(sv[c].z), bflo(sv[c].w), bfhi(sv[c].w)};
                h0 = h0 * cdv[c] + s0; h1 = h1 * cdv[c] + s1;
            }
        }
    }
    GRID_SYNC(4);

    if constexpr ((PH_MASK >> 4) & 1)
    for (int j = bx; j < 1024; j += G) {
        const int g = j & 7, bc = j >> 3, tok0 = bc * 128;
        int tid = threadIdx.x; asm volatile("" : "+v"(tid));
        const int lane = tid & 63, fr = lane & 15, fq = lane >> 4;
        LAS float* ac = (LAS float*)lds; LAS float* adt = ac + 512;
        const int l = 16 * wave + fr;
        bf16x8 fc[4];
#pragma unroll
        for (int ks = 0; ks < 4; ++ks) fc[ks] = *(const bf16x8*)(CC + (size_t)(tok0 + l) * 1024 + g * 128 + 32 * ks + 8 * fq);
        {
            const bf16_t* pg = PREV + (size_t)(bc * 8 + g) * 4096 * 8;
            u32x4 pv[8];
#pragma unroll
            for (int i = 0; i < 8; ++i) pv[i] = __builtin_nontemporal_load((const u32x4*)(pg + ((size_t)i * 512 + tid) * 8));
            const int mt_ = (tid >> 8) & 1, q_ = (tid >> 6) & 3, fr_ = tid & 15, fq_ = (tid >> 4) & 3;
#pragma unroll
            for (int i = 0; i < 8; ++i) { const int row = (i >> 1) * 64 + 32 * (i & 1) + 8 * (fr_ >> 2) + 4 * mt_ + (fr_ & 3);
                *(LAS u32x4*)(lds + 4096 + row * CB_STRIDE + (32 * q_ + 8 * fq_) * 2) = pv[i]; }
        }
        (void)chunk_prefix(adt, ac, DT, A.a_log, tok0, g, tid);
        f32x4 y[4][4];
        float ss = 0.f;
        bf16_t* zp = YAB + (size_t)(tok0 + l) * 4096 + 2048 + g * 256 + 8 * fq;
        const bf16_t* ydp = YD + ((size_t)(j * 8 + wave) * 8 * 64 + lane) * 8;
        const int prow0 = pg8::perm32(fr), prow1 = pg8::perm32(16 + fr);
#pragma unroll
        for (int k = 0; k < 4; ++k) {
            const int h = g * 4 + k; const float ea = __expf(ac[k * 128 + l]);
            const LAS unsigned char* pp = lds + 4096 + (k * 64) * CB_STRIDE + 16 * fq;
            f32x4 ao[4];
#pragma unroll
            for (int pt = 0; pt < 4; ++pt) ao[pt] = (f32x4){0.f, 0.f, 0.f, 0.f};
            u32x4 zv4[2], yv4[2];
#pragma unroll
            for (int q = 0; q < 2; ++q) { zv4[q] = *(const u32x4*)(zp + k * 64 + q * 32); yv4[q] = __builtin_nontemporal_load((const u32x4*)(ydp + (size_t)(k * 2 + q) * 512)); }
#pragma unroll
            for (int ks = 0; ks < 4; ++ks) {
                bf16x8 fpw[4];
#pragma unroll
                for (int pt = 0; pt < 4; ++pt) fpw[pt] = *(const LAS bf16x8*)(pp + (32 * (pt >> 1) + ((pt & 1) ? prow1 : prow0)) * CB_STRIDE + 64 * ks);
#pragma unroll
                for (int pt = 0; pt < 4; ++pt) ao[pt] = __builtin_amdgcn_mfma_f32_16x16x32_bf16(fpw[pt], fc[ks], ao[pt], 0, 0, 0);
            }
#pragma unroll
            for (int pt = 0; pt < 4; ++pt) { const u32x4 z4 = zv4[pt >> 1], y4 = yv4[pt >> 1];
                const unsigned zlo = (pt & 1) ? z4.z : z4.x, zhi = (pt & 1) ? z4.w : z4.y, ylo = (pt & 1) ? y4.z : y4.x, yhi = (pt & 1) ? y4.w : y4.y;
                f32x4 v = ao[pt] * ea; v[0] = (v[0] + bflo(ylo)) * bflo(zlo); v[1] = (v[1] + bfhi(ylo)) * bfhi(zlo); v[2] = (v[2] + bflo(yhi)) * bflo(zhi); v[3] = (v[3] + bfhi(yhi)) * bfhi(zhi);
                ss += (v[0] * v[0] + v[1] * v[1]) + (v[2] * v[2] + v[3] * v[3]); y[k][pt] = v; }
            __builtin_amdgcn_sched_barrier(0);
        }
        ss += __shfl_xor(ss, 16); ss += __shfl_xor(ss, 32);
        const float rstd = 1.0f / sqrtf(ss * (1.0f / 256.0f) + EPS);
        const float* nw = A.ssm_nw + g * 256 + 8 * fq;
        u32x4 ov[4][2];
#pragma unroll
        for (int k = 0; k < 4; ++k)
#pragma unroll
            for (int q = 0; q < 2; ++q) { const f32x4 w0 = *(const f32x4*)(nw + k * 64 + q * 32), w1 = *(const f32x4*)(nw + k * 64 + q * 32 + 4); const f32x4 v0 = y[k][2 * q], v1 = y[k][2 * q + 1];
                ov[k][q].x = cvt_pk_bf16(v0[0] * rstd * w0[0], v0[1] * rstd * w0[1]); ov[k][q].y = cvt_pk_bf16(v0[2] * rstd * w0[2], v0[3] * rstd * w0[3]);
                ov[k][q].z = cvt_pk_bf16(v1[0] * rstd * w1[0], v1[1] * rstd * w1[1]); ov[k][q].w = cvt_pk_bf16(v1[2] * rstd * w1[2], v1[3] * rstd * w1[3]); }
#pragma unroll
        for (int k = 0; k < 4; ++k)
#pragma unroll
            for (int q = 0; q < 2; ++q) *(u32x4*)(zp + k * 64 + q * 32) = ov[k][q];
        __syncthreads();
    }
    GRID_SYNC(5);

    if constexpr ((PH_MASK >> 5) & 1)
    {
        pg8::Gemm g{YAB, WbT, M_TOK, DM, DM, 2 * DM}; SplitKOrder S; S.init(M_TOK, DM, G, bx, WGM_P5);
        EpiMerge E{RG, GB, MERGED};
        pg8::gemm_phase<EpiMerge, SplitKOrder, true, true>(lds, g, S, E);
    }
    GRID_SYNC(6);

    if constexpr ((PH_MASK >> 6) & 1)
    {
        pg8::Gemm g{MERGED, WoT, M_TOK, DM, DM, DM}; pg8::StaticOrder S; S.init(M_TOK, DM, G, bx, WGM_P6);
        EpiAcc E{YAB};
        pg8::gemm_phase<EpiAcc, pg8::StaticOrder, true, true>(lds, g, S, E);
    }
    GRID_SYNC(7);

    if constexpr ((PH_MASK >> 7) & 1)
    for (int m = gw; m < M_TOK; m += 2 * NGW) {
        const int m2 = m + NGW;
        int tid_ = threadIdx.x; asm volatile("" : "+v"(tid_)); const int lane = tid_ & 63;
        const f32x4* xr = (const f32x4*)(A.x + (size_t)m * DM) + lane; const f32x4* xr2 = (const f32x4*)(A.x + (size_t)m2 * DM) + lane;
        const u32x2* ar = (const u32x2*)(YAB + (size_t)m * DM) + lane; const u32x2* ar2 = (const u32x2*)(YAB + (size_t)m2 * DM) + lane;
        const f32x4* wr4 = (const f32x4*)A.fnw + lane;
        f32x4 v[8], v2[8]; u32x2 a[8], a2[8]; float s = 0.f, s2 = 0.f;
#pragma unroll
        for (int j = 0; j < 8; ++j) { v[j] = __builtin_nontemporal_load(xr + 64 * j); v2[j] = __builtin_nontemporal_load(xr2 + 64 * j); a[j] = __builtin_nontemporal_load(ar + 64 * j); a2[j] = __builtin_nontemporal_load(ar2 + 64 * j); }
#pragma unroll
        for (int j = 0; j < 8; ++j) {
            v[j][0] += bflo(a[j].x); v[j][1] += bfhi(a[j].x); v[j][2] += bflo(a[j].y); v[j][3] += bfhi(a[j].y);
            v2[j][0] += bflo(a2[j].x); v2[j][1] += bfhi(a2[j].x); v2[j][2] += bflo(a2[j].y); v2[j][3] += bfhi(a2[j].y);
            s += (v[j][0] * v[j][0] + v[j][1] * v[j][1]) + (v[j][2] * v[j][2] + v[j][3] * v[j][3]); s2 += (v2[j][0] * v2[j][0] + v2[j][1] * v2[j][1]) + (v2[j][2] * v2[j][2] + v2[j][3] * v2[j][3]); }
        const float rstd = 1.0f / sqrtf(wave_sum(s) * (1.0f / DM) + EPS), rstd2 = 1.0f / sqrtf(wave_sum(s2) * (1.0f / DM) + EPS);
        f32x4* orow = (f32x4*)(A.out + (size_t)m * DM) + lane; f32x4* orow2 = (f32x4*)(A.out + (size_t)m2 * DM) + lane;
#pragma unroll
        for (int j = 0; j < 8; ++j) { const f32x4 w4 = wr4[64 * j]; __builtin_nontemporal_store(v[j] * rstd * w4, orow + 64 * j); __builtin_nontemporal_store(v2[j] * rstd2 * w4, orow2 + 64 * j); }
    }
#ifdef SPIN_SUB
    if (bx == 0 && tid == 0) {
        const unsigned long long* st = (const unsigned long long*)(BAR + 16) + 16;
        const unsigned long long d = (st[SPIN_SUB + 1] - st[SPIN_SUB]) * SPIN_MULT, t0 = __builtin_amdgcn_s_memrealtime();
        while (__builtin_amdgcn_s_memrealtime() - t0 < d) __builtin_amdgcn_s_sleep(10);
    }
#endif
#ifdef SPIN_PHASE
    STAMP(8);
    if (bx == 0 && tid == 0) {
        const unsigned long long* st = (const unsigned long long*)(BAR + 16);
        const unsigned long long d = (st[SPIN_PHASE + 1] - st[SPIN_PHASE]) * SPIN_MULT, t0 = __builtin_amdgcn_s_memrealtime();
        while (__builtin_amdgcn_s_memrealtime() - t0 < d) __builtin_amdgcn_s_sleep(10);
    }
#endif
}

extern "C" void kernel_launch(void* const* d_in, const int* in_sizes, int n_in, void* d_out, int out_size, void* d_ws, size_t ws_size, hipStream_t stream) {
    static int grid = 0;
    if (grid == 0) {
        if (n_in != 17 || out_size != M_TOK * DM || ws_size < WS_END) { fprintf(stderr, "kernel_launch: unexpected shapes (n_in %d out %d ws %zu)\n", n_in, out_size, ws_size); grid = -1; return; }
        int dev = 0, cus = 0, per_cu = 0;
        hipGetDevice(&dev); hipDeviceGetAttribute(&cus, hipDeviceAttributeMultiprocessorCount, dev);
        if (hipFuncSetAttribute((const void*)fwd_megakernel, hipFuncAttributeMaxDynamicSharedMemorySize, LDS_BYTES) != hipSuccess) { fprintf(stderr, "kernel_launch: hipFuncSetAttribute failed\n"); grid = -1; return; }
        if (hipOccupancyMaxActiveBlocksPerMultiprocessor(&per_cu, (const void*)fwd_megakernel, NT, LDS_BYTES) != hipSuccess || per_cu < 1) { fprintf(stderr, "kernel_launch: occupancy query says %d\n", per_cu); per_cu = 1; }
        (void)hipGetLastError();
        grid = cus * 1;
    }
    if (grid < 0) return;
    Args a{};
    a.x = (const float*)d_in[0]; a.norm_w = (const float*)d_in[1]; a.w_in = (const float*)d_in[2]; a.b_gate = (const float*)d_in[3]; a.ln_w = (const float*)d_in[4]; a.ln_b = (const float*)d_in[5];
    a.w_sp = (const float*)d_in[6]; a.b_sp = (const float*)d_in[7]; a.conv_w = (const float*)d_in[8]; a.conv_b = (const float*)d_in[9]; a.dt_bias = (const float*)d_in[10]; a.a_log = (const float*)d_in[11];
    a.d_skip = (const float*)d_in[12]; a.ssm_nw = (const float*)d_in[13]; a.w_branch = (const float*)d_in[14]; a.w_out = (const float*)d_in[15]; a.fnw = (const float*)d_in[16];
    a.out = (float*)d_out; a.ws = (unsigned char*)d_ws;
    void* args[] = {&a};
    hipError_t e = hipLaunchCooperativeKernel((const void*)fwd_megakernel, dim3(grid), dim3(NT), args, LDS_BYTES, stream);
    if (e != hipSuccess) fprintf(stderr, "cooperative launch failed: %s (grid %d)\n", hipGetErrorString(e), grid);
}
```

```cpp
#define WGM_P1 8
#include <hip/hip_runtime.h>
#include <hip/hip_cooperative_groups.h>
#include <cstdio>
#include <cstdint>
namespace cg = cooperative_groups;
namespace pg8 {
#define PG8_LAS __attribute__((address_space(3)))
typedef unsigned short bf16_t;
typedef short bf16x8 __attribute__((ext_vector_type(8)));
typedef float f32x4 __attribute__((ext_vector_type(4)));
typedef unsigned u32x4 __attribute__((ext_vector_type(4)));
constexpr int BM = 256, BK = 64, HALF = 128, HTB = HALF * BK * 2  , STAGE_BYTES = 8 * HTB, NXCD = 8, WGM = 8;

__host__ __device__ __forceinline__ int lds_byte(int r, int c) { const int st = (r >> 4) * 2 + (c >> 5), rr = r & 15, cc = c & 31, ob = rr * 64 + cc * 2; return st * 1024 + (ob ^ (((ob >> 9) & 1) << 5)); }
__host__ __device__ __forceinline__ void stage_rc(int b, int& R, int& C) { const int st = b / 1024, sb = b % 1024, swz = sb ^ (((sb >> 9) & 1) << 5); R = (st >> 1) * 16 + swz / 64; C = (st & 1) * 32 + (swz % 64) / 2; }
__host__ __device__ __forceinline__ int perm32(int rho) { const int n = rho >> 4, i = rho & 15; return 8 * (i >> 2) + 4 * n + (i & 3); }

struct Unit { int pm, pn, kh; };
struct Gemm { const bf16_t* A; const bf16_t* Bt; int M, N, K, ld; };

struct StaticOrder {
    int nM, nN, nwg, G, c, wgm;
    __host__ __device__ void init(int M, int N, int G_, int c_, int wgm_ = WGM) { nM = M / BM; nN = N / BM; nwg = nM * nN; G = G_; c = c_; wgm = wgm_; }
    __host__ __device__ bool next(int i, Unit& u) const {
        const long L = (long)i * G + c; if (L >= nwg) return false;
        int wgid = (int)L; { const int q = nwg / NXCD, r = nwg % NXCD, xcd = wgid % NXCD, off = wgid / NXCD; wgid = (xcd < r ? xcd * (q + 1) : r * (q + 1) + (xcd - r) * q) + off; }
        const int nig = wgm * nN, gid = wgid / nig, fm = gid * wgm, gsz = (nM - fm) < wgm ? (nM - fm) : wgm;
        u.pm = fm + ((wgid % nig) % gsz); u.pn = (wgid % nig) / gsz; u.kh = 0; return true;
    }
    __device__ __forceinline__ void a_ready(const Unit&) const {}
    __device__ __forceinline__ void done(const Unit&) const {}
};
typedef float f32x2_t_ __attribute__((ext_vector_type(2)));
typedef __bf16 bf16x2_t_ __attribute__((ext_vector_type(2)));
__device__ __forceinline__ unsigned cvt_pk_bf16(float lo, float hi) { const f32x2_t_ v = {lo, hi}; const bf16x2_t_ b = __builtin_convertvector(v, bf16x2_t_); return __builtin_bit_cast(unsigned, b); }
template <class Epi, class Sched, bool ALIGN_EPI = false, bool SP2 = false>
__device__ __forceinline__ void gemm_phase(PG8_LAS unsigned char* lds, const Gemm g, const Sched& S, const Epi& E) {
    int tid_ = threadIdx.x; asm volatile("" : "+v"(tid_));
    const int tid = tid_, wid = __builtin_amdgcn_readfirstlane(tid >> 6), lane = tid & 63, wr = wid >> 2, wc = wid & 3, fr = lane & 15, fq = lane >> 4;
    const int K = g.K, nt = K / BK, ld = g.ld;
    unsigned voffA[2], voffB[2];
#pragma unroll
    for (int i = 0; i < 2; ++i) { int R, C; stage_rc(tid * 16 + i * 8192, R, C); const int Rb = Epi::PERM ? ((R & ~31) + perm32(R & 31)) : R;
        voffA[i] = (unsigned)(R * ld + C) * 2u; voffB[i] = (unsigned)(Rb * ld + C) * 2u; }
    const size_t kstep = (size_t)(BK * 2);
    const size_t hstep = (size_t)HALF * ld * 2;
    const size_t tstep = 2 * hstep;
    const unsigned ldsw = (unsigned)wid * 1024u;
    const int aoff = lds_byte(wr * 64 + fr, fq * 8), boff = lds_byte(wc * 32 + fr, fq * 8);
#define PG8_SA(b, h) (((b) * 2 + (h)) * HTB)
#define PG8_SB(b, h) ((4 + (b) * 2 + (h)) * HTB)
#define PG8_STAGE(bufoff, gbase, voff) do { _Pragma("unroll") for (int _i = 0; _i < 2; ++_i) \
        __builtin_amdgcn_global_load_lds((const unsigned*)((const char*)(gbase) + (voff)[_i]), (PG8_LAS unsigned*)(lds + (bufoff) + ldsw + _i * 8192), 16, 0, 0); } while (0)
#define PG8_LDA(dst, b, h) do { _Pragma("unroll") for (int m = 0; m < 4; ++m) _Pragma("unroll") for (int k = 0; k < 2; ++k) dst[m][k] = *(const PG8_LAS bf16x8*)(lds + PG8_SA(b, h) + aoff + m * 2048 + k * 1024); } while (0)
#define PG8_LDB(dst, b, h) do { _Pragma("unroll") for (int n = 0; n < 2; ++n) _Pragma("unroll") for (int k = 0; k < 2; ++k) dst[n][k] = *(const PG8_LAS bf16x8*)(lds + PG8_SB(b, h) + boff + n * 2048 + k * 1024); } while (0)
#define PG8_MMA(ai, bj, At, Bt) do { __builtin_amdgcn_s_setprio(1); _Pragma("unroll") for (int m = 0; m < 4; ++m) _Pragma("unroll") for (int n = 0; n < 2; ++n) _Pragma("unroll") for (int k = 0; k < 2; ++k) \
        acc[ai][bj][m][n] = __builtin_amdgcn_mfma_f32_16x16x32_bf16(Bt[n][k], At[m][k], acc[ai][bj][m][n], 0, 0, 0); __builtin_amdgcn_s_setprio(0); } while (0)
#define PG8_WAIT_V(n) asm volatile("s_waitcnt vmcnt(" #n ")" ::: "memory")
#define PG8_WAIT_L(n) asm volatile("s_waitcnt lgkmcnt(" #n ")" ::: "memory")
#define PG8_BAR __builtin_amdgcn_s_barrier()
#define PG8_SCHED __builtin_amdgcn_sched_barrier(0)
    Unit cur, nxt; int ui = 0;
    if (!S.next(0, cur)) return;
    f32x4 acc[2][2][4][2];
#pragma unroll
    for (int a = 0; a < 2; ++a)
#pragma unroll
        for (int b = 0; b < 2; ++b)
#pragma unroll
            for (int m = 0; m < 4; ++m)
#pragma unroll
                for (int n = 0; n < 2; ++n) acc[a][b][m][n] = (f32x4){0.f, 0.f, 0.f, 0.f};
    bf16x8 At[4][2], B0[2][2], B1[2][2];
    const char* cA = (const char*)g.A + (size_t)cur.pm * tstep + (size_t)cur.kh * K * 2; const char* cB = (const char*)g.Bt + (size_t)cur.pn * tstep + (size_t)cur.kh * K * 2;
    S.a_ready(cur);
    if constexpr (SP2) {
        PG8_STAGE(PG8_SB(0, 0), cB, voffB); PG8_STAGE(PG8_SB(0, 1), cB + hstep, voffB); PG8_STAGE(PG8_SA(0, 0), cA, voffA); PG8_STAGE(PG8_SA(0, 1), cA + hstep, voffA);
        if (wr == 1) PG8_BAR;
        PG8_WAIT_V(2); PG8_BAR;
        PG8_STAGE(PG8_SB(1, 0), cB + kstep, voffB); PG8_STAGE(PG8_SA(1, 0), cA + kstep, voffA); PG8_STAGE(PG8_SB(1, 1), cB + hstep + kstep, voffB);
        PG8_WAIT_V(6); PG8_BAR;
    } else {
        PG8_STAGE(PG8_SB(0, 0), cB, voffB); PG8_STAGE(PG8_SA(0, 0), cA, voffA); PG8_STAGE(PG8_SB(0, 1), cB + hstep, voffB); PG8_STAGE(PG8_SA(0, 1), cA + hstep, voffA);
        if (wr == 1) PG8_BAR;
        PG8_WAIT_V(4); PG8_BAR;
        PG8_STAGE(PG8_SB(1, 0), cB + kstep, voffB); PG8_STAGE(PG8_SA(1, 0), cA + kstep, voffA); PG8_STAGE(PG8_SB(1, 1), cB + hstep + kstep, voffB);
        PG8_WAIT_V(6); PG8_BAR;
    }
    for (;;) {
        const bool has_next = S.next(ui + 1, nxt);
        const char* nA = has_next ? (const char*)g.A + (size_t)nxt.pm * tstep + (size_t)nxt.kh * K * 2 : cA; const char* nB = has_next ? (const char*)g.Bt + (size_t)nxt.pn * tstep + (size_t)nxt.kh * K * 2 : cB;
        for (int t = 0; t < nt; t += 2) {
            const bool last = (t == nt - 2);
            const char* a1 = cA + (size_t)(t + 1) * kstep;
            const char* a2 = last ? nA : cA + (size_t)(t + 2) * kstep; const char* b2 = last ? nB : cB + (size_t)(t + 2) * kstep;
            const char* a3 = a2 + kstep; const char* b3 = b2 + kstep;
            if (last && has_next) S.a_ready(nxt);
            if constexpr (SP2) {
            PG8_LDB(B0, 0, 0); PG8_LDB(B1, 0, 1); PG8_SCHED; PG8_LDA(At, 0, 0); PG8_STAGE(PG8_SA(1, 1), a1 + hstep, voffA);
            PG8_WAIT_V(8); PG8_WAIT_L(0); PG8_BAR; PG8_MMA(0, 0, At, B0); PG8_MMA(0, 1, At, B1); PG8_BAR; PG8_SCHED;
            PG8_LDA(At, 0, 1); PG8_STAGE(PG8_SB(0, 0), b2, voffB); PG8_STAGE(PG8_SB(0, 1), b2 + hstep, voffB); PG8_STAGE(PG8_SA(0, 0), a2, voffA);
            PG8_WAIT_V(8); PG8_WAIT_L(0); PG8_BAR; PG8_MMA(1, 0, At, B0); PG8_MMA(1, 1, At, B1); PG8_BAR; PG8_SCHED;
            PG8_LDB(B0, 1, 0); PG8_LDB(B1, 1, 1); PG8_SCHED; PG8_LDA(At, 1, 0); PG8_STAGE(PG8_SA(0, 1), a2 + hstep, voffA);
            PG8_WAIT_V(8); PG8_WAIT_L(0); PG8_BAR; PG8_MMA(0, 0, At, B0); PG8_MMA(0, 1, At, B1); PG8_BAR; PG8_SCHED;
            PG8_LDA(At, 1, 1); PG8_STAGE(PG8_SB(1, 0), b3, voffB); PG8_STAGE(PG8_SB(1, 1), b3 + hstep, voffB); PG8_STAGE(PG8_SA(1, 0), a3, voffA);
            PG8_WAIT_V(8); PG8_WAIT_L(0); PG8_BAR; PG8_MMA(1, 0, At, B0); PG8_MMA(1, 1, At, B1); PG8_BAR; PG8_SCHED;
            } else {
            PG8_LDB(B0, 0, 0); PG8_SCHED; PG8_LDA(At, 0, 0); PG8_STAGE(PG8_SA(1, 1), a1 + hstep, voffA);
            PG8_WAIT_L(8); PG8_BAR; PG8_WAIT_L(0); PG8_MMA(0, 0, At, B0); PG8_BAR; PG8_SCHED;
            PG8_LDB(B1, 0, 1); PG8_STAGE(PG8_SB(0, 0), b2, voffB);
            PG8_BAR; PG8_WAIT_L(0); PG8_MMA(0, 1, At, B1); PG8_BAR;
            PG8_LDA(At, 0, 1); PG8_STAGE(PG8_SA(0, 0), a2, voffA);
            PG8_BAR; PG8_WAIT_L(0); PG8_MMA(1, 0, At, B0); PG8_BAR; PG8_SCHED;
            PG8_STAGE(PG8_SB(0, 1), b2 + hstep, voffB);
            PG8_WAIT_V(6); PG8_BAR; PG8_MMA(1, 1, At, B1); PG8_BAR;
            PG8_LDB(B0, 1, 0); PG8_SCHED; PG8_LDA(At, 1, 0); PG8_STAGE(PG8_SA(0, 1), a2 + hstep, voffA);
            PG8_WAIT_L(8); PG8_BAR; PG8_WAIT_L(0); PG8_MMA(0, 0, At, B0); PG8_BAR; PG8_SCHED;
            PG8_LDB(B1, 1, 1); PG8_STAGE(PG8_SB(1, 0), b3, voffB);
            PG8_BAR; PG8_WAIT_L(0); PG8_MMA(0, 1, At, B1); PG8_BAR;
            PG8_LDA(At, 1, 1); PG8_STAGE(PG8_SA(1, 0), a3, voffA);
            PG8_BAR; PG8_WAIT_L(0); PG8_MMA(1, 0, At, B0); PG8_BAR; PG8_SCHED;
            PG8_STAGE(PG8_SB(1, 1), b3 + hstep, voffB);
            PG8_WAIT_V(6); PG8_BAR; PG8_MMA(1, 1, At, B1); PG8_BAR;
            }
        }
        if constexpr (ALIGN_EPI) { if (wr == 0) PG8_BAR; }
        if constexpr (!Epi::AFTER_DRAIN) { E(acc, cur, wr, wc, fr, fq); S.done(cur); }
        if (!has_next) break;
        if (!E.keep(cur))
#pragma unroll
        for (int a = 0; a < 2; ++a)
#pragma unroll
            for (int b = 0; b < 2; ++b)
#pragma unroll
                for (int m = 0; m < 4; ++m)
#pragma unroll
                    for (int n = 0; n < 2; ++n) acc[a][b][m][n] = (f32x4){0.f, 0.f, 0.f, 0.f};
        cur = nxt; cA = nA; cB = nB; ++ui;
        if constexpr (ALIGN_EPI) { if (wr == 1) PG8_BAR; }
    }
    PG8_WAIT_V(0);
    if constexpr (!ALIGN_EPI) { if (wr == 0) PG8_BAR; }
    PG8_BAR;
    if constexpr (Epi::AFTER_DRAIN) { E.fused(acc, cur, wr, wc, fr, fq, lds, wid, lane); S.done(cur); }
#undef PG8_SA
#undef PG8_SB
#undef PG8_STAGE
#undef PG8_LDA
#undef PG8_LDB
#undef PG8_MMA
#undef PG8_WAIT_V
#undef PG8_WAIT_L
#undef PG8_BAR
#undef PG8_SCHED
}
}

#define LAS __attribute__((address_space(3)))
using pg8::bf16_t; using pg8::bf16x8; using pg8::f32x4; using pg8::u32x4; using pg8::cvt_pk_bf16;
typedef unsigned u32x2 __attribute__((ext_vector_type(2)));
typedef short s16x4 __attribute__((ext_vector_type(4)));

constexpr int NT = 512, NWAVES = 8;
constexpr int M_TOK = 16384, DM = 2048, SEQ = 4096, NCH = 32, CL_ = 128;
constexpr int NIN = 16416;
constexpr int NPROJ = 16384;
constexpr float EPS = 1e-5f;
constexpr int LDS_BYTES = 147456;
#ifndef WGM_P1
#define WGM_P1 4
#endif
#ifndef WGM_P5
#define WGM_P5 4
#endif
#ifndef WGM_P6
#define WGM_P6 4
#endif
#ifndef PH_MASK
#define PH_MASK 0xFF
#endif

constexpr size_t MiB = 1048576;
constexpr size_t WS_BAR = 3 * MiB + 65536;
constexpr size_t WS_WDT = 0, WS_WSB = 131072, WS_STATS = 393216, WS_SSQ = 524288, WS_CD = 589824, WS_DT = 1 * MiB;
constexpr size_t WS_WB = 4 * MiB, WS_WO = 20 * MiB, WS_YAB = 28 * MiB, WS_V = 156 * MiB, WS_XBC = 220 * MiB, WS_R = 348 * MiB, WS_GB = 412 * MiB, WS_CC = 476 * MiB, WS_END = 508 * MiB;

__device__ __forceinline__ float bf2f(unsigned short u) { return __uint_as_float(((unsigned)u) << 16); }
__device__ __forceinline__ float bflo(unsigned w) { return __uint_as_float(w << 16); }
__device__ __forceinline__ float bfhi(unsigned w) { return __uint_as_float(w & 0xffff0000u); }
__device__ __forceinline__ float silu_f(float v) { return v * __builtin_amdgcn_rcpf(1.0f + __expf(-v)); }
__device__ __forceinline__ float sigmoid_f(float v) { return __builtin_amdgcn_rcpf(1.0f + __expf(-v)); }
__device__ __forceinline__ float wave_sum(float v) {
#pragma unroll
    for (int o = 1; o < 64; o <<= 1) v += __shfl_xor(v, o);
    return v;
}
__device__ __forceinline__ void atomic_addf(float* p, float v) { __hip_atomic_fetch_add(p, v, __ATOMIC_RELAXED, __HIP_MEMORY_SCOPE_AGENT); }

template <int OFF> __device__ __forceinline__ bf16x8 tr_frag(unsigned a) {
    s16x4 lo, hi;
    asm volatile("ds_read_b64_tr_b16 %0, %2\n\tds_read_b64_tr_b16 %1, %2 offset:%3\n\ts_waitcnt lgkmcnt(0)" : "=&v"(lo), "=&v"(hi) : "v"(a), "n"(OFF) : "memory");
    return (bf16x8){lo[0], lo[1], lo[2], lo[3], hi[0], hi[1], hi[2], hi[3]};
}

template <int OFF, int STEP> __device__ __forceinline__ void tr_frag2(unsigned a, bf16x8& f0, bf16x8& f1) {
    s16x4 l0, h0, l1, h1;
    asm volatile("ds_read_b64_tr_b16 %0, %4\n\tds_read_b64_tr_b16 %1, %4 offset:%5\n\tds_read_b64_tr_b16 %2, %4 offset:%6\n\tds_read_b64_tr_b16 %3, %4 offset:%7\n\ts_waitcnt lgkmcnt(0)"
                 : "=&v"(l0), "=&v"(h0), "=&v"(l1), "=&v"(h1) : "v"(a), "n"(OFF), "n"(STEP), "n"(STEP + OFF) : "memory");
    f0 = (bf16x8){l0[0], l0[1], l0[2], l0[3], h0[0], h0[1], h0[2], h0[3]}; f1 = (bf16x8){l1[0], l1[1], l1[2], l1[3], h1[0], h1[1], h1[2], h1[3]};
}
template <int OFF, int STEP> __device__ __forceinline__ void tr_frag4(unsigned a, bf16x8& f0, bf16x8& f1, bf16x8& f2, bf16x8& f3) {
    s16x4 l0, h0, l1, h1, l2, h2, l3, h3;
    asm volatile("ds_read_b64_tr_b16 %0, %8\n\tds_read_b64_tr_b16 %1, %8 offset:%9\n\tds_read_b64_tr_b16 %2, %8 offset:%10\n\tds_read_b64_tr_b16 %3, %8 offset:%11\n\t"
                 "ds_read_b64_tr_b16 %4, %8 offset:%12\n\tds_read_b64_tr_b16 %5, %8 offset:%13\n\tds_read_b64_tr_b16 %6, %8 offset:%14\n\tds_read_b64_tr_b16 %7, %8 offset:%15\n\ts_waitcnt lgkmcnt(0)"
                 : "=&v"(l0), "=&v"(h0), "=&v"(l1), "=&v"(h1), "=&v"(l2), "=&v"(h2), "=&v"(l3), "=&v"(h3)
                 : "v"(a), "n"(OFF), "n"(STEP), "n"(STEP + OFF), "n"(2 * STEP), "n"(2 * STEP + OFF), "n"(3 * STEP), "n"(3 * STEP + OFF) : "memory");
    f0 = (bf16x8){l0[0], l0[1], l0[2], l0[3], h0[0], h0[1], h0[2], h0[3]}; f1 = (bf16x8){l1[0], l1[1], l1[2], l1[3], h1[0], h1[1], h1[2], h1[3]};
    f2 = (bf16x8){l2[0], l2[1], l2[2], l2[3], h2[0], h2[1], h2[2], h2[3]}; f3 = (bf16x8){l3[0], l3[1], l3[2], l3[3], h3[0], h3[1], h3[2], h3[3]};
}

struct Args {
    const float* x; const float* norm_w; const float* w_in; const float* b_gate; const float* ln_w; const float* ln_b; const float* w_sp; const float* b_sp;
    const float* conv_w; const float* conv_b; const float* dt_bias; const float* a_log; const float* d_skip; const float* ssm_nw; const float* w_branch; const float* w_out; const float* fnw;
    float* out; unsigned char* ws;
};

struct EpiProj {
    static constexpr bool PERM = true, AFTER_DRAIN = false;
    __device__ __forceinline__ bool keep(const pg8::Unit&) const { return false; }
    bf16_t* YAB; bf16_t* V; bf16_t* XBC; bf16_t* R; bf16_t* GB; float* stats; const float* b_gate;
    __device__ __forceinline__ void operator()(const f32x4 (&acc)[2][2][4][2], const pg8::Unit& u, int wr, int wc, int fr, int fq) const {
        const int row0 = u.pm * 256 + wr * 64 + fr, pn = u.pn, cl = wc * 32 + 8 * fq;
        if (pn < 16) {
#pragma unroll
            for (int ai = 0; ai < 2; ++ai)
#pragma unroll
                for (int m = 0; m < 4; ++m) {
                    const f32x4 u0 = acc[ai][0][m][0], u1 = acc[ai][0][m][1], z0 = acc[ai][1][m][0], z1 = acc[ai][1][m][1];
                    u32x4 w;
                    w.x = cvt_pk_bf16(silu_f(z0[0]) * u0[0], silu_f(z0[1]) * u0[1]); w.y = cvt_pk_bf16(silu_f(z0[2]) * u0[2], silu_f(z0[3]) * u0[3]);
                    w.z = cvt_pk_bf16(silu_f(z1[0]) * u1[0], silu_f(z1[1]) * u1[1]); w.w = cvt_pk_bf16(silu_f(z1[2]) * u1[2], silu_f(z1[3]) * u1[3]);
                    __builtin_nontemporal_store(w, (u32x4*)(YAB + (size_t)(row0 + ai * 128 + m * 16) * 4096 + pn * 128 + cl));
                }
        } else if (pn < 24) {
            const int c0 = (pn - 16) * 256 + cl;
#pragma unroll
            for (int ai = 0; ai < 2; ++ai)
#pragma unroll
                for (int m = 0; m < 4; ++m) {
                    const int row = row0 + ai * 128 + m * 16; float s = 0.f, q = 0.f;
#pragma unroll
                    for (int bj = 0; bj < 2; ++bj) {
                        const f32x4 v0 = acc[ai][bj][m][0], v1 = acc[ai][bj][m][1];
                        s += (v0[0] + v0[1]) + (v0[2] + v0[3]) + (v1[0] + v1[1]) + (v1[2] + v1[3]);
                        q += (v0[0] * v0[0] + v0[1] * v0[1]) + (v0[2] * v0[2] + v0[3] * v0[3]) + (v1[0] * v1[0] + v1[1] * v1[1]) + (v1[2] * v1[2] + v1[3] * v1[3]);
                        u32x4 w; w.x = cvt_pk_bf16(v0[0], v0[1]); w.y = cvt_pk_bf16(v0[2], v0[3]); w.z = cvt_pk_bf16(v1[0], v1[1]); w.w = cvt_pk_bf16(v1[2], v1[3]);
                        __builtin_nontemporal_store(w, (u32x4*)(V + (size_t)row * 2048 + c0 + bj * 128));
                    }
                    s += __shfl_xor(s, 16); s += __shfl_xor(s, 32); q += __shfl_xor(q, 16); q += __shfl_xor(q, 32);
                    if (fq == 0) { atomic_addf(stats + 2 * row, s); atomic_addf(stats + 2 * row + 1, q); }
                }
        } else if (pn < 32) {
            const int c0 = (pn - 24) * 256 + cl;
#pragma unroll
            for (int ai = 0; ai < 2; ++ai)
#pragma unroll
                for (int m = 0; m < 4; ++m)
#pragma unroll
                    for (int bj = 0; bj < 2; ++bj) {
                        const f32x4 v0 = acc[ai][bj][m][0], v1 = acc[ai][bj][m][1];
                        u32x4 w; w.x = cvt_pk_bf16(silu_f(v0[0]), silu_f(v0[1])); w.y = cvt_pk_bf16(silu_f(v0[2]), silu_f(v0[3])); w.z = cvt_pk_bf16(silu_f(v1[0]), silu_f(v1[1])); w.w = cvt_pk_bf16(silu_f(v1[2]), silu_f(v1[3]));
                        __builtin_nontemporal_store(w, (u32x4*)(YAB + (size_t)(row0 + ai * 128 + m * 16) * 4096 + 2048 + c0 + bj * 128));
                    }
        } else if (pn < 48) {
            const int c0 = (pn - 32) * 256 + cl;
#pragma unroll
            for (int ai = 0; ai < 2; ++ai)
#pragma unroll
                for (int m = 0; m < 4; ++m)
#pragma unroll
                    for (int bj = 0; bj < 2; ++bj) {
                        const f32x4 v0 = acc[ai][bj][m][0], v1 = acc[ai][bj][m][1];
                        u32x4 w; w.x = cvt_pk_bf16(v0[0], v0[1]); w.y = cvt_pk_bf16(v0[2], v0[3]); w.z = cvt_pk_bf16(v1[0], v1[1]); w.w = cvt_pk_bf16(v1[2], v1[3]);
                        __builtin_nontemporal_store(w, (u32x4*)(XBC + (size_t)(row0 + ai * 128 + m * 16) * 4096 + c0 + bj * 128));
                    }
        } else {
            const int c0 = (pn - 48) * 128 + cl;
            const f32x4 ba0 = *(const f32x4*)(b_gate + c0), ba1 = *(const f32x4*)(b_gate + c0 + 4), bb0 = *(const f32x4*)(b_gate + 2048 + c0), bb1 = *(const f32x4*)(b_gate + 2048 + c0 + 4);
#pragma unroll
            for (int ai = 0; ai < 2; ++ai)
#pragma unroll
                for (int m = 0; m < 4; ++m) {
                    f32x4 a0 = acc[ai][0][m][0] + ba0, a1 = acc[ai][0][m][1] + ba1, b0 = acc[ai][1][m][0] + bb0, b1 = acc[ai][1][m][1] + bb1;
#pragma unroll
                    for (int j = 0; j < 4; ++j) { a0[j] = fminf(fmaxf(a0[j], -30.f), 30.f); a1[j] = fminf(fmaxf(a1[j], -30.f), 30.f); b0[j] = fminf(fmaxf(b0[j], -30.f), 30.f); b1[j] = fminf(fmaxf(b1[j], -30.f), 30.f); }
                    float ea[8], eb[8], rr[8], gb[8];
#pragma unroll
                    for (int j = 0; j < 4; ++j) { ea[j] = 1.0f + __expf(-a0[j]); ea[4 + j] = 1.0f + __expf(-a1[j]); eb[j] = 1.0f + __expf(-b0[j]); eb[4 + j] = 1.0f + __expf(-b1[j]); }
#pragma unroll
                    for (int j = 0; j < 8; ++j) { rr[j] = eb[j] * __builtin_amdgcn_rcpf(ea[j]); gb[j] = 1.0f * __builtin_amdgcn_rcpf(eb[j]); }
                    u32x4 wr_, wg_;
                    wr_.x = cvt_pk_bf16(rr[0], rr[1]); wr_.y = cvt_pk_bf16(rr[2], rr[3]); wr_.z = cvt_pk_bf16(rr[4], rr[5]); wr_.w = cvt_pk_bf16(rr[6], rr[7]);
                    wg_.x = cvt_pk_bf16(gb[0], gb[1]); wg_.y = cvt_pk_bf16(gb[2], gb[3]); wg_.z = cvt_pk_bf16(gb[4], gb[5]); wg_.w = cvt_pk_bf16(gb[6], gb[7]);
                    const size_t o = ((((((size_t)u.pm * 8 + ((pn - 48) >> 1)) * 2 + ((pn - 48) & 1)) * 2 + ai) * 4 + m) * 8 + (wr * 4 + wc)) * 512 + (size_t)(fr + 16 * fq) * 8;
                    __builtin_nontemporal_store(wr_, (u32x4*)(R + o)); __builtin_nontemporal_store(wg_, (u32x4*)(GB + o));
                }
        }
    }
};
__device__ __forceinline__ void merge_store(const bf16_t* __restrict__ GB, bf16_t* __restrict__ merged, const f32x4 (&acc)[2][2][4][2], int row0, int col0, size_t gbase, int wl) {
#pragma unroll
    for (int ai = 0; ai < 2; ++ai) {
        u32x4 gv[4][2];
#pragma unroll
        for (int m = 0; m < 4; ++m)
#pragma unroll
            for (int bj = 0; bj < 2; ++bj) gv[m][bj] = __builtin_nontemporal_load((const u32x4*)(GB + ((((gbase * 2 + bj) * 2 + ai) * 4 + m) * 8) * 512 + wl));
#pragma unroll
        for (int m = 0; m < 4; ++m)
#pragma unroll
            for (int bj = 0; bj < 2; ++bj) { const u32x4 g = gv[m][bj]; const f32x4 v0 = acc[ai][bj][m][0], v1 = acc[ai][bj][m][1];
                u32x4 w; w.x = cvt_pk_bf16(v0[0] * bflo(g.x), v0[1] * bfhi(g.x)); w.y = cvt_pk_bf16(v0[2] * bflo(g.y), v0[3] * bfhi(g.y));
                w.z = cvt_pk_bf16(v1[0] * bflo(g.z), v1[1] * bfhi(g.z)); w.w = cvt_pk_bf16(v1[2] * bflo(g.w), v1[3] * bfhi(g.w));
                *(u32x4*)(merged + (size_t)(row0 + ai * 128 + m * 16) * 2048 + col0 + bj * 128) = w; }
    }
}
struct EpiMerge {
    static constexpr bool PERM = true, AFTER_DRAIN = false;
    const bf16_t* R; const bf16_t* GB; bf16_t* merged;
    __device__ __forceinline__ bool keep(const pg8::Unit& u) const { return u.kh == 0; }
    __device__ __forceinline__ void operator()(f32x4 (&acc)[2][2][4][2], const pg8::Unit& u, int wr, int wc, int fr, int fq) const {
        const int row0 = u.pm * 256 + wr * 64 + fr, col0 = u.pn * 256 + wc * 32 + 8 * fq;
        const size_t gbase = (size_t)u.pm * 8 + u.pn; const int wl = (wr * 4 + wc) * 512 + (fr + 16 * fq) * 8;
        if (u.kh == 0) {
#pragma unroll
            for (int ai = 0; ai < 2; ++ai) {
                u32x4 rv[4][2];
#pragma unroll
                for (int m = 0; m < 4; ++m)
#pragma unroll
                    for (int bj = 0; bj < 2; ++bj) rv[m][bj] = __builtin_nontemporal_load((const u32x4*)(R + ((((gbase * 2 + bj) * 2 + ai) * 4 + m) * 8) * 512 + wl));
#pragma unroll
                for (int m = 0; m < 4; ++m)
#pragma unroll
                    for (int bj = 0; bj < 2; ++bj) { const u32x4 g = rv[m][bj];
                        f32x4 v0 = acc[ai][bj][m][0], v1 = acc[ai][bj][m][1];
                        v0[0] *= bflo(g.x); v0[1] *= bfhi(g.x); v0[2] *= bflo(g.y); v0[3] *= bfhi(g.y); v1[0] *= bflo(g.z); v1[1] *= bfhi(g.z); v1[2] *= bflo(g.w); v1[3] *= bfhi(g.w);
                        acc[ai][bj][m][0] = v0; acc[ai][bj][m][1] = v1; }
            }
        } else merge_store(GB, merged, acc, row0, col0, gbase, wl);
    }
};
struct SplitKOrder : pg8::StaticOrder {
    __device__ bool next(int i, pg8::Unit& u) const { const bool ok = pg8::StaticOrder::next(i >> 1, u); u.kh = i & 1; return ok; }
};
__device__ __forceinline__ void out_store(const float* __restrict__ x, float* __restrict__ out, float* __restrict__ ssq, const f32x4 (&acc)[2][2][4][2], int row0, int col0, int fq) {
    f32x4 xv[2][4];
#pragma unroll
    for (int bj = 0; bj < 2; ++bj)
#pragma unroll
        for (int n = 0; n < 2; ++n) xv[0][bj * 2 + n] = *(const f32x4*)(x + (size_t)row0 * 2048 + col0 + bj * 128 + n * 16);
#pragma unroll
    for (int gi = 0; gi < 8; ++gi) {
        const int ai = gi >> 2, m = gi & 3;
        if (gi < 7) { const int ai2 = (gi + 1) >> 2, m2 = (gi + 1) & 3;
#pragma unroll
            for (int bj = 0; bj < 2; ++bj)
#pragma unroll
                for (int n = 0; n < 2; ++n) xv[(gi + 1) & 1][bj * 2 + n] = *(const f32x4*)(x + (size_t)(row0 + ai2 * 128 + m2 * 16) * 2048 + col0 + bj * 128 + n * 16); }
        const size_t row = (size_t)(row0 + ai * 128 + m * 16); float q = 0.f;
#pragma unroll
        for (int bj = 0; bj < 2; ++bj)
#pragma unroll
            for (int n = 0; n < 2; ++n) { const f32x4 r = xv[gi & 1][bj * 2 + n] + acc[ai][bj][m][n];
                q += (r[0] * r[0] + r[1] * r[1]) + (r[2] * r[2] + r[3] * r[3]);
                *(f32x4*)(out + row * 2048 + col0 + bj * 128 + n * 16) = r; }
        q += __shfl_xor(q, 16); q += __shfl_xor(q, 32);
        if (fq == 0) atomic_addf(ssq + row, q);
    }
}
struct EpiOut {
    static constexpr bool PERM = false, AFTER_DRAIN = false;
    __device__ __forceinline__ bool keep(const pg8::Unit&) const { return false; }
    const float* x; float* out; float* ssq;
    __device__ __forceinline__ void operator()(const f32x4 (&acc)[2][2][4][2], const pg8::Unit& u, int wr, int wc, int fr, int fq) const {
        out_store(x, out, ssq, acc, u.pm * 256 + wr * 64 + fr, u.pn * 256 + wc * 32 + 4 * fq, fq);
    }
};

struct EpiAcc {
    static constexpr bool PERM = true, AFTER_DRAIN = false;
    __device__ __forceinline__ bool keep(const pg8::Unit&) const { return false; }
    bf16_t* O;
    __device__ __forceinline__ void operator()(const f32x4 (&acc)[2][2][4][2], const pg8::Unit& u, int wr, int wc, int fr, int fq) const {
        const int row0 = u.pm * 256 + wr * 64 + fr, col0 = u.pn * 256 + wc * 32 + 8 * fq;
#pragma unroll
        for (int ai = 0; ai < 2; ++ai)
#pragma unroll
            for (int m = 0; m < 4; ++m)
#pragma unroll
                for (int bj = 0; bj < 2; ++bj) {
                    const f32x4 v0 = acc[ai][bj][m][0], v1 = acc[ai][bj][m][1];
                    u32x4 w; w.x = cvt_pk_bf16(v0[0], v0[1]); w.y = cvt_pk_bf16(v0[2], v0[3]); w.z = cvt_pk_bf16(v1[0], v1[1]); w.w = cvt_pk_bf16(v1[2], v1[3]);
                    __builtin_nontemporal_store(w, (u32x4*)(O + (size_t)(row0 + ai * 128 + m * 16) * 2048 + col0 + bj * 128));
                }
    }
};

__device__ __forceinline__ void transpose_item(const float* W, int ldw, int K, int k0, int n0, bf16_t* dst, LAS float* scr, int lane, int kd = -1) {
    if (kd < 0) kd = k0;
#pragma unroll 8
    for (int i = 0; i < 32; ++i) { const int kk = 2 * i + (lane >> 5); scr[kk * 33 + (lane & 31)] = W[(size_t)(k0 + kk) * ldw + n0 + (lane & 31)]; }
    asm volatile("s_waitcnt lgkmcnt(0)" ::: "memory");
    const int c = lane & 7;
#pragma unroll
    for (int j = 0; j < 4; ++j) { const int n = (lane >> 3) + 8 * j; const LAS float* s = scr + (8 * c) * 33 + n;
        u32x4 o; o.x = cvt_pk_bf16(s[0 * 33], s[1 * 33]); o.y = cvt_pk_bf16(s[2 * 33], s[3 * 33]); o.z = cvt_pk_bf16(s[4 * 33], s[5 * 33]); o.w = cvt_pk_bf16(s[6 * 33], s[7 * 33]);
        *(u32x4*)(dst + (size_t)n * K + kd + 8 * c) = o; }
    asm volatile("s_waitcnt lgkmcnt(0)" ::: "memory");
}
struct TItem { const float* src; bf16_t* dst; int ldw, ldd; };
__device__ __forceinline__ void titem_load(const TItem& t, f32x4 (&v)[16], int lane) {
    const int r4 = lane >> 4, c4 = lane & 15;
#pragma unroll
    for (int i = 0; i < 16; ++i) v[i] = __builtin_nontemporal_load((const f32x4*)(t.src + (size_t)(4 * i + r4) * t.ldw + 4 * c4));
}
__device__ __forceinline__ void titem_finish(const TItem& t, const f32x4 (&v)[16], LAS float* scr, int lane) {
    const int r4 = lane >> 4, c4 = lane & 15;
#pragma unroll
    for (int i = 0; i < 16; ++i) { LAS float* p = scr + (4 * i + r4) * 65 + 4 * c4; p[0] = v[i][0]; p[1] = v[i][1]; p[2] = v[i][2]; p[3] = v[i][3]; }
    asm volatile("s_waitcnt lgkmcnt(0)" ::: "memory");
    const int c = lane & 7;
#pragma unroll
    for (int i = 0; i < 8; ++i) { const int n = (lane >> 3) + 8 * i; const LAS float* s = scr + (8 * c) * 65 + n;
        u32x4 o; o.x = cvt_pk_bf16(s[0 * 65], s[1 * 65]); o.y = cvt_pk_bf16(s[2 * 65], s[3 * 65]); o.z = cvt_pk_bf16(s[4 * 65], s[5 * 65]); o.w = cvt_pk_bf16(s[6 * 65], s[7 * 65]);
        *(u32x4*)(t.dst + (size_t)n * t.ldd + 8 * c) = o; }
    asm volatile("s_waitcnt lgkmcnt(0)" ::: "memory");
}
__device__ __forceinline__ int proj_row(int n0) {
    if (n0 < 2048) return 256 * (n0 >> 7) + (n0 & 127);
    if (n0 < 4096) return 4096 + (n0 - 2048);
    if (n0 < 6144) { const int ch = n0 - 4096; return 256 * (ch >> 7) + 128 + (ch & 127); }
    if (n0 < 12288) return n0;
    if (n0 < 12320) return -1;
    { const int c = n0 - 12320, n = c >> 11, ch = c & 2047; return 12288 + 256 * (ch >> 7) + 128 * n + (ch & 127); }
}

template <int W> struct ConvRaw { static constexpr int CG = W / 8, RB = NT / CG, RPT = 128 / RB; u32x4 r[RPT + 3]; };
template <int W>
__device__ __forceinline__ void stage_conv_load(ConvRaw<W>& raw, const bf16_t* xbc, int tok0, int cidx, int col0, int tid) {
    constexpr int CG = ConvRaw<W>::CG, RPT = ConvRaw<W>::RPT;
    const int cgi = tid % CG, rb = tid / CG, r0 = rb * RPT;
    const bf16_t* src = xbc + (size_t)tok0 * 4096 + col0 + cgi * 8;
#pragma unroll
    for (int i = 0; i < RPT + 3; ++i) { const int r = r0 - 3 + i;
        if (cidx == 0 && r < 0) raw.r[i] = (u32x4){0u, 0u, 0u, 0u}; else raw.r[i] = __builtin_nontemporal_load((const u32x4*)(src + (ptrdiff_t)r * 4096)); }
}
template <int W>
__device__ __forceinline__ void stage_conv_finish(const ConvRaw<W>& raw, LAS unsigned char* dst, int stride, int col0, const float* conv_w, const float* conv_b, const LAS float* scale, int tid, bf16_t* gdst = nullptr, int gstride = 0) {
    constexpr int CG = ConvRaw<W>::CG, RPT = ConvRaw<W>::RPT;
    const int cgi = tid % CG, rb = tid / CG, r0 = rb * RPT, ch0 = col0 + cgi * 8;
    float w[4][8], bias[8], h0[8], h1[8], h2[8];
#pragma unroll
    for (int k = 0; k < 4; ++k) { const f32x4 a = *(const f32x4*)(conv_w + k * 4096 + ch0), b = *(const f32x4*)(conv_w + k * 4096 + ch0 + 4);
#pragma unroll
        for (int j = 0; j < 4; ++j) { w[k][j] = a[j]; w[k][4 + j] = b[j]; } }
    { const f32x4 a = *(const f32x4*)(conv_b + ch0), b = *(const f32x4*)(conv_b + ch0 + 4);
#pragma unroll
      for (int j = 0; j < 4; ++j) { bias[j] = a[j]; bias[4 + j] = b[j]; } }
#define UNPK(v_, o) do { o[0] = bflo(v_.x); o[1] = bfhi(v_.x); o[2] = bflo(v_.y); o[3] = bfhi(v_.y); o[4] = bflo(v_.z); o[5] = bfhi(v_.z); o[6] = bflo(v_.w); o[7] = bfhi(v_.w); } while (0)
    UNPK(raw.r[0], h0); UNPK(raw.r[1], h1); UNPK(raw.r[2], h2);
#pragma unroll
    for (int i = 0; i < RPT; ++i) {
        float cur[8], o[8]; UNPK(raw.r[3 + i], cur);
        float sc = 1.0f; if (scale) sc = scale[(cgi >> 3) * 128 + r0 + i];
#pragma unroll
        for (int j = 0; j < 8; ++j) { float v = bias[j] + w[0][j] * h0[j] + w[1][j] * h1[j] + w[2][j] * h2[j] + w[3][j] * cur[j]; o[j] = silu_f(v) * sc; h0[j] = h1[j]; h1[j] = h2[j]; h2[j] = cur[j]; }
        u32x4 pk; pk.x = cvt_pk_bf16(o[0], o[1]); pk.y = cvt_pk_bf16(o[2], o[3]); pk.z = cvt_pk_bf16(o[4], o[5]); pk.w = cvt_pk_bf16(o[6], o[7]);
        { LAS unsigned char* q_ = dst + (r0 + i) * stride + (32 * (cgi >> 2) + 4 * (cgi & 3)) * 2;
          *(LAS u32x2*)q_ = (u32x2){pk.x, pk.y}; *(LAS u32x2*)(q_ + 32) = (u32x2){pk.z, pk.w}; }
        if (gdst) __builtin_nontemporal_store(pk, (u32x4*)(gdst + (size_t)(r0 + i) * gstride + cgi * 8));
    }
#undef UNPK
}
__device__ __forceinline__ float chunk_prefix(LAS float* adt, LAS float* ac, const float* DT, const float* a_log, int tok0, int g, int tid) {
    const int k = tid >> 7, l = tid & 127, h = g * 4 + k, lane = tid & 63;
    const float dtv = DT[(size_t)h * M_TOK + tok0 + l];
    const float a = -expf(a_log[h]);
    float s = dtv * a;
#pragma unroll
    for (int o = 1; o < 64; o <<= 1) { const float t = __shfl_up(s, o); if (lane >= o) s += t; }
    if (lane == 63) adt[tid >> 6] = s;
    __syncthreads();
    if (l >= 64) s += adt[(tid >> 6) - 1];
    ac[k * 128 + l] = s;
    __syncthreads();
    return dtv;
}

constexpr int XS_STRIDE = 528, CB_STRIDE = 272;

__device__ __forceinline__ void own_barrier(unsigned* bar, unsigned target) {
    if (threadIdx.x == 0) {
        __hip_atomic_fetch_add(bar, 1u, __ATOMIC_RELAXED, __HIP_MEMORY_SCOPE_AGENT);
        const unsigned long long t0 = __builtin_amdgcn_s_memrealtime();
        while (__hip_atomic_load(bar, __ATOMIC_RELAXED, __HIP_MEMORY_SCOPE_AGENT) < target) {
            __builtin_amdgcn_s_sleep(2);
            if (__builtin_amdgcn_s_memrealtime() - t0 > 200000000ull) break;
        }
    }
    __syncthreads();
}
#define GRID_SYNC(i) do { asm volatile("s_waitcnt vmcnt(0) lgkmcnt(0)" ::: "memory"); grid.sync(); \
    __builtin_amdgcn_fence(__ATOMIC_ACQUIRE, "agent"); asm volatile("s_waitcnt vmcnt(0)" ::: "memory"); __syncthreads(); STAMP(i); } while (0)
#ifdef SPIN_PHASE
#define STAMP(i) do { if (bx == 0 && tid == 0) { ((unsigned long long*)(BAR + 16))[i] = __builtin_amdgcn_s_memrealtime(); } } while (0)
#else
#define STAMP(i) do { } while (0)
#endif
#ifdef SPIN_SUB
#define SUBSTAMP(i) do { if (bx == 0 && tid == 0 && j == 0) ((unsigned long long*)(BAR + 16))[16 + (i)] = __builtin_amdgcn_s_memrealtime(); } while (0)
#else
#define SUBSTAMP(i) do { } while (0)
#endif
__global__ void __launch_bounds__(NT, 2) fwd_megakernel(Args A) {
    extern __shared__ __attribute__((aligned(16))) unsigned char lds_raw[];
    LAS unsigned char* lds = (LAS unsigned char*)lds_raw;
    const unsigned lds_u32 = (unsigned)(size_t)lds_raw;
    cg::grid_group grid = cg::this_grid();
    const int tid = threadIdx.x, lane = tid & 63, wave = __builtin_amdgcn_readfirstlane(tid >> 6), fr = lane & 15, fq = lane >> 4;
    const int G = gridDim.x, bx = blockIdx.x;
    const int gw = bx * NWAVES + wave, NGW = G * NWAVES;
    unsigned char* ws = A.ws;
    bf16_t* WinT = (bf16_t*)A.out; bf16_t* H = (bf16_t*)((unsigned char*)A.out + 64 * MiB);
    bf16_t* STATES = (bf16_t*)A.out;
    bf16_t* WdtT = (bf16_t*)(ws + WS_WDT); bf16_t* WsB = (bf16_t*)(ws + WS_WSB); float* STATS = (float*)(ws + WS_STATS); float* SSQ = (float*)(ws + WS_SSQ);
    float* CD = (float*)(ws + WS_CD); float* DT = (float*)(ws + WS_DT); unsigned* BAR = (unsigned*)(ws + WS_BAR); unsigned bar_epoch = 0;
    bf16_t* WbT = (bf16_t*)(ws + WS_WB); bf16_t* WoT = (bf16_t*)(ws + WS_WO); bf16_t* YAB = (bf16_t*)(ws + WS_YAB); bf16_t* V = (bf16_t*)(ws + WS_V);
    bf16_t* PREV = (bf16_t*)(ws + WS_V); bf16_t* MERGED = (bf16_t*)(ws + WS_V);
    bf16_t* CC = (bf16_t*)(ws + WS_CC); bf16_t* YD = (bf16_t*)((unsigned char*)A.out + 64 * MiB);
    bf16_t* XBC = (bf16_t*)(ws + WS_XBC); bf16_t* RG = (bf16_t*)(ws + WS_R); bf16_t* GB = (bf16_t*)(ws + WS_GB);

    STAMP(0);
    if constexpr ((PH_MASK >> 0) & 1)
    {
        LAS float* scr = (LAS float*)(lds + wave * 16640);
        constexpr int I_IN = 32 * 256, I_B = 32 * 32, I_O = 32 * 32, NITEMS = I_IN + 2 * I_B + I_O;
        auto item_of = [&](int it) -> TItem {
            TItem t; int r = it;
            if (r < I_IN) { const int kb = r >> 8, nb = r & 255, n0 = nb < 192 ? 64 * nb : 12320 + 64 * (nb - 192);
                t.src = A.w_in + (size_t)(64 * kb) * NIN + n0; t.ldw = NIN; t.dst = WinT + (size_t)proj_row(n0) * 2048 + 64 * kb; t.ldd = 2048; return t; }
            r -= I_IN;
            if (r < 2 * I_B) { const int nbr = r / I_B, rr = r % I_B, kb = rr >> 5, nb = rr & 31;
                t.src = A.w_branch + (size_t)nbr * 2048 * 2048 + (size_t)(64 * kb) * 2048 + 64 * nb; t.ldw = 2048; t.dst = WbT + (size_t)(64 * nb) * 4096 + nbr * 2048 + 64 * kb; t.ldd = 4096; return t; }
            r -= 2 * I_B;
            { const int kb = r >> 5, nb = r & 31; t.src = A.w_out + (size_t)(64 * kb) * 2048 + 64 * nb; t.ldw = 2048; t.dst = WoT + (size_t)(64 * nb) * 2048 + 64 * kb; t.ldd = 2048; return t; }
        };
        {
            f32x4 va[16], vb[16]; int it = gw; TItem ta, tb;
            if (it < NITEMS) { ta = item_of(it); titem_load(ta, va, lane); }
            while (it < NITEMS) {
                const int it2 = it + NGW, it3 = it2 + NGW;
                if (it2 < NITEMS) { tb = item_of(it2); titem_load(tb, vb, lane); }
                titem_finish(ta, va, scr, lane);
                if (it3 < NITEMS) { ta = item_of(it3); titem_load(ta, va, lane); }
                if (it2 < NITEMS) titem_finish(tb, vb, scr, lane);
                it = it3;
            }
        }
        for (int r = gw; r < 32; r += NGW) transpose_item(A.w_in, NIN, 2048, 64 * r, 12288, WdtT, scr, lane);
        for (int i = bx * NT + tid; i < 8 * 128 * 128; i += G * NT) { const int t = (i >> 7) & 127, s = i & 127; const float v = (s <= t) ? A.w_sp[i] : 0.f; WsB[i] = (bf16_t)(cvt_pk_bf16(v, 0.f) & 0xffffu); }
        for (int i = bx * NT + tid; i < 2 * M_TOK; i += G * NT) STATS[i] = 0.f;
        for (int i = bx * NT + tid; i < M_TOK; i += G * NT) SSQ[i] = 0.f;
        for (int m = gw; m < M_TOK; m += 2 * NGW) {
            const int m2 = m + NGW;
            const f32x4* xr = (const f32x4*)(A.x + (size_t)m * DM) + lane; const f32x4* xr2 = (const f32x4*)(A.x + (size_t)m2 * DM) + lane; const f32x4* wr4 = (const f32x4*)A.norm_w + lane;
            f32x4 v[8], v2[8]; float s = 0.f, s2 = 0.f;
#pragma unroll
            for (int j = 0; j < 8; ++j) { v[j] = __builtin_nontemporal_load(xr + 64 * j); v2[j] = __builtin_nontemporal_load(xr2 + 64 * j); }
#pragma unroll
            for (int j = 0; j < 8; ++j) { s += (v[j][0] * v[j][0] + v[j][1] * v[j][1]) + (v[j][2] * v[j][2] + v[j][3] * v[j][3]); s2 += (v2[j][0] * v2[j][0] + v2[j][1] * v2[j][1]) + (v2[j][2] * v2[j][2] + v2[j][3] * v2[j][3]); }
            const float rstd = 1.0f / sqrtf(wave_sum(s) * (1.0f / DM) + EPS), rstd2 = 1.0f / sqrtf(wave_sum(s2) * (1.0f / DM) + EPS);
            u32x2* o8 = (u32x2*)(H + (size_t)m * DM) + lane; u32x2* o82 = (u32x2*)(H + (size_t)m2 * DM) + lane;
#pragma unroll
            for (int j = 0; j < 8; ++j) { const f32x4 w4 = wr4[64 * j];
                u32x2 o; o.x = cvt_pk_bf16(v[j][0] * rstd * w4[0], v[j][1] * rstd * w4[1]); o.y = cvt_pk_bf16(v[j][2] * rstd * w4[2], v[j][3] * rstd * w4[3]); o8[64 * j] = o;
                u32x2 o2; o2.x = cvt_pk_bf16(v2[j][0] * rstd2 * w4[0], v2[j][1] * rstd2 * w4[1]); o2.y = cvt_pk_bf16(v2[j][2] * rstd2 * w4[2], v2[j][3] * rstd2 * w4[3]); o82[64 * j] = o2; }
        }
    }
    GRID_SYNC(1);

    if constexpr ((PH_MASK >> 1) & 1)
    {
        pg8::Gemm g{H, WinT, M_TOK, NPROJ, DM, DM}; pg8::StaticOrder S; S.init(M_TOK, NPROJ, G, bx, WGM_P1);
        EpiProj E{YAB, V, XBC, RG, GB, STATS, A.b_gate};
        pg8::gemm_phase<EpiProj, pg8::StaticOrder, true, true>(lds, g, S, E);
        {
            constexpr int WROW = 4112;
#pragma unroll
            for (int i = 0; i < 16; ++i) { const int row = 2 * i + (tid >> 8), ch = tid & 255;
                *(LAS u32x4*)(lds + row * WROW + ch * 16) = *(const u32x4*)(WdtT + (size_t)row * DM + ch * 8); }
            __syncthreads();
            for (int t0 = bx * 4; t0 < M_TOK / 16; t0 += G * 4) {
                const int t = t0 + (wave >> 1), kh = wave & 1;
                f32x4 acc0 = {0.f, 0.f, 0.f, 0.f}, acc1 = {0.f, 0.f, 0.f, 0.f};
                const bf16_t* ap = H + (size_t)(16 * t + fr) * DM + 8 * fq + kh * 1024;
                const LAS unsigned char* bp = lds + fr * WROW + (8 * fq + kh * 1024) * 2;
#pragma unroll 16
                for (int ks = 0; ks < 32; ++ks) {
                    const bf16x8 fa = *(const bf16x8*)(ap + 32 * ks), fb0 = *(const LAS bf16x8*)(bp + 64 * ks), fb1 = *(const LAS bf16x8*)(bp + 16 * WROW + 64 * ks);
                    acc0 = __builtin_amdgcn_mfma_f32_16x16x32_bf16(fb0, fa, acc0, 0, 0, 0);
                    acc1 = __builtin_amdgcn_mfma_f32_16x16x32_bf16(fb1, fa, acc1, 0, 0, 0);
                }
                LAS f32x4* xch = (LAS f32x4*)(lds + 32 * WROW) + (wave >> 1) * 128 + lane * 2;
                if (kh) { xch[0] = acc0; xch[1] = acc1; }
                __syncthreads();
                if (!kh) {
                    acc0 += xch[0]; acc1 += xch[1];
                    const f32x4 bb0 = *(const f32x4*)(A.dt_bias + 4 * fq), bb1 = *(const f32x4*)(A.dt_bias + 16 + 4 * fq);
                    f32x4 o0, o1;
#pragma unroll
                    for (int j = 0; j < 4; ++j) { const float v0 = acc0[j] + bb0[j], v1 = acc1[j] + bb1[j];
                        o0[j] = fmaxf(v0, 0.f) + log1pf(expf(-fabsf(v0))); o1[j] = fmaxf(v1, 0.f) + log1pf(expf(-fabsf(v1))); }
                    float* dp = DT + (size_t)(4 * fq) * M_TOK + 16 * t + fr;
#pragma unroll
                    for (int j = 0; j < 4; ++j) { dp[(size_t)j * M_TOK] = o0[j]; dp[(size_t)(16 + j) * M_TOK] = o1[j]; }
                }
                __syncthreads();
            }
        }
    }
    GRID_SYNC(2);

    if constexpr ((PH_MASK >> 2) & 1)
    for (int j = bx; j < 2048; j += G) {
        const int jj = j & 1023, g = jj & 7, bc = jj >> 3, tok0 = bc * 128, cidx = bc & 31;
        int tid = threadIdx.x; asm volatile("" : "+v"(tid));
        const int lane = tid & 63, fr = lane & 15, fq = lane >> 4;
        if (j < 1024) {
            {
                const bf16_t* wsrc = WsB + (size_t)g * 16384;
                u32x4 wv[4];
#pragma unroll
                for (int i = 0; i < 4; ++i) wv[i] = *(const u32x4*)(wsrc + (size_t)(i * 32 + (tid >> 4)) * 128 + (tid & 15) * 8);
#pragma unroll
                for (int i = 0; i < 4; ++i) *(LAS u32x4*)(lds + 67584 + (i * 32 + (tid >> 4)) * CB_STRIDE + (tid & 15) * 16) = wv[i];
            }
            bf16_t* p0 = YAB + (size_t)(tok0 + fr) * 4096 + g * 256 + 32 * wave + 8 * fq;
            u32x4 sv[8]; float bs[8];
#pragma unroll
            for (int mt = 0; mt < 8; ++mt) { bs[mt] = A.b_sp[g * 128 + 16 * mt + fr]; sv[mt] = *(const u32x4*)(p0 + (size_t)(16 * mt) * 4096); }
            {
                const int cgi = tid & 31, rb = tid >> 5, d0 = g * 256 + cgi * 8;
                const f32x4 lw0 = *(const f32x4*)(A.ln_w + d0), lw1 = *(const f32x4*)(A.ln_w + d0 + 4), lb0 = *(const f32x4*)(A.ln_b + d0), lb1 = *(const f32x4*)(A.ln_b + d0 + 4);
#pragma unroll
                for (int i = 0; i < 8; ++i) {
                    const int r = rb * 8 + i, tok = tok0 + r;
                    const float2 st2 = *(const float2*)(STATS + 2 * tok); const float mean = st2.x * (1.0f / 2048.0f), var = st2.y * (1.0f / 2048.0f) - mean * mean, rstd = 1.0f / sqrtf(fmaxf(var, 0.f) + EPS);
                    const u32x4 v = __builtin_nontemporal_load((const u32x4*)(V + (size_t)tok * 2048 + d0));
                    u32x4 pk;
                    pk.x = cvt_pk_bf16((bflo(v.x) - mean) * rstd * lw0[0] + lb0[0], (bfhi(v.x) - mean) * rstd * lw0[1] + lb0[1]);
                    pk.y = cvt_pk_bf16((bflo(v.y) - mean) * rstd * lw0[2] + lb0[2], (bfhi(v.y) - mean) * rstd * lw0[3] + lb0[3]);
                    pk.z = cvt_pk_bf16((bflo(v.z) - mean) * rstd * lw1[0] + lb1[0], (bfhi(v.z) - mean) * rstd * lw1[1] + lb1[1]);
                    pk.w = cvt_pk_bf16((bflo(v.w) - mean) * rstd * lw1[2] + lb1[2], (bfhi(v.w) - mean) * rstd * lw1[3] + lb1[3]);
                    { LAS unsigned char* q_ = lds + r * XS_STRIDE + (32 * (cgi >> 2) + 4 * (cgi & 3)) * 2; *(LAS u32x2*)q_ = (u32x2){pk.x, pk.y}; *(LAS u32x2*)(q_ + 32) = (u32x2){pk.z, pk.w}; }
                }
            }
            __syncthreads();
            f32x4 acc[8][2];
#pragma unroll
            for (int mt = 0; mt < 8; ++mt) { acc[mt][0] = (f32x4){0.f, 0.f, 0.f, 0.f}; acc[mt][1] = (f32x4){0.f, 0.f, 0.f, 0.f}; }
            const unsigned tra = lds_u32 + (8 * fq + (fr >> 2)) * XS_STRIDE + (32 * wave + 4 * (lane & 3)) * 2;
#pragma unroll
            for (int ks = 0; ks < 4; ++ks) {
                bf16x8 fn0, fn1; tr_frag2<4 * XS_STRIDE, 32>(tra + 32 * ks * XS_STRIDE, fn0, fn1);
#pragma unroll
                for (int mt = 2 * ks; mt < 8; ++mt) {
                    const bf16x8 fm = *(const LAS bf16x8*)(lds + 67584 + (16 * mt + fr) * CB_STRIDE + (32 * ks + 8 * fq) * 2);
                    acc[mt][0] = __builtin_amdgcn_mfma_f32_16x16x32_bf16(fn0, fm, acc[mt][0], 0, 0, 0);
                    acc[mt][1] = __builtin_amdgcn_mfma_f32_16x16x32_bf16(fn1, fm, acc[mt][1], 0, 0, 0);
                }
            }
            {
#pragma unroll
                for (int mt = 0; mt < 8; ++mt) { const f32x4 a0 = acc[mt][0], a1 = acc[mt][1]; const u32x4 s4 = sv[mt]; const float b = bs[mt];
                    u32x4 o; o.x = cvt_pk_bf16(bflo(s4.x) * (a0[0] + b), bfhi(s4.x) * (a0[1] + b)); o.y = cvt_pk_bf16(bflo(s4.y) * (a0[2] + b), bfhi(s4.y) * (a0[3] + b));
                    o.z = cvt_pk_bf16(bflo(s4.z) * (a1[0] + b), bfhi(s4.z) * (a1[1] + b)); o.w = cvt_pk_bf16(bflo(s4.w) * (a1[2] + b), bfhi(s4.w) * (a1[3] + b));
                    *(u32x4*)(p0 + (size_t)(16 * mt) * 4096) = o; }
            }
            __syncthreads();
        } else {
            LAS float* ac = (LAS float*)(lds + 137216); LAS float* dtl = ac + 512; LAS float* adt = dtl + 512; LAS float* wg = adt + 512;
            ConvRaw<128> rc, rbb; ConvRaw<256> rx;
            stage_conv_load<128>(rc, XBC, tok0, cidx, 3072 + g * 128, tid); stage_conv_load<128>(rbb, XBC, tok0, cidx, 2048 + g * 128, tid); stage_conv_load<256>(rx, XBC, tok0, cidx, g * 256, tid);
            { const float dtv = chunk_prefix(adt, ac, DT, A.a_log, tok0, g, tid); dtl[tid] = dtv;
              const int k = tid >> 7, l_ = tid & 127; const float aend = ac[k * 128 + 127]; wg[tid] = expf(aend - ac[tid]) * dtv; if (l_ == 127) CD[bc * 32 + g * 4 + k] = expf(aend); }
            stage_conv_finish<128>(rc, lds, CB_STRIDE, 3072 + g * 128, A.conv_w, A.conv_b, nullptr, tid, CC + (size_t)tok0 * 1024 + g * 128, 1024);
            stage_conv_finish<128>(rbb, lds + 34816, CB_STRIDE, 2048 + g * 128, A.conv_w, A.conv_b, nullptr, tid);
            stage_conv_finish<256>(rx, lds + 69632, XS_STRIDE, g * 256, A.conv_w, A.conv_b, nullptr, tid);
            __syncthreads();
            const int l = 16 * wave + fr;
            f32x4 cb[8];
            {
                bf16x8 fc[4];
#pragma unroll
                for (int ks = 0; ks < 4; ++ks) fc[ks] = *(const LAS bf16x8*)(lds + l * CB_STRIDE + (32 * ks + 8 * fq) * 2);
#pragma unroll
                for (int nt = 0; nt < 8; ++nt) {
                    cb[nt] = (f32x4){0.f, 0.f, 0.f, 0.f};
                    if (nt <= wave) {
#pragma unroll
                        for (int ks = 0; ks < 4; ++ks) { const bf16x8 fb = *(const LAS bf16x8*)(lds + 34816 + (16 * nt + fr) * CB_STRIDE + (32 * ks + 8 * fq) * 2);
                            cb[nt] = __builtin_amdgcn_mfma_f32_16x16x32_bf16(fb, fc[ks], cb[nt], 0, 0, 0); }
                    }
                }
            }
            {
                const int k = wave >> 1, ph = wave & 1;
                f32x4 acc[2][8];
#pragma unroll
                for (int mt = 0; mt < 2; ++mt)
#pragma unroll
                    for (int nt = 0; nt < 8; ++nt) acc[mt][nt] = (f32x4){0.f, 0.f, 0.f, 0.f};
                const unsigned xa = lds_u32 + 69632 + (8 * fq + (fr >> 2)) * XS_STRIDE + (k * 64 + 32 * ph + 4 * (lane & 3)) * 2;
                const unsigned ba = lds_u32 + 34816 + (8 * fq + (fr >> 2)) * CB_STRIDE + (4 * (lane & 3)) * 2;
#pragma unroll
                for (int ks = 0; ks < 4; ++ks) {
                    bf16x8 fm0, fm1; tr_frag2<4 * XS_STRIDE, 32>(xa + 32 * ks * XS_STRIDE, fm0, fm1);
                    const f32x4 w0 = *(const LAS f32x4*)(wg + k * 128 + 32 * ks + 8 * fq), w1 = *(const LAS f32x4*)(wg + k * 128 + 32 * ks + 8 * fq + 4);
                    const float wv[8] = {w0[0], w0[1], w0[2], w0[3], w1[0], w1[1], w1[2], w1[3]};
                    bf16x8 sm0, sm1;
#pragma unroll
                    for (int e = 0; e < 8; e += 2) {
                        const unsigned a0 = cvt_pk_bf16(bf2f((unsigned short)fm0[e]) * wv[e], bf2f((unsigned short)fm0[e + 1]) * wv[e + 1]);
                        const unsigned a1 = cvt_pk_bf16(bf2f((unsigned short)fm1[e]) * wv[e], bf2f((unsigned short)fm1[e + 1]) * wv[e + 1]);
                        sm0[e] = (short)(a0 & 0xffffu); sm0[e + 1] = (short)(a0 >> 16); sm1[e] = (short)(a1 & 0xffffu); sm1[e + 1] = (short)(a1 >> 16);
                    }
#pragma unroll
                    for (int nq = 0; nq < 2; ++nq) {
                        bf16x8 fn[4]; tr_frag4<4 * CB_STRIDE, 32>(ba + 32 * ks * CB_STRIDE + 128 * nq, fn[0], fn[1], fn[2], fn[3]);
#pragma unroll
                        for (int i = 0; i < 4; ++i) {
                            acc[0][4 * nq + i] = __builtin_amdgcn_mfma_f32_16x16x32_bf16(fn[i], sm0, acc[0][4 * nq + i], 0, 0, 0);
                            acc[1][4 * nq + i] = __builtin_amdgcn_mfma_f32_16x16x32_bf16(fn[i], sm1, acc[1][4 * nq + i], 0, 0, 0);
                        }
                    }
                }
                bf16_t* sp = STATES + ((size_t)(bc * 8 + g) * 4096 + (size_t)wave * 512 + lane) * 8;
#pragma unroll
                for (int mt = 0; mt < 2; ++mt)
#pragma unroll
                    for (int q = 0; q < 4; ++q) { const f32x4 a0 = acc[mt][2 * q], a1 = acc[mt][2 * q + 1];
                        u32x4 o; o.x = cvt_pk_bf16(a0[0], a0[1]); o.y = cvt_pk_bf16(a0[2], a0[3]); o.z = cvt_pk_bf16(a1[0], a1[1]); o.w = cvt_pk_bf16(a1[2], a1[3]);
                        __builtin_nontemporal_store(o, (u32x4*)(sp + (size_t)((mt * 4 + q) * 64) * 8)); }
            }
            __syncthreads();
            LAS unsigned char* sw = lds + 34816 + wave * (16 * CB_STRIDE);
            bf16_t* ydp = YD + ((size_t)(jj * 8 + wave) * 8 * 64 + lane) * 8;
#pragma unroll
            for (int k = 0; k < 4; ++k) {
                const int h = g * 4 + k; const float al = ac[k * 128 + l], dsk = A.d_skip[h];
#pragma unroll
                for (int nt = 0; nt < 8; ++nt) {
                    float sv[4];
#pragma unroll
                    for (int r = 0; r < 4; ++r) { const int s = 16 * nt + 4 * fq + r;
                        float v = (s <= l) ? cb[nt][r] * __expf(al - ac[k * 128 + s]) * dtl[k * 128 + s] : 0.f;
                        if (s == l) v += dsk; sv[r] = v; }
                    u32x2 o; o.x = cvt_pk_bf16(sv[0], sv[1]); o.y = cvt_pk_bf16(sv[2], sv[3]);
                    *(LAS u32x2*)(sw + fr * CB_STRIDE + (16 * nt + 4 * fq) * 2) = o;
                    if (nt & 1) asm volatile("" ::: "memory");
                }
                asm volatile("s_waitcnt lgkmcnt(0)" ::: "memory");
                f32x4 ay[4];
#pragma unroll
                for (int pt = 0; pt < 4; ++pt) ay[pt] = (f32x4){0.f, 0.f, 0.f, 0.f};
                const unsigned xa = lds_u32 + 69632 + (8 * fq + (fr >> 2)) * XS_STRIDE + (k * 64 + 4 * (lane & 3)) * 2;
#pragma unroll
                for (int ks = 0; ks < 4; ++ks) {
                    if (ks <= (wave >> 1)) {
                        const bf16x8 fs = *(const LAS bf16x8*)(sw + fr * CB_STRIDE + (32 * ks + 8 * fq) * 2);
                        bf16x8 fx[4]; tr_frag4<4 * XS_STRIDE, 32>(xa + 32 * ks * XS_STRIDE, fx[0], fx[1], fx[2], fx[3]);
#pragma unroll
                        for (int pt = 0; pt < 4; ++pt) ay[pt] = __builtin_amdgcn_mfma_f32_16x16x32_bf16(fx[pt], fs, ay[pt], 0, 0, 0);
                    }
                }
#pragma unroll
                for (int q = 0; q < 2; ++q) { u32x4 o; o.x = cvt_pk_bf16(ay[2 * q][0], ay[2 * q][1]); o.y = cvt_pk_bf16(ay[2 * q][2], ay[2 * q][3]); o.z = cvt_pk_bf16(ay[2 * q + 1][0], ay[2 * q + 1][1]); o.w = cvt_pk_bf16(ay[2 * q + 1][2], ay[2 * q + 1][3]); __builtin_nontemporal_store(o, (u32x4*)(ydp + (size_t)(k * 2 + q) * 512)); }
                __builtin_amdgcn_sched_barrier(0);
                asm volatile("s_waitcnt lgkmcnt(0)" ::: "memory");
            }
            __syncthreads();
        }
    }
    GRID_SYNC(3);

    if constexpr ((PH_MASK >> 3) & 1)
    for (int blk = bx; blk < 256; blk += G) {
        const int b = blk >> 6; const unsigned o8 = (unsigned)(blk & 63) * 512u + (unsigned)tid; const int h = (int)(o8 >> 10);
        const bf16_t* sbase = STATES + (size_t)(b * 32) * 262144; bf16_t* pbase = PREV + (size_t)(b * 32) * 262144;
        const unsigned voff = o8 * 8u;
        f32x4 h0 = {0.f, 0.f, 0.f, 0.f}, h1 = {0.f, 0.f, 0.f, 0.f};
#pragma unroll 1
        for (int cb0 = 0; cb0 < 32; cb0 += 16) {
            const bf16_t* sb = sbase + (size_t)cb0 * 262144; bf16_t* pb = pbase + (size_t)cb0 * 262144;
            u32x4 sv[16]; float cdv[16];
#pragma unroll
            for (int c = 0; c < 16; ++c) { sv[c] = __builtin_nontemporal_load((const u32x4*)(sb + (size_t)c * 262144 + voff)); cdv[c] = CD[(b * 32 + cb0 + c) * 32 + h]; }
#pragma unroll
            for (int c = 0; c < 16; ++c) {
                u32x4 o; o.x = cvt_pk_bf16(h0[0], h0[1]); o.y = cvt_pk_bf16(h0[2], h0[3]); o.z = cvt_pk_bf16(h1[0], h1[1]); o.w = cvt_pk_bf16(h1[2], h1[3]);
                __builtin_nontemporal_store(o, (u32x4*)(pb + (size_t)c * 262144 + voff));
                const f32x4 s0 = {bflo(sv[c].x), bfhi(sv[c].x), bflo(sv[c].y), bfhi(sv[c].y)}, s1 = {bflo(sv[c].z), bfhi(sv[c].z), bflo(sv[c].w), bfhi(sv[c].w)};
                h0 = h0 * cdv[c] + s0; h1 = h1 * cdv[c] + s1;
            }
        }
    }
    GRID_SYNC(4);

    if constexpr ((PH_MASK >> 4) & 1)
    for (int j = bx; j < 1024; j += G) {
        const int g = j & 7, bc = j >> 3, tok0 = bc * 128;
        int tid = threadIdx.x; asm volatile("" : "+v"(tid));
        const int lane = tid & 63, fr = lane & 15, fq = lane >> 4;
        LAS float* ac = (LAS float*)lds; LAS float* adt = ac + 512;
        const int l = 16 * wave + fr;
        bf16x8 fc[4];
#pragma unroll
        for (int ks = 0; ks < 4; ++ks) fc[ks] = *(const bf16x8*)(CC + (size_t)(tok0 + l) * 1024 + g * 128 + 32 * ks + 8 * fq);
        {
            const bf16_t* pg = PREV + (size_t)(bc * 8 + g) * 4096 * 8;
            u32x4 pv[8];
#pragma unroll
            for (int i = 0; i < 8; ++i) pv[i] = __builtin_nontemporal_load((const u32x4*)(pg + ((size_t)i * 512 + tid) * 8));
            const int mt_ = (tid >> 8) & 1, q_ = (tid >> 6) & 3, fr_ = tid & 15, fq_ = (tid >> 4) & 3;
#pragma unroll
            for (int i = 0; i < 8; ++i) { const int row = (i >> 1) * 64 + 32 * (i & 1) + 8 * (fr_ >> 2) + 4 * mt_ + (fr_ & 3);
                *(LAS u32x4*)(lds + 4096 + row * CB_STRIDE + (32 * q_ + 8 * fq_) * 2) = pv[i]; }
        }
        (void)chunk_prefix(adt, ac, DT, A.a_log, tok0, g, tid);
        f32x4 y[4][4];
        float ss = 0.f;
        bf16_t* zp = YAB + (size_t)(tok0 + l) * 4096 + 2048 + g * 256 + 8 * fq;
        const bf16_t* ydp = YD + ((size_t)(j * 8 + wave) * 8 * 64 + lane) * 8;
        const int prow0 = pg8::perm32(fr), prow1 = pg8::perm32(16 + fr);
#pragma unroll
        for (int k = 0; k < 4; ++k) {
            const int h = g * 4 + k; const float ea = __expf(ac[k * 128 + l]);
            const LAS unsigned char* pp = lds + 4096 + (k * 64) * CB_STRIDE + 16 * fq;
            f32x4 ao[4];
#pragma unroll
            for (int pt = 0; pt < 4; ++pt) ao[pt] = (f32x4){0.f, 0.f, 0.f, 0.f};
            u32x4 zv4[2], yv4[2];
#pragma unroll
            for (int q = 0; q < 2; ++q) { zv4[q] = *(const u32x4*)(zp + k * 64 + q * 32); yv4[q] = __builtin_nontemporal_load((const u32x4*)(ydp + (size_t)(k * 2 + q) * 512)); }
#pragma unroll
            for (int ks = 0; ks < 4; ++ks) {
                bf16x8 fpw[4];
#pragma unroll
                for (int pt = 0; pt < 4; ++pt) fpw[pt] = *(const LAS bf16x8*)(pp + (32 * (pt >> 1) + ((pt & 1) ? prow1 : prow0)) * CB_STRIDE + 64 * ks);
#pragma unroll
                for (int pt = 0; pt < 4; ++pt) ao[pt] = __builtin_amdgcn_mfma_f32_16x16x32_bf16(fpw[pt], fc[ks], ao[pt], 0, 0, 0);
            }
#pragma unroll
            for (int pt = 0; pt < 4; ++pt) { const u32x4 z4 = zv4[pt >> 1], y4 = yv4[pt >> 1];
                const unsigned zlo = (pt & 1) ? z4.z : z4.x, zhi = (pt & 1) ? z4.w : z4.y, ylo = (pt & 1) ? y4.z : y4.x, yhi = (pt & 1) ? y4.w : y4.y;
                f32x4 v = ao[pt] * ea; v[0] = (v[0] + bflo(ylo)) * bflo(zlo); v[1] = (v[1] + bfhi(ylo)) * bfhi(zlo); v[2] = (v[2] + bflo(yhi)) * bflo(zhi); v[3] = (v[3] + bfhi(yhi)) * bfhi(zhi);
                ss += (v[0] * v[0] + v[1] * v[1]) + (v[2] * v[2] + v[3] * v[3]); y[k][pt] = v; }
            __builtin_amdgcn_sched_barrier(0);
        }
        ss += __shfl_xor(ss, 16); ss += __shfl_xor(ss, 32);
        const float rstd = 1.0f / sqrtf(ss * (1.0f / 256.0f) + EPS);
        const float* nw = A.ssm_nw + g * 256 + 8 * fq;
        u32x4 ov[4][2];
#pragma unroll
        for (int k = 0; k < 4; ++k)
#pragma unroll
            for (int q = 0; q < 2; ++q) { const f32x4 w0 = *(const f32x4*)(nw + k * 64 + q * 32), w1 = *(const f32x4*)(nw + k * 64 + q * 32 + 4); const f32x4 v0 = y[k][2 * q], v1 = y[k][2 * q + 1];
                ov[k][q].x = cvt_pk_bf16(v0[0] * rstd * w0[0], v0[1] * rstd * w0[1]); ov[k][q].y = cvt_pk_bf16(v0[2] * rstd * w0[2], v0[3] * rstd * w0[3]);
                ov[k][q].z = cvt_pk_bf16(v1[0] * rstd * w1[0], v1[1] * rstd * w1[1]); ov[k][q].w = cvt_pk_bf16(v1[2] * rstd * w1[2], v1[3] * rstd * w1[3]); }
#pragma unroll
        for (int k = 0; k < 4; ++k)
#pragma unroll
            for (int q = 0; q < 2; ++q) *(u32x4*)(zp + k * 64 + q * 32) = ov[k][q];
        __syncthreads();
    }
    GRID_SYNC(5);

    if constexpr ((PH_MASK >> 5) & 1)
    {
        pg8::Gemm g{YAB, WbT, M_TOK, DM, DM, 2 * DM}; SplitKOrder S; S.init(M_TOK, DM, G, bx, WGM_P5);
        EpiMerge E{RG, GB, MERGED};
        pg8::gemm_phase<EpiMerge, SplitKOrder, true, true>(lds, g, S, E);
    }
    GRID_SYNC(6);

    if constexpr ((PH_MASK >> 6) & 1)
    {
        pg8::Gemm g{MERGED, WoT, M_TOK, DM, DM, DM}; pg8::StaticOrder S; S.init(M_TOK, DM, G, bx, WGM_P6);
        EpiAcc E{YAB};
        pg8::gemm_phase<EpiAcc, pg8::StaticOrder, true, true>(lds, g, S, E);
    }
    GRID_SYNC(7);

    if constexpr ((PH_MASK >> 7) & 1)
    for (int m = gw; m < M_TOK; m += 2 * NGW) {
        const int m2 = m + NGW;
        int tid_ = threadIdx.x; asm volatile("" : "+v"(tid_)); const int lane = tid_ & 63;
        const f32x4* xr = (const f32x4*)(A.x + (size_t)m * DM) + lane; const f32x4* xr2 = (const f32x4*)(A.x + (size_t)m2 * DM) + lane;
        const u32x2* ar = (const u32x2*)(YAB + (size_t)m * DM) + lane; const u32x2* ar2 = (const u32x2*)(YAB + (size_t)m2 * DM) + lane;
        const f32x4* wr4 = (const f32x4*)A.fnw + lane;
        f32x4 v[8], v2[8]; u32x2 a[8], a2[8]; float s = 0.f, s2 = 0.f;
#pragma unroll
        for (int j = 0; j < 8; ++j) { v[j] = __builtin_nontemporal_load(xr + 64 * j); v2[j] = __builtin_nontemporal_load(xr2 + 64 * j); a[j] = __builtin_nontemporal_load(ar + 64 * j); a2[j] = __builtin_nontemporal_load(ar2 + 64 * j); }
#pragma unroll
        for (int j = 0; j < 8; ++j) {
            v[j][0] += bflo(a[j].x); v[j][1] += bfhi(a[j].x); v[j][2] += bflo(a[j].y); v[j][3] += bfhi(a[j].y);
            v2[j][0] += bflo(a2[j].x); v2[j][1] += bfhi(a2[j].x); v2[j][2] += bflo(a2[j].y); v2[j][3] += bfhi(a2[j].y);
            s += (v[j][0] * v[j][0] + v[j][1] * v[j][1]) + (v[j][2] * v[j][2] + v[j][3] * v[j][3]); s2 += (v2[j][0] * v2[j][0] + v2[j][1] * v2[j][1]) + (v2[j][2] * v2[j][2] + v2[j][3] * v2[j][3]); }
        const float rstd = 1.0f / sqrtf(wave_sum(s) * (1.0f / DM) + EPS), rstd2 = 1.0f / sqrtf(wave_sum(s2) * (1.0f / DM) + EPS);
        f32x4* orow = (f32x4*)(A.out + (size_t)m * DM) + lane; f32x4* orow2 = (f32x4*)(A.out + (size_t)m2 * DM) + lane;
#pragma unroll
        for (int j = 0; j < 8; ++j) { const f32x4 w4 = wr4[64 * j]; __builtin_nontemporal_store(v[j] * rstd * w4, orow + 64 * j); __builtin_nontemporal_store(v2[j] * rstd2 * w4, orow2 + 64 * j); }
    }
#ifdef SPIN_SUB
    if (bx == 0 && tid == 0) {
        const unsigned long long* st = (const unsigned long long*)(BAR + 16) + 16;
        const unsigned long long d = (st[SPIN_SUB + 1] - st[SPIN_SUB]) * SPIN_MULT, t0 = __builtin_amdgcn_s_memrealtime();
        while (__builtin_amdgcn_s_memrealtime() - t0 < d) __builtin_amdgcn_s_sleep(10);
    }
#endif
#ifdef SPIN_PHASE
    STAMP(8);
    if (bx == 0 && tid == 0) {
        const unsigned long long* st = (const unsigned long long*)(BAR + 16);
        const unsigned long long d = (st[SPIN_PHASE + 1] - st[SPIN_PHASE]) * SPIN_MULT, t0 = __builtin_amdgcn_s_memrealtime();
        while (__builtin_amdgcn_s_memrealtime() - t0 < d) __builtin_amdgcn_s_sleep(10);
    }
#endif
}

extern "C" void kernel_launch(void* const* d_in, const int* in_sizes, int n_in, void* d_out, int out_size, void* d_ws, size_t ws_size, hipStream_t stream) {
    static int grid = 0;
    if (grid == 0) {
        if (n_in != 17 || out_size != M_TOK * DM || ws_size < WS_END) { fprintf(stderr, "kernel_launch: unexpected shapes (n_in %d out %d ws %zu)\n", n_in, out_size, ws_size); grid = -1; return; }
        int dev = 0, cus = 0, per_cu = 0;
        hipGetDevice(&dev); hipDeviceGetAttribute(&cus, hipDeviceAttributeMultiprocessorCount, dev);
        if (hipFuncSetAttribute((const void*)fwd_megakernel, hipFuncAttributeMaxDynamicSharedMemorySize, LDS_BYTES) != hipSuccess) { fprintf(stderr, "kernel_launch: hipFuncSetAttribute failed\n"); grid = -1; return; }
        if (hipOccupancyMaxActiveBlocksPerMultiprocessor(&per_cu, (const void*)fwd_megakernel, NT, LDS_BYTES) != hipSuccess || per_cu < 1) { fprintf(stderr, "kernel_launch: occupancy query says %d\n", per_cu); per_cu = 1; }
        (void)hipGetLastError();
        grid = cus * 1;
    }
    if (grid < 0) return;
    Args a{};
    a.x = (const float*)d_in[0]; a.norm_w = (const float*)d_in[1]; a.w_in = (const float*)d_in[2]; a.b_gate = (const float*)d_in[3]; a.ln_w = (const float*)d_in[4]; a.ln_b = (const float*)d_in[5];
    a.w_sp = (const float*)d_in[6]; a.b_sp = (const float*)d_in[7]; a.conv_w = (const float*)d_in[8]; a.conv_b = (const float*)d_in[9]; a.dt_bias = (const float*)d_in[10]; a.a_log = (const float*)d_in[11];
    a.d_skip = (const float*)d_in[12]; a.ssm_nw = (const float*)d_in[13]; a.w_branch = (const float*)d_in[14]; a.w_out = (const float*)d_in[15]; a.fnw = (const float*)d_in[16];
    a.out = (float*)d_out; a.ws = (unsigned char*)d_ws;
    void* args[] = {&a};
    hipError_t e = hipLaunchCooperativeKernel((const void*)fwd_megakernel, dim3(grid), dim3(NT), args, LDS_BYTES, stream);
    if (e != hipSuccess) fprintf(stderr, "cooperative launch failed: %s (grid %d)\n", hipGetErrorString(e), grid);
}
```
